# Optimizing an MI355X kernel written in HIP

```python
import math
import jax, jax.numpy as jnp
from jax import lax
import numpy as np

D_MODEL = 2048
BATCH = 4
SEQ = 4096
DEPTH = 1
DEC_BATCH = 1
DEC_SEQ = 8192
PAST_LEN = 128

HEAD_DIM = 64
N_HEADS_A = 16
N_HEADS_B = 16
N_KV_B = 4
WIDTH_A = N_HEADS_A * HEAD_DIM
WIDTH_B = N_HEADS_B * HEAD_DIM
MIX_WIDTH = WIDTH_A + WIDTH_B
KV_WIDTH_B = N_KV_B * HEAD_DIM
IN_WIDTH = 3 * WIDTH_A + WIDTH_B + 2 * KV_WIDTH_B
DILATED_PATTERNS = ((128, 1), (512, 4), (2048, 16))
LOCAL_WINDOW = 128
PEER_HEADS = 8
PEER_NKEYS = 128
PEER_DKEY = 256
PEER_TOPK = 16
N_EXPERTS = PEER_NKEYS * PEER_NKEYS
TOKEN_CHUNK = 128
RMS_EPS = 1e-6
NEG = -1e30

kernel_name = "hymba_dilated_swa_peer_encoder"


def rmsnorm(x, g):
    xf = x.astype(jnp.float32)
    y = xf * lax.rsqrt(jnp.mean(xf * xf, axis=-1, keepdims=True) + RMS_EPS)
    return (y * g.astype(jnp.float32)).astype(x.dtype)


def alibi_slopes():
    n = N_HEADS_A + N_HEADS_B
    s = 2.0 ** (-8.0 * jnp.arange(1, n + 1, dtype=jnp.float32) / n)
    return s[0::2], s[1::2]


def banded_attn(q, k, v, slopes, half, step, sink=None):
    B, L, Hq, dh = q.shape
    Hk = k.shape[2]
    G = Hq // Hk
    W = half
    nb = -(-L // W)
    Lp = nb * W
    pad = Lp - L
    q = jnp.pad(q, ((0, 0), (0, pad), (0, 0), (0, 0)))
    kp = jnp.pad(k, ((0, 0), (W, pad + W), (0, 0), (0, 0))).reshape(B, nb + 2, W, Hk, dh)
    vp = jnp.pad(v, ((0, 0), (W, pad + W), (0, 0), (0, 0))).reshape(B, nb + 2, W, Hk, dh)
    kwin = jnp.concatenate([kp[:, :-2], kp[:, 1:-1], kp[:, 2:]], axis=2)
    vwin = jnp.concatenate([vp[:, :-2], vp[:, 1:-1], vp[:, 2:]], axis=2)
    qb = q.reshape(B, nb, W, Hk, G, dh)
    s = jnp.einsum('bnqkgd,bnskd->bnkgqs', qb, kwin).astype(jnp.float32) / math.sqrt(dh)
    rel = jnp.arange(3 * W)[None, :] - W - jnp.arange(W)[:, None]
    kpos = jnp.arange(nb)[:, None] * W + jnp.arange(3 * W)[None, :] - W
    valid = (jnp.abs(rel) <= W)[None] & ((kpos >= 0) & (kpos < L))[:, None, :]
    dist = (jnp.abs(rel) * step).astype(jnp.float32)
    bias = -slopes.astype(jnp.float32).reshape(Hk, G)[:, :, None, None] * dist
    s = jnp.where(valid[None, :, None, None], s + bias[None, None], NEG)
    m = jnp.max(s, axis=-1)
    if sink is not None:
        sk = sink.astype(jnp.float32).reshape(Hk, G)[:, :, None]
        m = jnp.maximum(m, sk)
    e = jnp.exp(s - m[..., None])
    den = jnp.sum(e, axis=-1)
    if sink is not None:
        den = den + jnp.exp(sk - m)
    lse = m + jnp.log(den)
    p = e / den[..., None]
    o = jnp.einsum('bnkgqs,bnskd->bnqkgd', p.astype(vwin.dtype), vwin)
    o = o.reshape(B, Lp, Hq, dh)[:, :L]
    lse = lse.transpose(0, 1, 4, 2, 3).reshape(B, Lp, Hq)[:, :L]
    return o, lse


def dilated_attention(q, k, v, slopes):
    B, S, H, dh = q.shape
    outs, lses = [], []
    for window, d in DILATED_PATTERNS:
        half = (window // 2) // d
        def split(t):
            return t.reshape(B, S // d, d, H, dh).transpose(0, 2, 1, 3, 4).reshape(B * d, S // d, H, dh)
        o, lse = banded_attn(split(q), split(k), split(v), slopes, half, d)
        outs.append(o.reshape(B, d, S // d, H, dh).transpose(0, 2, 1, 3, 4).reshape(B, S, H, dh).astype(jnp.float32))
        lses.append(lse.reshape(B, d, S // d, H).transpose(0, 2, 1, 3).reshape(B, S, H))
    w = jax.nn.softmax(jnp.stack(lses), axis=0)
    out = jnp.einsum('pbsh,pbshd->bshd', w, jnp.stack(outs))
    return out.astype(q.dtype)


def peer(h, w_pq, sub_keys, expert_u, expert_v):
    B, S, D = h.shape
    T = B * S
    hc = h.reshape(T // TOKEN_CHUNK, TOKEN_CHUNK, D)
    K = PEER_TOPK

    def chunk(xc):
        C = xc.shape[0]
        q = (xc @ w_pq).reshape(C, PEER_HEADS, 2, PEER_DKEY // 2)
        sc = jnp.einsum('chpd,hpnd->chpn', q, sub_keys).astype(jnp.float32)
        v1, i1 = lax.top_k(sc[:, :, 0], K)
        v2, i2 = lax.top_k(sc[:, :, 1], K)
        cand = (v1[..., :, None] + v2[..., None, :]).reshape(C, PEER_HEADS, K * K)
        cid = (i1[..., :, None] * PEER_NKEYS + i2[..., None, :]).reshape(C, PEER_HEADS, K * K)
        top, pos = lax.top_k(cand, K)
        eid = jnp.take_along_axis(cid, pos, axis=-1)
        g = jax.nn.softmax(top, axis=-1)
        ue = expert_u[eid]
        act = jax.nn.gelu(jnp.einsum('cd,chkd->chk', xc, ue).astype(jnp.float32), approximate=False)
        ve = expert_v[eid]
        return jnp.einsum('chk,chkd->cd', (g * act).astype(xc.dtype), ve)

    return lax.map(chunk, hc).reshape(B, S, D)


def trunk(x, norm1_g, w_in, a_out_g, b_out_g, sink, w_out, norm2_g, w_pq, sub_keys, expert_u, expert_v, normf_g):
    B, S, _ = x.shape
    slopes_a, slopes_b = alibi_slopes()
    cuts = [WIDTH_A, 2 * WIDTH_A, 3 * WIDTH_A, 3 * WIDTH_A + WIDTH_B, 3 * WIDTH_A + WIDTH_B + KV_WIDTH_B]
    for l in range(DEPTH):
        xn = rmsnorm(x, norm1_g[l])
        proj = xn @ w_in[l]
        qa, ka, va, qb, kb, vb = jnp.split(proj, cuts, axis=-1)
        qa = qa.reshape(B, S, N_HEADS_A, HEAD_DIM)
        ka = ka.reshape(B, S, N_HEADS_A, HEAD_DIM)
        va = va.reshape(B, S, N_HEADS_A, HEAD_DIM)
        qb = qb.reshape(B, S, N_HEADS_B, HEAD_DIM)
        kb = kb.reshape(B, S, N_KV_B, HEAD_DIM)
        vb = vb.reshape(B, S, N_KV_B, HEAD_DIM)
        oa = dilated_attention(qa, ka, va, slopes_a).reshape(B, S, WIDTH_A)
        ob, _ = banded_attn(qb, kb, vb, slopes_b, LOCAL_WINDOW, 1, sink[l])
        ob = ob.reshape(B, S, WIDTH_B)
        mixed = jnp.concatenate([rmsnorm(oa, a_out_g[l]), rmsnorm(ob, b_out_g[l])], axis=-1)
        x = x + mixed @ w_out[l]
        x = x + peer(rmsnorm(x, norm2_g[l]), w_pq[l], sub_keys[l], expert_u[l], expert_v[l])
    return rmsnorm(x, normf_g)


def setup_inputs(seed: int = 0) -> dict:
    key = jax.random.key(seed)
    ks = jax.random.split(key, 16)
    f32 = jnp.float32
    D = D_MODEL
    nrm = lambda k, shape, sc: jax.random.normal(k, shape, f32) * sc
    return {
        "x_prompt": nrm(ks[0], (BATCH, SEQ, D), 1.0),
        "x_sample": nrm(ks[1], (DEC_BATCH, DEC_SEQ, D), 1.0),
        "norm1_g": 1.0 + nrm(ks[2], (DEPTH, D), 0.02),
        "w_in": nrm(ks[3], (DEPTH, D, IN_WIDTH), D ** -0.5),
        "a_out_g": 1.0 + nrm(ks[4], (DEPTH, WIDTH_A), 0.02),
        "b_out_g": 1.0 + nrm(ks[5], (DEPTH, WIDTH_B), 0.02),
        "sink": nrm(ks[6], (DEPTH, N_HEADS_B), 0.1),
        "w_out": nrm(ks[7], (DEPTH, MIX_WIDTH, D), MIX_WIDTH ** -0.5),
        "norm2_g": 1.0 + nrm(ks[8], (DEPTH, D), 0.02),
        "w_pq": nrm(ks[9], (DEPTH, D, PEER_HEADS * PEER_DKEY), D ** -0.5),
        "sub_keys": nrm(ks[10], (DEPTH, PEER_HEADS, 2, PEER_NKEYS, PEER_DKEY // 2), (PEER_DKEY // 2) ** -0.5),
        "expert_u": nrm(ks[11], (DEPTH, N_EXPERTS, D), D ** -0.5),
        "expert_v": nrm(ks[12], (DEPTH, N_EXPERTS, D), 0.1),
        "normf_g": 1.0 + nrm(ks[13], (D,), 0.02),
    }


def reference(x_prompt, x_sample, norm1_g, w_in, a_out_g, b_out_g, sink, w_out, norm2_g, w_pq, sub_keys, expert_u, expert_v, normf_g):
    y_prompt = trunk(x_prompt, norm1_g, w_in, a_out_g, b_out_g, sink, w_out, norm2_g, w_pq, sub_keys, expert_u, expert_v, normf_g)
    y_sample = trunk(x_sample, norm1_g, w_in, a_out_g, b_out_g, sink, w_out, norm2_g, w_pq, sub_keys, expert_u, expert_v, normf_g)
    return (y_prompt, y_sample)
```

```cpp
#include <hip/hip_runtime.h>
#include <hip/hip_cooperative_groups.h>
#include <cstdio>
#include <cstdint>
namespace cg = cooperative_groups;

#ifndef MK_N_LAUNCHES
#define MK_N_LAUNCHES 8
#endif

namespace pg8 {
#define PG8_LAS __attribute__((address_space(3)))
typedef unsigned short bf16_t;
typedef short bf16x8 __attribute__((ext_vector_type(8)));
typedef float f32x4 __attribute__((ext_vector_type(4)));
typedef unsigned u32x4 __attribute__((ext_vector_type(4)));
typedef unsigned u32x2 __attribute__((ext_vector_type(2)));
constexpr int BM = 256, BK = 64, HALF = 128, HTB = HALF * BK * 2, STAGE_BYTES = 8 * HTB, NXCD = 8, WGM = 8;

__host__ __device__ __forceinline__ int lds_byte(int r, int c) { const int st = (r >> 4) * 2 + (c >> 5), rr = r & 15, cc = c & 31, ob = rr * 64 + cc * 2; return st * 1024 + (ob ^ (((ob >> 9) & 1) << 5)); }
__host__ __device__ __forceinline__ void stage_rc(int b, int& R, int& C) { const int st = b / 1024, sb = b % 1024, swz = sb ^ (((sb >> 9) & 1) << 5); R = (st >> 1) * 16 + swz / 64; C = (st & 1) * 32 + (swz % 64) / 2; }
__host__ __device__ __forceinline__ int perm32(int rho) { const int n = rho >> 4, i = rho & 15; return 8 * (i >> 2) + 4 * n + (i & 3); }

struct Unit { int pm, pn; };
struct Gemm { const bf16_t* A; const bf16_t* Bt; int M, N, K; };

struct StaticOrder {
    int nM, nN, nwg, G, c;
    __host__ __device__ void init(int M, int N, int G_, int c_) { nM = M / BM; nN = N / BM; nwg = nM * nN; G = G_; c = c_; }
    __host__ __device__ bool next(int i, Unit& u) const {
        const long L = (long)i * G + c; if (L >= nwg) return false;
        int wgid = (int)L; { const int q = nwg / NXCD, r = nwg % NXCD, xcd = wgid % NXCD, off = wgid / NXCD; wgid = (xcd < r ? xcd * (q + 1) : r * (q + 1) + (xcd - r) * q) + off; }
        const int nig = WGM * nN, gid = wgid / nig, fm = gid * WGM, gsz = (nM - fm) < WGM ? (nM - fm) : WGM;
        u.pm = fm + ((wgid % nig) % gsz); u.pn = (wgid % nig) / gsz; return true;
    }
    __device__ __forceinline__ void a_ready(const Unit&) const {}
    __device__ __forceinline__ void done(const Unit&) const {}
};

__device__ __forceinline__ unsigned cvt_pk_bf16(float lo, float hi) { unsigned r; asm volatile("v_cvt_pk_bf16_f32 %0, %1, %2" : "=v"(r) : "v"(lo), "v"(hi)); return r; }

struct EpiBf16 {
    static constexpr bool PERM = true, AFTER_DRAIN = false;
    bf16_t* O; int ldc; const float* ss;
    __device__ __forceinline__ void operator()(const f32x4 (&acc)[2][2][4][2], const Unit& u, int wr, int wc, int fr, int fq) const {
        const int row0 = u.pm * BM + wr * 64 + fr; const int col0 = u.pn * BM + wc * 32 + 8 * fq;
#pragma unroll
        for (int ai = 0; ai < 2; ++ai)
#pragma unroll
            for (int m = 0; m < 4; ++m) {
                const int r = row0 + ai * HALF + m * 16;
                float sc = 1.f;
                if (ss) { const f32x4* p = (const f32x4*)(ss + (size_t)r * 32); float s = 0.f;
#pragma unroll
                    for (int i = 0; i < 8; ++i) { const f32x4 v = p[i]; s += (v[0] + v[1]) + (v[2] + v[3]); }
                    sc = 1.0f / sqrtf(s * (1.0f / 2048.0f) + 1e-6f); }
                bf16_t* rowp = O + (size_t)r * ldc + col0;
#pragma unroll
                for (int bj = 0; bj < 2; ++bj) { const f32x4 v0 = acc[ai][bj][m][0] * sc, v1 = acc[ai][bj][m][1] * sc;
                    u32x4 w; w.x = cvt_pk_bf16(v0[0], v0[1]); w.y = cvt_pk_bf16(v0[2], v0[3]); w.z = cvt_pk_bf16(v1[0], v1[1]); w.w = cvt_pk_bf16(v1[2], v1[3]);
                    *(u32x4*)(rowp + bj * HALF) = w; } }
    }
};
struct EpiResid {
    static constexpr bool PERM = false, AFTER_DRAIN = false;
    const float* xp; const float* xs; float* out; bf16_t* xb; float* ss;
    __device__ __forceinline__ void operator()(const f32x4 (&acc)[2][2][4][2], const Unit& u, int wr, int wc, int fr, int fq) const {
        const int row0 = u.pm * BM + wr * 64 + fr; const int col0 = u.pn * BM + wc * 32 + 4 * fq;
#pragma unroll
        for (int ai = 0; ai < 2; ++ai)
#pragma unroll
            for (int m = 0; m < 4; ++m) {
                const int r = row0 + ai * HALF + m * 16;
                const float* xrow = (r < 16384) ? (xp + (size_t)r * 2048) : (xs + (size_t)(r - 16384) * 2048);
                float s = 0.f;
#pragma unroll
                for (int bj = 0; bj < 2; ++bj)
#pragma unroll
                    for (int n = 0; n < 2; ++n) { const int c = col0 + bj * HALF + n * 16;
                        const f32x4 v = acc[ai][bj][m][n] + *(const f32x4*)(xrow + c);
                        *(f32x4*)(out + (size_t)r * 2048 + c) = v;
                        u32x2 w; w.x = cvt_pk_bf16(v[0], v[1]); w.y = cvt_pk_bf16(v[2], v[3]);
                        *(u32x2*)(xb + (size_t)r * 2048 + c) = w;
                        s += (v[0] * v[0] + v[1] * v[1]) + (v[2] * v[2] + v[3] * v[3]); }
                s += __shfl_xor(s, 16); s += __shfl_xor(s, 32);
                if (fq == 0) ss[(size_t)r * 32 + u.pn * 4 + wc] = s;
                asm volatile("" ::: "memory"); }
    }
};

template <class Epi, class Sched, bool ALIGN_EPI = false, bool SP2 = false>
__device__ __forceinline__ void gemm_phase(PG8_LAS unsigned char* lds, const Gemm g, const Sched& S, const Epi& E) {
    const int tid = threadIdx.x, wid = __builtin_amdgcn_readfirstlane(tid >> 6), lane = tid & 63, wr = wid >> 2, wc = wid & 3, fr = lane & 15, fq = lane >> 4;
    const int K = g.K, nt = K / BK;
    unsigned voffA[2], voffB[2];
#pragma unroll
    for (int i = 0; i < 2; ++i) { int R, C; stage_rc(tid * 16 + i * 8192, R, C); const int Rb = Epi::PERM ? ((R & ~31) + perm32(R & 31)) : R;
        voffA[i] = (unsigned)(R * K + C) * 2u; voffB[i] = (unsigned)(Rb * K + C) * 2u; }
    const size_t kstep = (size_t)(BK * 2);
    const size_t hstep = (size_t)HALF * K * 2;
    const size_t tstep = 2 * hstep;
    const unsigned ldsw = (unsigned)wid * 1024u;
    const int aoff = lds_byte(wr * 64 + fr, fq * 8), boff = lds_byte(wc * 32 + fr, fq * 8);
#define PG8_SA(b, h) (((b) * 2 + (h)) * HTB)
#define PG8_SB(b, h) ((4 + (b) * 2 + (h)) * HTB)
#define PG8_STAGE(bufoff, gbase, voff) do { _Pragma("unroll") for (int _i = 0; _i < 2; ++_i) \
        __builtin_amdgcn_global_load_lds((const unsigned*)((const char*)(gbase) + (voff)[_i]), (PG8_LAS unsigned*)(lds + (bufoff) + ldsw + _i * 8192), 16, 0, 0); } while (0)
#define PG8_LDA(dst, b, h) do { _Pragma("unroll") for (int m = 0; m < 4; ++m) _Pragma("unroll") for (int k = 0; k < 2; ++k) dst[m][k] = *(const PG8_LAS bf16x8*)(lds + PG8_SA(b, h) + aoff + m * 2048 + k * 1024); } while (0)
#define PG8_LDB(dst, b, h) do { _Pragma("unroll") for (int n = 0; n < 2; ++n) _Pragma("unroll") for (int k = 0; k < 2; ++k) dst[n][k] = *(const PG8_LAS bf16x8*)(lds + PG8_SB(b, h) + boff + n * 2048 + k * 1024); } while (0)
#define PG8_MMA(ai, bj, At, Bt) do { __builtin_amdgcn_s_setprio(1); _Pragma("unroll") for (int m = 0; m < 4; ++m) _Pragma("unroll") for (int n = 0; n < 2; ++n) _Pragma("unroll") for (int k = 0; k < 2; ++k) \
        acc[ai][bj][m][n] = __builtin_amdgcn_mfma_f32_16x16x32_bf16(Bt[n][k], At[m][k], acc[ai][bj][m][n], 0, 0, 0); __builtin_amdgcn_s_setprio(0); } while (0)
#define PG8_WAIT_V(n) asm volatile("s_waitcnt vmcnt(" #n ")" ::: "memory")
#define PG8_WAIT_L(n) asm volatile("s_waitcnt lgkmcnt(" #n ")" ::: "memory")
#define PG8_BAR __builtin_amdgcn_s_barrier()
#define PG8_SCHED __builtin_amdgcn_sched_barrier(0)
    Unit cur, nxt; int ui = 0;
    if (!S.next(0, cur)) return;
    f32x4 acc[2][2][4][2];
#pragma unroll
    for (int a = 0; a < 2; ++a)
#pragma unroll
        for (int b = 0; b < 2; ++b)
#pragma unroll
            for (int m = 0; m < 4; ++m)
#pragma unroll
                for (int n = 0; n < 2; ++n) acc[a][b][m][n] = (f32x4){0.f, 0.f, 0.f, 0.f};
    bf16x8 At[4][2], B0[2][2], B1[2][2];
    const char* cA = (const char*)g.A + (size_t)cur.pm * tstep; const char* cB = (const char*)g.Bt + (size_t)cur.pn * tstep;
    S.a_ready(cur);
    if constexpr (SP2) {
        PG8_STAGE(PG8_SB(0, 0), cB, voffB); PG8_STAGE(PG8_SB(0, 1), cB + hstep, voffB); PG8_STAGE(PG8_SA(0, 0), cA, voffA); PG8_STAGE(PG8_SA(0, 1), cA + hstep, voffA);
        if (wr == 1) PG8_BAR;
        PG8_WAIT_V(2); PG8_BAR;
        PG8_STAGE(PG8_SB(1, 0), cB + kstep, voffB); PG8_STAGE(PG8_SA(1, 0), cA + kstep, voffA); PG8_STAGE(PG8_SB(1, 1), cB + hstep + kstep, voffB);
        PG8_WAIT_V(6); PG8_BAR;
    } else {
        PG8_STAGE(PG8_SB(0, 0), cB, voffB); PG8_STAGE(PG8_SA(0, 0), cA, voffA); PG8_STAGE(PG8_SB(0, 1), cB + hstep, voffB); PG8_STAGE(PG8_SA(0, 1), cA + hstep, voffA);
        if (wr == 1) PG8_BAR;
        PG8_WAIT_V(4); PG8_BAR;
        PG8_STAGE(PG8_SB(1, 0), cB + kstep, voffB); PG8_STAGE(PG8_SA(1, 0), cA + kstep, voffA); PG8_STAGE(PG8_SB(1, 1), cB + hstep + kstep, voffB);
        PG8_WAIT_V(6); PG8_BAR;
    }
    for (;;) {
        const bool has_next = S.next(ui + 1, nxt);
        const char* nA = has_next ? (const char*)g.A + (size_t)nxt.pm * tstep : cA; const char* nB = has_next ? (const char*)g.Bt + (size_t)nxt.pn * tstep : cB;
        for (int t = 0; t < nt; t += 2) {
            const bool last = (t == nt - 2);
            const char* a1 = cA + (size_t)(t + 1) * kstep;
            const char* a2 = last ? nA : cA + (size_t)(t + 2) * kstep; const char* b2 = last ? nB : cB + (size_t)(t + 2) * kstep;
            const char* a3 = a2 + kstep; const char* b3 = b2 + kstep;
            if (last && has_next) S.a_ready(nxt);
            if constexpr (SP2) {
            PG8_LDB(B0, 0, 0); PG8_LDB(B1, 0, 1); PG8_SCHED; PG8_LDA(At, 0, 0); PG8_STAGE(PG8_SA(1, 1), a1 + hstep, voffA);
            PG8_WAIT_V(8); PG8_WAIT_L(0); PG8_BAR; PG8_MMA(0, 0, At, B0); PG8_MMA(0, 1, At, B1); PG8_BAR; PG8_SCHED;
            PG8_LDA(At, 0, 1); PG8_STAGE(PG8_SB(0, 0), b2, voffB); PG8_STAGE(PG8_SB(0, 1), b2 + hstep, voffB); PG8_STAGE(PG8_SA(0, 0), a2, voffA);
            PG8_WAIT_V(8); PG8_WAIT_L(0); PG8_BAR; PG8_MMA(1, 0, At, B0); PG8_MMA(1, 1, At, B1); PG8_BAR; PG8_SCHED;
            PG8_LDB(B0, 1, 0); PG8_LDB(B1, 1, 1); PG8_SCHED; PG8_LDA(At, 1, 0); PG8_STAGE(PG8_SA(0, 1), a2 + hstep, voffA);
            PG8_WAIT_V(8); PG8_WAIT_L(0); PG8_BAR; PG8_MMA(0, 0, At, B0); PG8_MMA(0, 1, At, B1); PG8_BAR; PG8_SCHED;
            PG8_LDA(At, 1, 1); PG8_STAGE(PG8_SB(1, 0), b3, voffB); PG8_STAGE(PG8_SB(1, 1), b3 + hstep, voffB); PG8_STAGE(PG8_SA(1, 0), a3, voffA);
            PG8_WAIT_V(8); PG8_WAIT_L(0); PG8_BAR; PG8_MMA(1, 0, At, B0); PG8_MMA(1, 1, At, B1); PG8_BAR; PG8_SCHED;
            } else {
            PG8_LDB(B0, 0, 0); PG8_SCHED; PG8_LDA(At, 0, 0); PG8_STAGE(PG8_SA(1, 1), a1 + hstep, voffA);
            PG8_WAIT_L(8); PG8_BAR; PG8_WAIT_L(0); PG8_MMA(0, 0, At, B0); PG8_BAR; PG8_SCHED;
            PG8_LDB(B1, 0, 1); PG8_STAGE(PG8_SB(0, 0), b2, voffB);
            PG8_BAR; PG8_WAIT_L(0); PG8_MMA(0, 1, At, B1); PG8_BAR;
            PG8_LDA(At, 0, 1); PG8_STAGE(PG8_SA(0, 0), a2, voffA);
            PG8_BAR; PG8_WAIT_L(0); PG8_MMA(1, 0, At, B0); PG8_BAR; PG8_SCHED;
            PG8_STAGE(PG8_SB(0, 1), b2 + hstep, voffB);
            PG8_WAIT_V(6); PG8_BAR; PG8_MMA(1, 1, At, B1); PG8_BAR;
            PG8_LDB(B0, 1, 0); PG8_SCHED; PG8_LDA(At, 1, 0); PG8_STAGE(PG8_SA(0, 1), a2 + hstep, voffA);
            PG8_WAIT_L(8); PG8_BAR; PG8_WAIT_L(0); PG8_MMA(0, 0, At, B0); PG8_BAR; PG8_SCHED;
            PG8_LDB(B1, 1, 1); PG8_STAGE(PG8_SB(1, 0), b3, voffB);
            PG8_BAR; PG8_WAIT_L(0); PG8_MMA(0, 1, At, B1); PG8_BAR;
            PG8_LDA(At, 1, 1); PG8_STAGE(PG8_SA(1, 0), a3, voffA);
            PG8_BAR; PG8_WAIT_L(0); PG8_MMA(1, 0, At, B0); PG8_BAR; PG8_SCHED;
            PG8_STAGE(PG8_SB(1, 1), b3 + hstep, voffB);
            PG8_WAIT_V(6); PG8_BAR; PG8_MMA(1, 1, At, B1); PG8_BAR;
            }
        }
        if constexpr (ALIGN_EPI) { if (wr == 0) PG8_BAR; }
        if constexpr (!Epi::AFTER_DRAIN) { E(acc, cur, wr, wc, fr, fq); S.done(cur); }
        if (!has_next) break;
#pragma unroll
        for (int a = 0; a < 2; ++a)
#pragma unroll
            for (int b = 0; b < 2; ++b)
#pragma unroll
                for (int m = 0; m < 4; ++m)
#pragma unroll
                    for (int n = 0; n < 2; ++n) acc[a][b][m][n] = (f32x4){0.f, 0.f, 0.f, 0.f};
        cur = nxt; cA = nA; cB = nB; ++ui;
        if constexpr (ALIGN_EPI) { if (wr == 1) PG8_BAR; }
    }
    PG8_WAIT_V(0);
    if constexpr (!ALIGN_EPI) { if (wr == 0) PG8_BAR; }
    PG8_BAR;
#undef PG8_SA
#undef PG8_SB
#undef PG8_STAGE
#undef PG8_LDA
#undef PG8_LDB
#undef PG8_MMA
#undef PG8_WAIT_V
#undef PG8_WAIT_L
#undef PG8_BAR
#undef PG8_SCHED
}
}

constexpr int NT_TOK = 24576, DM = 2048, INW = 4608, NPROMPT = 16384;
constexpr int NWAVES = 8, NTHREADS = 512;
constexpr float RMS_EPS = 1e-6f;
constexpr float LOG2E = 1.4426950408889634f;

constexpr size_t MiB = 1u << 20;
constexpr size_t WS_CTL = 0, CTL_ZERO_BYTES = 64 * 1024;
constexpr size_t WS_WIN = 1 * MiB;
constexpr size_t WS_WOUT = 19 * MiB;
constexpr size_t WS_WPQ = 27 * MiB;
constexpr size_t WS_SK = 35 * MiB;
constexpr size_t WS_SS = 36 * MiB;
constexpr size_t WS_U = 40 * MiB;
constexpr size_t WS_V = 104 * MiB;
constexpr size_t WS_XN = 168 * MiB;
constexpr size_t WS_PROJ = 264 * MiB;
constexpr size_t WS_MIXED = WS_PROJ;
constexpr size_t WS_X2B = WS_PROJ + 96 * MiB;
constexpr size_t WS_RE = WS_PROJ + 192 * MiB;
constexpr size_t WS_RG = WS_PROJ + 204 * MiB;
constexpr size_t WS_END = 480 * MiB;
constexpr size_t OUT_OA = 0, OUT_OA_STRIDE = 48 * MiB, OUT_LSE = 144 * MiB, OUT_LSE_STRIDE = (size_t)NT_TOK * 16 * 4;

constexpr int LDS_BYTES = 147456;

#define LAS __attribute__((address_space(3)))
typedef unsigned short bf16;
typedef unsigned v4u __attribute__((ext_vector_type(4)));
typedef unsigned v2u __attribute__((ext_vector_type(2)));
typedef float f32x4 __attribute__((ext_vector_type(4)));
typedef float f32x16 __attribute__((ext_vector_type(16)));
typedef short bf16x8 __attribute__((ext_vector_type(8)));
typedef short s16x4 __attribute__((ext_vector_type(4)));

__device__ __forceinline__ unsigned f2bf(float f) { unsigned u = __builtin_bit_cast(unsigned, f); return (u + 0x7fffu + ((u >> 16) & 1u)) >> 16; }
__device__ __forceinline__ unsigned pk2(float lo, float hi) { return f2bf(lo) | (f2bf(hi) << 16); }
__device__ __forceinline__ float bflo(unsigned w) { return __builtin_bit_cast(float, w << 16); }
__device__ __forceinline__ float bfhi(unsigned w) { return __builtin_bit_cast(float, w & 0xffff0000u); }
__device__ __forceinline__ float wave_sum(float v) {
#pragma unroll
    for (int o = 1; o < 64; o <<= 1) v += __shfl_xor(v, o);
    return v;
}

struct Args { const float* in[14]; float* out; unsigned char* ws; int ph_lo, ph_hi; };

struct Frame {
    LAS unsigned char* lds; unsigned char* lds_g;
    int tid, lane, wave, vcu, G;
    const float *xp, *xs, *norm1_g, *w_in, *a_out_g, *b_out_g, *sink, *w_out, *norm2_g, *w_pq, *sub_keys, *expert_u, *expert_v, *normf_g;
    float* out; unsigned char* ws;
};

__device__ __forceinline__ void p0_transpose_item(const float* W, int K, int N, bf16* WT, const float* kscale, LAS float* scr, int item, int lane) {
    const int nblk = N / 32, kb = item / nblk, nb = item % nblk, k0 = 64 * kb, n0 = 32 * nb;
#pragma unroll 8
    for (int i = 0; i < 32; ++i) { const int kk = 2 * i + (lane >> 5); float v = W[(size_t)(k0 + kk) * N + n0 + (lane & 31)]; if (kscale) v *= kscale[k0 + kk]; scr[kk * 33 + (lane & 31)] = v; }
    asm volatile("s_waitcnt lgkmcnt(0)" ::: "memory");
    const int c = lane & 7;
#pragma unroll
    for (int j = 0; j < 4; ++j) { const int n = (lane >> 3) + 8 * j; const LAS float* s = scr + (8 * c) * 33 + n;
        v4u o; o.x = pk2(s[0 * 33], s[1 * 33]); o.y = pk2(s[2 * 33], s[3 * 33]); o.z = pk2(s[4 * 33], s[5 * 33]); o.w = pk2(s[6 * 33], s[7 * 33]);
        *(v4u*)(WT + (size_t)(n0 + n) * K + k0 + 8 * c) = o; }
    asm volatile("s_waitcnt lgkmcnt(0)" ::: "memory");
}
__device__ __forceinline__ void p0_prep(Frame& F) {
    LAS float* scr = (LAS float*)(F.lds + F.wave * 16384);
    const int gw = F.vcu * NWAVES + F.wave, NGW = F.G * NWAVES, lane = F.lane;
    bf16* WinT = (bf16*)(F.ws + WS_WIN); bf16* WoutT = (bf16*)(F.ws + WS_WOUT); bf16* WpqT = (bf16*)(F.ws + WS_WPQ);
    constexpr int I_IN = (DM / 64) * (INW / 32), I_OUT = (DM / 64) * (DM / 32), I_PQ = I_OUT;
    for (int it = gw; it < I_IN + I_OUT + I_PQ; it += NGW) {
        int r = it;
        if (r < I_IN) { p0_transpose_item(F.w_in, DM, INW, WinT, nullptr, scr, r, lane); continue; } r -= I_IN;
        if (r < I_OUT) { p0_transpose_item(F.w_out, DM, DM, WoutT, nullptr, scr, r, lane); continue; } r -= I_OUT;
        p0_transpose_item(F.w_pq, DM, DM, WpqT, F.norm2_g, scr, r, lane);
    }
    { bf16* SK = (bf16*)(F.ws + WS_SK);
      for (int i = gw * 64 + lane; i < 65536; i += NGW * 64) { const f32x4 v = ((const f32x4*)F.sub_keys)[i]; v2u o; o.x = pk2(v[0], v[1]); o.y = pk2(v[2], v[3]); ((v2u*)SK)[i] = o; } }
    { bf16* U = (bf16*)(F.ws + WS_U); bf16* V = (bf16*)(F.ws + WS_V);
      f32x4 g2[4][2];
#pragma unroll
      for (int j = 0; j < 4; ++j) { g2[j][0] = *(const f32x4*)(F.norm2_g + 512 * j + 8 * lane); g2[j][1] = *(const f32x4*)(F.norm2_g + 512 * j + 8 * lane + 4); }
      for (int row = gw; row < 32768; row += NGW) {
          const bool isu = row < 16384; const int e = isu ? row : row - 16384;
          const float* src = (isu ? F.expert_u : F.expert_v) + (size_t)e * DM; bf16* dst = (isu ? U : V) + (size_t)e * DM;
#pragma unroll
          for (int j = 0; j < 4; ++j) { f32x4 a = *(const f32x4*)(src + 512 * j + 8 * lane), b = *(const f32x4*)(src + 512 * j + 8 * lane + 4);
              if (isu) { a = a * g2[j][0]; b = b * g2[j][1]; }
              v4u o; o.x = pk2(a[0], a[1]); o.y = pk2(a[2], a[3]); o.z = pk2(b[0], b[1]); o.w = pk2(b[2], b[3]);
              *(v4u*)(dst + 512 * j + 8 * lane) = o; } } }
    { bf16* XN = (bf16*)(F.ws + WS_XN);
      for (int t = gw; t < NT_TOK; t += NGW) {
          const float* xr = (t < NPROMPT) ? F.xp + (size_t)t * DM : F.xs + (size_t)(t - NPROMPT) * DM;
          f32x4 v[4][2]; float s = 0.f;
#pragma unroll
          for (int j = 0; j < 4; ++j) { v[j][0] = *(const f32x4*)(xr + 512 * j + 8 * lane); v[j][1] = *(const f32x4*)(xr + 512 * j + 8 * lane + 4);
#pragma unroll
              for (int q = 0; q < 2; ++q) s += (v[j][q][0] * v[j][q][0] + v[j][q][1] * v[j][q][1]) + (v[j][q][2] * v[j][q][2] + v[j][q][3] * v[j][q][3]); }
          const float rstd = 1.0f / sqrtf(wave_sum(s) * (1.0f / DM) + RMS_EPS);
#pragma unroll
          for (int j = 0; j < 4; ++j) { const f32x4 ga = *(const f32x4*)(F.norm1_g + 512 * j + 8 * lane), gb = *(const f32x4*)(F.norm1_g + 512 * j + 8 * lane + 4);
              const f32x4 a = v[j][0] * rstd * ga, b = v[j][1] * rstd * gb;
              v4u o; o.x = pk2(a[0], a[1]); o.y = pk2(a[2], a[3]); o.z = pk2(b[0], b[1]); o.w = pk2(b[2], b[3]);
              *(v4u*)(XN + (size_t)t * DM + 512 * j + 8 * lane) = o; } } }
}

constexpr int ATT_KOFF = 0, ATT_VOFF = 65536;
template <int NK>
__device__ __forceinline__ void att_stage(Frame& F, const bf16* proj, int rowbase, int r, int d, int i0, int Lsub, int kcol, int vcol) {
    LAS unsigned char* Ks = F.lds + ATT_KOFF; LAS unsigned char* Vs = F.lds + ATT_VOFF;
    constexpr int ITERS = NK * 8 / NTHREADS;
    v4u kv[ITERS], vv[ITERS];
#pragma unroll
    for (int it = 0; it < ITERS; ++it) { const int idx = F.tid + it * NTHREADS, row = idx >> 3, ch = idx & 7, i = i0 + row; const bool ok = (i >= 0) && (i < Lsub);
        const bf16* src = proj + (size_t)(rowbase + r + d * (ok ? i : 0)) * INW + ch * 8;
        kv[it] = ok ? *(const v4u*)(src + kcol) : (v4u){0u, 0u, 0u, 0u}; vv[it] = ok ? *(const v4u*)(src + vcol) : (v4u){0u, 0u, 0u, 0u}; }
#pragma unroll
    for (int it = 0; it < ITERS; ++it) { const int idx = F.tid + it * NTHREADS, row = idx >> 3, ch = idx & 7;
        *(LAS v4u*)(Ks + row * 128 + ((ch ^ ((row >> 1) & 7)) << 4)) = kv[it];
        *(LAS v4u*)(Vs + row * 128 + ((ch ^ (((row >> 1) & 1) << 2)) << 4)) = vv[it]; }
}
template <int HALFW>
__device__ __forceinline__ void att_wave(Frame& F, const bf16* qptr  , float slope2, int kp0  , int Lsub,
                                         f32x16& o0, f32x16& o1, float& m_out, float& l_out) {
    constexpr int NTILE = 1 + 2 * HALFW / 32;
    const int lane = F.lane, ql = lane & 31, hh = lane >> 5, w = F.wave;
    LAS unsigned char* Ks = F.lds + ATT_KOFF; LAS unsigned char* Vs = F.lds + ATT_VOFF;
    bf16x8 qf[4];
#pragma unroll
    for (int ks = 0; ks < 4; ++ks) qf[ks] = *(const bf16x8*)(qptr + 16 * ks + 8 * hh);
    o0 = (f32x16){}; o1 = (f32x16){};
    float m = -1e30f, lsum = 0.f;
    const float C1 = 0.125f * LOG2E;
    const int i15 = lane & 15, G = (lane >> 4) & 1;
#pragma unroll 1
    for (int j = 0; j < NTILE; ++j) {
        const int rb = 32 * w + 32 * j;
        f32x16 s = (f32x16){};
        { const int row = rb + ql; const LAS unsigned char* kr = Ks + row * 128; const int sw = (row >> 1) & 7;
#pragma unroll
          for (int ks = 0; ks < 4; ++ks) { const bf16x8 kf = *(const LAS bf16x8*)(kr + (((2 * ks + hh) ^ sw) << 4)); s = __builtin_amdgcn_mfma_f32_32x32x16_bf16(kf, qf[ks], s, 0, 0, 0); } }
        float tmax = -INFINITY;
#pragma unroll
        for (int reg = 0; reg < 16; ++reg) { const int kl = (reg & 3) + 8 * (reg >> 2) + 4 * hh; const int rel = 32 * j - HALFW + kl - ql; const int kpos = kp0 + 32 * j + kl;
            const int ar = rel < 0 ? -rel : rel; const bool ok = (ar <= HALFW) && (kpos >= 0) && (kpos < Lsub);
            const float v = ok ? (s[reg] * C1 - slope2 * (float)ar) : -INFINITY; s[reg] = v; tmax = fmaxf(tmax, v); }
        tmax = fmaxf(tmax, __shfl_xor(tmax, 32));
        const float mnew = fmaxf(m, tmax); const float alpha = __builtin_amdgcn_exp2f(m - mnew); m = mnew;
        float psum = 0.f;
#pragma unroll
        for (int reg = 0; reg < 16; ++reg) { const float p = __builtin_amdgcn_exp2f(s[reg] - mnew); s[reg] = p; psum += p; }
        lsum = lsum * alpha + psum;
#pragma unroll
        for (int reg = 0; reg < 16; ++reg) { o0[reg] *= alpha; o1[reg] *= alpha; }
        bf16x8 pf[2];
#pragma unroll
        for (int st = 0; st < 2; ++st) { v4u t; t.x = pk2(s[8 * st + 0], s[8 * st + 1]); t.y = pk2(s[8 * st + 2], s[8 * st + 3]); t.z = pk2(s[8 * st + 4], s[8 * st + 5]); t.w = pk2(s[8 * st + 6], s[8 * st + 7]); pf[st] = __builtin_bit_cast(bf16x8, t); }
#pragma unroll
        for (int dt = 0; dt < 2; ++dt)
#pragma unroll
            for (int st = 0; st < 2; ++st) {
                const int row = rb + 16 * st + 4 * hh + (i15 >> 2);
                const int chunk = 4 * dt + 2 * G + ((i15 & 3) >> 1), sub = (i15 & 1) * 8;
                const LAS unsigned char* a0 = Vs + row * 128 + ((chunk ^ (((row >> 1) & 1) << 2)) << 4) + sub;
                const LAS unsigned char* a1 = Vs + (row + 8) * 128 + ((chunk ^ ((((row + 8) >> 1) & 1) << 2)) << 4) + sub;
                const s16x4 lo = __builtin_bit_cast(s16x4, __builtin_amdgcn_ds_read_tr16_b64_v4i16((LAS s16x4*)a0));
                const s16x4 hi = __builtin_bit_cast(s16x4, __builtin_amdgcn_ds_read_tr16_b64_v4i16((LAS s16x4*)a1));
                const bf16x8 vf = (bf16x8){lo[0], lo[1], lo[2], lo[3], hi[0], hi[1], hi[2], hi[3]};
                if (dt == 0) o0 = __builtin_amdgcn_mfma_f32_32x32x16_bf16(vf, pf[st], o0, 0, 0, 0);
                else o1 = __builtin_amdgcn_mfma_f32_32x32x16_bf16(vf, pf[st], o1, 0, 0, 0);
            }
    }
    lsum += __shfl_xor(lsum, 32);
    m_out = m; l_out = lsum;
}
__device__ __forceinline__ void att_store(bf16* orow, const f32x16& o0, const f32x16& o1, float scale, int hh) {
#pragma unroll
    for (int g = 0; g < 4; ++g) { v2u a; a.x = pk2(o0[4 * g] * scale, o0[4 * g + 1] * scale); a.y = pk2(o0[4 * g + 2] * scale, o0[4 * g + 3] * scale); *(v2u*)(orow + 8 * g + 4 * hh) = a;
        v2u b; b.x = pk2(o1[4 * g] * scale, o1[4 * g + 1] * scale); b.y = pk2(o1[4 * g + 2] * scale, o1[4 * g + 3] * scale); *(v2u*)(orow + 32 + 8 * g + 4 * hh) = b; }
}
__device__ __forceinline__ void p2_attention(Frame& F) {
    const bf16* proj = (const bf16*)(F.ws + WS_PROJ);
    bf16* OB = (bf16*)(F.ws + WS_XN);
    unsigned char* outb = (unsigned char*)F.out;
    constexpr int NB_UNITS = 768, NA_UNITS = 4608;
    const int ql = F.lane & 31, hh = F.lane >> 5;
    for (int uidx = F.vcu; uidx < NB_UNITS + NA_UNITS; uidx += F.G) {
        if (uidx < NB_UNITS) {
            const int gb = uidx / 8, kvh = (uidx >> 1) & 3, qp = uidx & 1;
            const int rowbase = gb < 64 ? (gb >> 4) * 4096 : NPROMPT; const int L = gb < 64 ? 4096 : 8192; const int sb = gb < 64 ? (gb & 15) : (gb - 64);
            const int i0 = 256 * sb - 128;
            __syncthreads();
            att_stage<512>(F, proj, rowbase, 0, 1, i0, L, 4096 + kvh * 64, 4352 + kvh * 64);
            __syncthreads();
#pragma unroll 1
            for (int q2 = 0; q2 < 2; ++q2) {
                const int hq = kvh * 4 + qp * 2 + q2;
                const int tok = rowbase + 256 * sb + 32 * F.wave + ql;
                const float slope = exp2f(-0.5f * (float)(hq + 1));
                f32x16 o0, o1; float m, l;
                att_wave<128>(F, proj + (size_t)tok * INW + 3072 + hq * 64, slope * LOG2E, i0 + 32 * F.wave, L, o0, o1, m, l);
                const float sk2 = F.sink[hq] * LOG2E; const float mf = fmaxf(m, sk2);
                const float sc = __builtin_amdgcn_exp2f(m - mf); const float den = l * sc + __builtin_amdgcn_exp2f(sk2 - mf);
                att_store(OB + (size_t)tok * 1024 + hq * 64, o0, o1, sc / den, hh);
            }
        } else {
            const int a = uidx - NB_UNITS; const int p = a / 1536, rem = a % 1536, head = rem / 96, gb = rem % 96;
            const int d = p == 0 ? 1 : (p == 1 ? 4 : 16);
            const int rowbase = gb < 64 ? (gb >> 4) * 4096 : NPROMPT; const int L = gb < 64 ? 4096 : 8192; const int idx = gb < 64 ? (gb & 15) : (gb - 64);
            const int r = idx % d, sb = idx / d, Lsub = L / d, i0 = 256 * sb - 64;
            __syncthreads();
            att_stage<384>(F, proj, rowbase, r, d, i0, Lsub, 1024 + head * 64, 2048 + head * 64);
            __syncthreads();
            const int tok = rowbase + r + d * (256 * sb + 32 * F.wave + ql);
            const float slope = exp2f(-0.25f * (float)(2 * head + 1));
            f32x16 o0, o1; float m, l;
            att_wave<64>(F, proj + (size_t)tok * INW + head * 64, slope * (float)d * LOG2E, i0 + 32 * F.wave, Lsub, o0, o1, m, l);
            bf16* OA = (bf16*)(outb + OUT_OA + (size_t)p * OUT_OA_STRIDE);
            float* LSE = (float*)(outb + OUT_LSE + (size_t)p * OUT_LSE_STRIDE);
            att_store(OA + (size_t)tok * 1024 + head * 64, o0, o1, 1.0f / l, hh);
            if (hh == 0) LSE[(size_t)tok * 16 + head] = m + __builtin_amdgcn_logf(l);
        }
    }
    __syncthreads();
}

__device__ __forceinline__ void p3_finalize(Frame& F) {
    const int gw = F.vcu * NWAVES + F.wave, NGW = F.G * NWAVES, lane = F.lane;
    const unsigned char* outb = (const unsigned char*)F.out;
    const bf16* OB = (const bf16*)(F.ws + WS_XN);
    bf16* MIXED = (bf16*)(F.ws + WS_MIXED);
    const int head = lane >> 2;
    for (int t = gw; t < NT_TOK; t += NGW) {
        float ls[3]; v4u oa[3][2];
#pragma unroll
        for (int p = 0; p < 3; ++p) { ls[p] = ((const float*)(outb + OUT_LSE + (size_t)p * OUT_LSE_STRIDE))[(size_t)t * 16 + head];
            const v4u* src = (const v4u*)((const bf16*)(outb + OUT_OA + (size_t)p * OUT_OA_STRIDE) + (size_t)t * 1024 + 16 * lane); oa[p][0] = src[0]; oa[p][1] = src[1]; }
        const v4u* sb = (const v4u*)(OB + (size_t)t * 1024 + 16 * lane); const v4u ob0 = sb[0], ob1 = sb[1];
        const float mx = fmaxf(fmaxf(ls[0], ls[1]), ls[2]);
        float w0 = __builtin_amdgcn_exp2f(ls[0] - mx), w1 = __builtin_amdgcn_exp2f(ls[1] - mx), w2 = __builtin_amdgcn_exp2f(ls[2] - mx);
        const float inv = 1.0f / (w0 + w1 + w2); w0 *= inv; w1 *= inv; w2 *= inv;
        float a[16], b[16]; float sa = 0.f, sbq = 0.f;
#pragma unroll
        for (int q = 0; q < 2; ++q)
#pragma unroll
            for (int e = 0; e < 4; ++e) {
                const unsigned x0 = oa[0][q][e], x1 = oa[1][q][e], x2 = oa[2][q][e], y = (q == 0 ? ob0 : ob1)[e];
                const float lo = w0 * bflo(x0) + w1 * bflo(x1) + w2 * bflo(x2), hi = w0 * bfhi(x0) + w1 * bfhi(x1) + w2 * bfhi(x2);
                a[q * 8 + e * 2] = lo; a[q * 8 + e * 2 + 1] = hi; sa += lo * lo + hi * hi;
                const float bl = bflo(y), bh = bfhi(y); b[q * 8 + e * 2] = bl; b[q * 8 + e * 2 + 1] = bh; sbq += bl * bl + bh * bh; }
        const float ra = 1.0f / sqrtf(wave_sum(sa) * (1.0f / 1024.0f) + RMS_EPS), rb = 1.0f / sqrtf(wave_sum(sbq) * (1.0f / 1024.0f) + RMS_EPS);
        v4u o[2], o2[2];
#pragma unroll
        for (int q = 0; q < 2; ++q) {
            const f32x4 ga0 = *(const f32x4*)(F.a_out_g + 16 * lane + 8 * q), ga1 = *(const f32x4*)(F.a_out_g + 16 * lane + 8 * q + 4);
            const f32x4 gb0 = *(const f32x4*)(F.b_out_g + 16 * lane + 8 * q), gb1 = *(const f32x4*)(F.b_out_g + 16 * lane + 8 * q + 4);
            o[q].x = pk2(a[8 * q + 0] * ra * ga0[0], a[8 * q + 1] * ra * ga0[1]); o[q].y = pk2(a[8 * q + 2] * ra * ga0[2], a[8 * q + 3] * ra * ga0[3]);
            o[q].z = pk2(a[8 * q + 4] * ra * ga1[0], a[8 * q + 5] * ra * ga1[1]); o[q].w = pk2(a[8 * q + 6] * ra * ga1[2], a[8 * q + 7] * ra * ga1[3]);
            o2[q].x = pk2(b[8 * q + 0] * rb * gb0[0], b[8 * q + 1] * rb * gb0[1]); o2[q].y = pk2(b[8 * q + 2] * rb * gb0[2], b[8 * q + 3] * rb * gb0[3]);
            o2[q].z = pk2(b[8 * q + 4] * rb * gb1[0], b[8 * q + 5] * rb * gb1[1]); o2[q].w = pk2(b[8 * q + 6] * rb * gb1[2], b[8 * q + 7] * rb * gb1[3]); }
        v4u* dst = (v4u*)(MIXED + (size_t)t * DM + 16 * lane); dst[0] = o[0]; dst[1] = o[1];
        v4u* dst2 = (v4u*)(MIXED + (size_t)t * DM + 1024 + 16 * lane); dst2[0] = o2[0]; dst2[1] = o2[1];
    }
}

__device__ __forceinline__ int f2key(float v) { const int b = __builtin_bit_cast(int, v); return b ^ ((b >> 31) & 0x7fffffff); }
__device__ __forceinline__ float key2f(int k) { return __builtin_bit_cast(float, k ^ ((k >> 31) & 0x7fffffff)); }
__device__ __forceinline__ void p6_route(Frame& F) {
    const int gw = F.vcu * NWAVES + F.wave, NGW = F.G * NWAVES, lane = F.lane, ql = lane & 31, hh = lane >> 5;
    const bf16* Q = (const bf16*)(F.ws + WS_MIXED);
    const bf16* SK = (const bf16*)(F.ws + WS_SK);
    int* RE = (int*)(F.ws + WS_RE); float* RG = (float*)(F.ws + WS_RG);
    constexpr int INT_MINV = -2147483647 - 1;
#pragma unroll 1
    for (int task = gw; task < 768 * 8; task += NGW) {
        const int h = task / 768, tile = task % 768, tok = tile * 32 + ql;
        int k1[2][16];
#pragma unroll
        for (int p = 0; p < 2; ++p) {
            const bf16* qrow = Q + (size_t)tok * DM + h * 256 + p * 128 + 8 * hh;
            const bf16* skb = SK + (size_t)(h * 2 + p) * 128 * 128 + (size_t)ql * 128 + 8 * hh;
            bf16x8 qf[8];
#pragma unroll
            for (int ks = 0; ks < 8; ++ks) qf[ks] = *(const bf16x8*)(qrow + 16 * ks);
            int sc[64];
#pragma unroll
            for (int kt = 0; kt < 4; ++kt) { f32x16 s = (f32x16){};
#pragma unroll
                for (int ks = 0; ks < 8; ++ks) { const bf16x8 kf = *(const bf16x8*)(skb + (size_t)kt * 32 * 128 + 16 * ks); s = __builtin_amdgcn_mfma_f32_32x32x16_bf16(kf, qf[ks], s, 0, 0, 0); }
#pragma unroll
                for (int reg = 0; reg < 16; ++reg) { const int n = 32 * kt + (reg & 3) + 8 * (reg >> 2) + 4 * hh; sc[kt * 16 + reg] = (f2key(s[reg]) & ~127) | n; } }
#pragma unroll
            for (int rnd = 0; rnd < 16; ++rnd) {
                int mx = sc[0];
#pragma unroll
                for (int i = 1; i < 64; ++i) mx = max(mx, sc[i]);
                const int other = __shfl_xor(mx, 32); const int wv = max(mx, other);
                k1[p][rnd] = wv;
#pragma unroll
                for (int i = 0; i < 64; ++i) sc[i] = (sc[i] == wv) ? INT_MINV : sc[i];
            }
        }
        float v1[16], v2[16]; int i1[16], i2[16];
#pragma unroll
        for (int i = 0; i < 16; ++i) { v1[i] = key2f(k1[0][i] & ~127); i1[i] = k1[0][i] & 127; v2[i] = key2f(k1[1][i] & ~127); i2[i] = k1[1][i] & 127; }
        int ck[25], ce[25];
#define P6_CAND(k, Ia, Ja, Ib, Jb) do { const float sa_ = v1[Ia] + v2[Ja], sb_ = v1[Ib] + v2[Jb]; const int ea_ = i1[Ia] * 128 + i2[Ja], eb_ = i1[Ib] * 128 + i2[Jb]; \
            ck[k] = (f2key(hh ? sb_ : sa_) & ~63) | (2 * (k) + hh); ce[k] = hh ? eb_ : ea_; } while (0)
        P6_CAND(0, 0, 0, 0, 1);
        P6_CAND(1, 0, 2, 0, 3);
        P6_CAND(2, 0, 4, 0, 5);
        P6_CAND(3, 0, 6, 0, 7);
        P6_CAND(4, 0, 8, 0, 9);
        P6_CAND(5, 0, 10, 0, 11);
        P6_CAND(6, 0, 12, 0, 13);
        P6_CAND(7, 0, 14, 0, 15);
        P6_CAND(8, 1, 0, 1, 1);
        P6_CAND(9, 1, 2, 1, 3);
        P6_CAND(10, 1, 4, 1, 5);
        P6_CAND(11, 1, 6, 1, 7);
        P6_CAND(12, 2, 0, 2, 1);
        P6_CAND(13, 2, 2, 2, 3);
        P6_CAND(14, 2, 4, 3, 0);
        P6_CAND(15, 3, 1, 3, 2);
        P6_CAND(16, 3, 3, 4, 0);
        P6_CAND(17, 4, 1, 4, 2);
        P6_CAND(18, 5, 0, 5, 1);
        P6_CAND(19, 6, 0, 6, 1);
        P6_CAND(20, 7, 0, 7, 1);
        P6_CAND(21, 8, 0, 9, 0);
        P6_CAND(22, 10, 0, 11, 0);
        P6_CAND(23, 12, 0, 13, 0);
        P6_CAND(24, 14, 0, 15, 0);
#undef P6_CAND
        float top[16]; int eid[16];
#pragma unroll
        for (int rnd = 0; rnd < 16; ++rnd) {
            int mx = ck[0];
#pragma unroll
            for (int i = 1; i < 25; ++i) mx = max(mx, ck[i]);
            const int other = __shfl_xor(mx, 32); const int wv = max(mx, other);
            int es = 0;
#pragma unroll
            for (int i = 0; i < 25; ++i) { const bool hit = (ck[i] == wv); es = hit ? ce[i] : es; ck[i] = hit ? INT_MINV : ck[i]; }
            const int eo = __shfl_xor(es, 32);
            eid[rnd] = (mx == wv) ? es : eo; top[rnd] = key2f(wv & ~63);
        }
        float gs = 0.f; float g[16];
#pragma unroll
        for (int i = 0; i < 16; ++i) { g[i] = __expf(top[i] - top[0]); gs += g[i]; }
        const float ginv = 1.0f / gs;
        if (hh == 0) {
            int* re = RE + ((size_t)tok * 8 + h) * 16; float* rg = RG + ((size_t)tok * 8 + h) * 16;
#pragma unroll
            for (int i = 0; i < 16; i += 4) { *(int4*)(re + i) = make_int4(eid[i], eid[i + 1], eid[i + 2], eid[i + 3]);
                *(f32x4*)(rg + i) = (f32x4){g[i] * ginv, g[i + 1] * ginv, g[i + 2] * ginv, g[i + 3] * ginv}; }
        }
    }
}

__device__ __forceinline__ void p7_experts(Frame& F) {
    const int gw = F.vcu * NWAVES + F.wave, NGW = F.G * NWAVES, lane = F.lane;
    const bf16* U = (const bf16*)(F.ws + WS_U); const bf16* V = (const bf16*)(F.ws + WS_V);
    const int* RE = (const int*)(F.ws + WS_RE); const float* RG = (const float*)(F.ws + WS_RG);
    const float* SS = (const float*)(F.ws + WS_SS);
    f32x4 gf[4][2];
#pragma unroll
    for (int j = 0; j < 4; ++j) { gf[j][0] = *(const f32x4*)(F.normf_g + 512 * j + 8 * lane); gf[j][1] = *(const f32x4*)(F.normf_g + 512 * j + 8 * lane + 4); }
#pragma unroll 1
    for (int t = gw; t < NT_TOK; t += NGW) {
        float* xrow = F.out + (size_t)t * DM;
        float x[32];
#pragma unroll
        for (int j = 0; j < 4; ++j) { const f32x4 a = *(const f32x4*)(xrow + 512 * j + 8 * lane), b = *(const f32x4*)(xrow + 512 * j + 8 * lane + 4);
            x[8 * j + 0] = a[0]; x[8 * j + 1] = a[1]; x[8 * j + 2] = a[2]; x[8 * j + 3] = a[3]; x[8 * j + 4] = b[0]; x[8 * j + 5] = b[1]; x[8 * j + 6] = b[2]; x[8 * j + 7] = b[3]; }
        float rstd;
        { const float sp = (lane < 32) ? SS[(size_t)t * 32 + lane] : 0.f; rstd = 1.0f / sqrtf(wave_sum(sp) * (1.0f / DM) + RMS_EPS); }
        const int e_a = RE[(size_t)t * 128 + lane], e_b = RE[(size_t)t * 128 + 64 + lane];
        const float g_a = RG[(size_t)t * 128 + lane], g_b = RG[(size_t)t * 128 + 64 + lane];
        float dot_a = 0.f, dot_b = 0.f;
#pragma unroll 1
        for (int pb = 0; pb < 128; pb += 4) {
            float part[4];
#pragma unroll
            for (int q = 0; q < 4; ++q) {
                const int pi = pb + q; const int e = __builtin_amdgcn_readlane(pi < 64 ? e_a : e_b, pi & 63);
                const bf16* ur = U + (size_t)e * DM + 8 * lane; float s = 0.f;
#pragma unroll
                for (int j = 0; j < 4; ++j) { const v4u w = *(const v4u*)(ur + 512 * j);
                    s += x[8 * j + 0] * bflo(w.x) + x[8 * j + 1] * bfhi(w.x) + x[8 * j + 2] * bflo(w.y) + x[8 * j + 3] * bfhi(w.y)
                       + x[8 * j + 4] * bflo(w.z) + x[8 * j + 5] * bfhi(w.z) + x[8 * j + 6] * bflo(w.w) + x[8 * j + 7] * bfhi(w.w); }
                part[q] = s; }
#pragma unroll
            for (int q = 0; q < 4; ++q) { const float tot = wave_sum(part[q]); const int pi = pb + q;
                if (pi < 64) { if (lane == pi) dot_a = tot; } else { if (lane == pi - 64) dot_b = tot; } }
        }
        float c_a, c_b;
        { const float za = dot_a * rstd, zb = dot_b * rstd;
          c_a = g_a * 0.5f * za * (1.0f + erff(za * 0.70710678118654752f)); c_b = g_b * 0.5f * zb * (1.0f + erff(zb * 0.70710678118654752f)); }
        float acc[32];
#pragma unroll
        for (int i = 0; i < 32; ++i) acc[i] = 0.f;
#pragma unroll 1
        for (int pb = 0; pb < 128; pb += 4) {
#pragma unroll
            for (int q = 0; q < 4; ++q) {
                const int pi = pb + q; const int e = __builtin_amdgcn_readlane(pi < 64 ? e_a : e_b, pi & 63);
                const float c = __builtin_bit_cast(float, __builtin_amdgcn_readlane(__builtin_bit_cast(int, pi < 64 ? c_a : c_b), pi & 63));
                const bf16* vr = V + (size_t)e * DM + 8 * lane;
#pragma unroll
                for (int j = 0; j < 4; ++j) { const v4u w = *(const v4u*)(vr + 512 * j);
                    acc[8 * j + 0] += c * bflo(w.x); acc[8 * j + 1] += c * bfhi(w.x); acc[8 * j + 2] += c * bflo(w.y); acc[8 * j + 3] += c * bfhi(w.y);
                    acc[8 * j + 4] += c * bflo(w.z); acc[8 * j + 5] += c * bfhi(w.z); acc[8 * j + 6] += c * bflo(w.w); acc[8 * j + 7] += c * bfhi(w.w); } }
        }
        float s3 = 0.f;
#pragma unroll
        for (int i = 0; i < 32; ++i) { x[i] += acc[i]; s3 += x[i] * x[i]; }
        const float r3 = 1.0f / sqrtf(wave_sum(s3) * (1.0f / DM) + RMS_EPS);
#pragma unroll
        for (int j = 0; j < 4; ++j) { const f32x4 a = (f32x4){x[8 * j + 0], x[8 * j + 1], x[8 * j + 2], x[8 * j + 3]} * r3 * gf[j][0], b = (f32x4){x[8 * j + 4], x[8 * j + 5], x[8 * j + 6], x[8 * j + 7]} * r3 * gf[j][1];
            *(f32x4*)(xrow + 512 * j + 8 * lane) = a; *(f32x4*)(xrow + 512 * j + 8 * lane + 4) = b; }
    }
}

__global__ void __launch_bounds__(NTHREADS, 2) hymba_fwd(Args args) {
    extern __shared__ __attribute__((aligned(16))) unsigned char lds[];
    Frame F;
    F.lds = (LAS unsigned char*)lds; F.lds_g = lds;
    F.tid = threadIdx.x; F.lane = F.tid & 63; F.wave = __builtin_amdgcn_readfirstlane(F.tid >> 6);
    F.G = gridDim.x; { const int bx = blockIdx.x; F.vcu = (F.G % 8 == 0) ? (bx % 8) * (F.G / 8) + bx / 8 : bx; }
    F.xp = args.in[0]; F.xs = args.in[1]; F.norm1_g = args.in[2]; F.w_in = args.in[3]; F.a_out_g = args.in[4]; F.b_out_g = args.in[5]; F.sink = args.in[6];
    F.w_out = args.in[7]; F.norm2_g = args.in[8]; F.w_pq = args.in[9]; F.sub_keys = args.in[10]; F.expert_u = args.in[11]; F.expert_v = args.in[12]; F.normf_g = args.in[13];
    F.out = args.out; F.ws = args.ws;
    const int lo = args.ph_lo, hi = args.ph_hi;
#define IN(k) (lo <= (k) && (k) < hi)
#if MK_N_LAUNCHES == 1
#define GRID_BAR(k) do { if (IN(k) && IN((k) + 1)) { cg::this_grid().sync(); } } while (0)
#else
#define GRID_BAR(k) do { } while (0)
#endif
    if (IN(0)) { p0_prep(F); GRID_BAR(0); }
    if (IN(1)) {
        pg8::Gemm g{(const bf16*)(F.ws + WS_XN), (const bf16*)(F.ws + WS_WIN), NT_TOK, INW, DM}; pg8::StaticOrder S; S.init(NT_TOK, INW, F.G, (int)blockIdx.x);
        pg8::EpiBf16 E{(bf16*)(F.ws + WS_PROJ), INW, nullptr};
        pg8::gemm_phase<pg8::EpiBf16, pg8::StaticOrder, true, true>(F.lds, g, S, E);
        GRID_BAR(1);
    }
    if (IN(2)) { p2_attention(F); GRID_BAR(2); }
    if (IN(3)) { p3_finalize(F); GRID_BAR(3); }
    if (IN(4)) {
        pg8::Gemm g{(const bf16*)(F.ws + WS_MIXED), (const bf16*)(F.ws + WS_WOUT), NT_TOK, DM, DM}; pg8::StaticOrder S; S.init(NT_TOK, DM, F.G, (int)blockIdx.x);
        pg8::EpiResid E{F.xp, F.xs, F.out, (bf16*)(F.ws + WS_X2B), (float*)(F.ws + WS_SS)};
        pg8::gemm_phase<pg8::EpiResid, pg8::StaticOrder, true, true>(F.lds, g, S, E);
        GRID_BAR(4);
    }
    if (IN(5)) {
        pg8::Gemm g{(const bf16*)(F.ws + WS_X2B), (const bf16*)(F.ws + WS_WPQ), NT_TOK, DM, DM}; pg8::StaticOrder S; S.init(NT_TOK, DM, F.G, (int)blockIdx.x);
        pg8::EpiBf16 E{(bf16*)(F.ws + WS_MIXED), DM, (const float*)(F.ws + WS_SS)};
        pg8::gemm_phase<pg8::EpiBf16, pg8::StaticOrder, true, true>(F.lds, g, S, E);
        GRID_BAR(5);
    }
    if (IN(6)) { p6_route(F); GRID_BAR(6); }
    if (IN(7)) { p7_experts(F); }
#undef IN
#undef GRID_BAR
}

extern "C" void kernel_launch(void* const* d_in, const int* in_sizes, int n_in, void* d_out, int out_size, void* d_ws, size_t ws_size, hipStream_t stream) {
    static int grid = 0;
    if (grid == 0) {
        if (n_in != 14 || out_size != NT_TOK * DM || ws_size < WS_END) { fprintf(stderr, "kernel_launch: unexpected shapes (n_in %d out %d ws %zu)\n", n_in, out_size, ws_size); grid = -1; return; }
        int dev = 0, cus = 0, per_cu = 0;
        (void)hipGetDevice(&dev); (void)hipDeviceGetAttribute(&cus, hipDeviceAttributeMultiprocessorCount, dev);
        (void)hipFuncSetAttribute((const void*)hymba_fwd, hipFuncAttributeMaxDynamicSharedMemorySize, LDS_BYTES);
        (void)hipOccupancyMaxActiveBlocksPerMultiprocessor(&per_cu, (const void*)hymba_fwd, NTHREADS, LDS_BYTES);
        if (per_cu < 1) { fprintf(stderr, "kernel_launch: occupancy query says %d blocks per CU\n", per_cu); per_cu = 1; }
        (void)hipGetLastError();
        grid = cus;
    }
    if (grid < 0) return;
    Args a{};
    for (int i = 0; i < 14; ++i) a.in[i] = (const float*)d_in[i];
    a.out = (float*)d_out; a.ws = (unsigned char*)d_ws;
#if MK_N_LAUNCHES == 1
    a.ph_lo = 0; a.ph_hi = 8;
    void* kargs[] = {&a};
    hipError_t e = hipLaunchCooperativeKernel((const void*)hymba_fwd, dim3(grid), dim3(NTHREADS), kargs, LDS_BYTES, stream);
    if (e != hipSuccess) fprintf(stderr, "cooperative launch failed: %s (grid %d)\n", hipGetErrorString(e), grid);
#else
    for (int ph = 0; ph < 8; ++ph) { a.ph_lo = ph; a.ph_hi = ph + 1; hipLaunchKernelGGL(hymba_fwd, dim3(grid), dim3(NTHREADS), LDS_BYTES, stream, a); }
#endif
}
```

```cpp
#include <hip/hip_runtime.h>
#include <hip/hip_cooperative_groups.h>
#include <cstdio>
#include <cstdint>
namespace cg = cooperative_groups;

#ifndef PROBE_REP
#define PROBE_REP -1
#endif
#ifndef P4_I8
#define P4_I8 0
#endif
#ifndef P1_I8
#define P1_I8 1
#endif
#ifndef P5_I8
#define P5_I8 2
#endif
#ifndef P7A_INV
#define P7A_INV 1
#endif
#ifndef P7A_X2Q
#define P7A_X2Q 1
#endif
#ifndef MK_N_LAUNCHES
#define MK_N_LAUNCHES 1
#endif

__device__ __forceinline__ int fresh_lane() { int l; asm volatile("v_mbcnt_lo_u32_b32 %0, -1, 0\n\tv_mbcnt_hi_u32_b32 %0, -1, %0" : "=v"(l)); return l; }
namespace pg8 {
#define PG8_LAS __attribute__((address_space(3)))
typedef unsigned short bf16_t;
typedef short bf16x8 __attribute__((ext_vector_type(8)));
typedef float f32x4 __attribute__((ext_vector_type(4)));
typedef unsigned u32x4 __attribute__((ext_vector_type(4)));
typedef unsigned u32x2 __attribute__((ext_vector_type(2)));
typedef int i32x4 __attribute__((ext_vector_type(4)));
template <bool I8> struct AccT { typedef f32x4 type; };
template <> struct AccT<true> { typedef i32x4 type; };
template <bool I8> __device__ __forceinline__ typename AccT<I8>::type mma16(bf16x8 b, bf16x8 a, typename AccT<I8>::type c) {
    if constexpr (I8) return __builtin_amdgcn_mfma_i32_16x16x64_i8(__builtin_bit_cast(i32x4, b), __builtin_bit_cast(i32x4, a), c, 0, 0, 0);
    else return __builtin_amdgcn_mfma_f32_16x16x32_bf16(b, a, c, 0, 0, 0);
}
constexpr int BM = 256, BK = 64, HALF = 128, HTB = HALF * BK * 2, STAGE_BYTES = 8 * HTB, NXCD = 8, WGM = 8;

__host__ __device__ __forceinline__ int lds_byte(int r, int c) { const int st = (r >> 4) * 2 + (c >> 5), rr = r & 15, cc = c & 31, ob = rr * 64 + cc * 2; return st * 1024 + (ob ^ (((ob >> 9) & 1) << 5)); }
__host__ __device__ __forceinline__ void stage_rc(int b, int& R, int& C) { const int st = b / 1024, sb = b % 1024, swz = sb ^ (((sb >> 9) & 1) << 5); R = (st >> 1) * 16 + swz / 64; C = (st & 1) * 32 + (swz % 64) / 2; }
__host__ __device__ __forceinline__ int perm32(int rho) { const int n = rho >> 4, i = rho & 15; return 8 * (i >> 2) + 4 * n + (i & 3); }

struct Unit { int pm, pn; };
struct Gemm { const bf16_t* A; const bf16_t* Bt; int M, N, K; };

struct StaticOrder {
    int nM, nN, nwg, G, c;
    __host__ __device__ void init(int M, int N, int G_, int c_) { nM = M / BM; nN = N / BM; nwg = nM * nN; G = G_; c = c_; }
    __host__ __device__ bool next(int i, Unit& u) const {
        const long L = (long)i * G + c; if (L >= nwg) return false;
        int wgid = (int)L; { const int q = nwg / NXCD, r = nwg % NXCD, xcd = wgid % NXCD, off = wgid / NXCD; wgid = (xcd < r ? xcd * (q + 1) : r * (q + 1) + (xcd - r) * q) + off; }
        const int nig = WGM * nN, gid = wgid / nig, fm = gid * WGM, gsz = (nM - fm) < WGM ? (nM - fm) : WGM;
        u.pm = fm + ((wgid % nig) % gsz); u.pn = (wgid % nig) / gsz; return true;
    }
    __device__ __forceinline__ void a_ready(const Unit&) const {}
    __device__ __forceinline__ void done(const Unit&) const {}
};

struct OneUnit { Unit u;
    __device__ __forceinline__ bool next(int i, Unit& o) const { if (i != 0) return false; o = u; return true; }
    __device__ __forceinline__ void a_ready(const Unit&) const {}
    __device__ __forceinline__ void done(const Unit&) const {}
};

__device__ __forceinline__ unsigned cvt_pk_bf16(float lo, float hi) { unsigned r; asm volatile("v_cvt_pk_bf16_f32 %0, %1, %2" : "=v"(r) : "v"(lo), "v"(hi)); return r; }

struct EpiBf16 {
    static constexpr bool PERM = true, AFTER_DRAIN = false, I8 = false;
    bf16_t* O; int ldc; const float* ss;
    float qscale;
    __device__ __forceinline__ void operator()(const f32x4 (&acc)[2][2][4][2], const Unit& u, int wr, int wc, int fr, int fq) const {
        const int row0 = u.pm * BM + wr * 64 + fr; const int col0 = u.pn * BM + wc * 32 + 8 * fq;
#pragma unroll
        for (int ai = 0; ai < 2; ++ai)
#pragma unroll
            for (int m = 0; m < 4; ++m) {
                const int r = row0 + ai * HALF + m * 16;
                float sc = (qscale != 0.f && (u.pn < 4 || (u.pn >= 12 && u.pn < 16))) ? qscale : 1.f;
                if (ss) { const f32x4* p = (const f32x4*)(ss + (size_t)r * 32); float s = 0.f;
#pragma unroll
                    for (int i = 0; i < 8; ++i) { const f32x4 v = p[i]; s += (v[0] + v[1]) + (v[2] + v[3]); }
                    sc *= 1.0f / sqrtf(s * (1.0f / 2048.0f) + 1e-6f); }
                bf16_t* rowp = O + (size_t)r * ldc + col0;
#pragma unroll
                for (int bj = 0; bj < 2; ++bj) { const f32x4 v0 = acc[ai][bj][m][0] * sc, v1 = acc[ai][bj][m][1] * sc;
                    u32x4 w; w.x = cvt_pk_bf16(v0[0], v0[1]); w.y = cvt_pk_bf16(v0[2], v0[3]); w.z = cvt_pk_bf16(v1[0], v1[1]); w.w = cvt_pk_bf16(v1[2], v1[3]);
                    *(u32x4*)(rowp + bj * HALF) = w; } }
    }
};
struct EpiBf16I8 {
    static constexpr bool PERM = true, AFTER_DRAIN = false, I8 = true;
    bf16_t* O; int ldc; const float* sa; const float* sw; float qscale;
    __device__ __forceinline__ void operator()(const i32x4 (&acc)[2][2][4][2], const Unit& u, int wr, int wc, int fr, int fq) const {
        const int row0 = u.pm * BM + wr * 64 + fr; const int col0 = u.pn * BM + wc * 32 + 8 * fq;
        f32x4 w0[2], w1[2]; float sav[8];
#pragma unroll
        for (int bj = 0; bj < 2; ++bj) { w0[bj] = *(const f32x4*)(sw + col0 + bj * HALF); w1[bj] = *(const f32x4*)(sw + col0 + bj * HALF + 4); }
#pragma unroll
        for (int i = 0; i < 8; ++i) sav[i] = sa[row0 + (i >> 2) * HALF + (i & 3) * 16];
#pragma unroll
        for (int ai = 0; ai < 2; ++ai)
#pragma unroll
            for (int m = 0; m < 4; ++m) {
                const int r = row0 + ai * HALF + m * 16;
                float sc = sav[4 * ai + m]; if (qscale != 0.f && (u.pn < 4 || (u.pn >= 12 && u.pn < 16))) sc *= qscale;
                bf16_t* rowp = O + (size_t)r * ldc + col0;
#pragma unroll
                for (int bj = 0; bj < 2; ++bj) { const i32x4 a0 = acc[ai][bj][m][0], a1 = acc[ai][bj][m][1];
                    const f32x4 v0 = (f32x4){(float)a0[0], (float)a0[1], (float)a0[2], (float)a0[3]} * w0[bj] * sc, v1 = (f32x4){(float)a1[0], (float)a1[1], (float)a1[2], (float)a1[3]} * w1[bj] * sc;
                    u32x4 w; w.x = cvt_pk_bf16(v0[0], v0[1]); w.y = cvt_pk_bf16(v0[2], v0[3]); w.z = cvt_pk_bf16(v1[0], v1[1]); w.w = cvt_pk_bf16(v1[2], v1[3]);
                    *(u32x4*)(rowp + bj * HALF) = w; } }
    }
};
struct EpiResid {
    static constexpr bool PERM = true, AFTER_DRAIN = false, I8 = false, XQ = (P5_I8 == 2);
    const float* xp; const float* xs; float* out; bf16_t* xb; float* ss; unsigned char* xq; const float* sx;
    __device__ __forceinline__ void operator()(const f32x4 (&acc)[2][2][4][2], const Unit& u, int wr, int wc, int fr, int fq) const {
        const int row0 = u.pm * BM + wr * 64 + fr; const int col0 = u.pn * BM + wc * 32 + 8 * fq;
        f32x4 xv[3][4];
#define EPR_ROW(it) (row0 + ((it) >> 2) * HALF + ((it) & 3) * 16)
#define EPR_LOAD(buf, it) do { const int r_ = EPR_ROW(it); const float* xrow_ = (r_ < 16384) ? (xp + (size_t)r_ * 2048) : (xs + (size_t)(r_ - 16384) * 2048); \
            _Pragma("unroll") for (int q_ = 0; q_ < 4; ++q_) xv[buf][q_] = *(const f32x4*)(xrow_ + col0 + (q_ >> 1) * HALF + (q_ & 1) * 4); } while (0)
        float sxv[8];
#pragma unroll
        for (int i = 0; i < 8; ++i) sxv[i] = XQ ? sx[EPR_ROW(i)] : 1.0f;
        EPR_LOAD(0, 0); EPR_LOAD(1, 1);
#pragma unroll
        for (int it = 0; it < 8; ++it) {
            const int ai = it >> 2, m = it & 3, r = EPR_ROW(it);
            if (it + 2 < 8) EPR_LOAD((it + 2) % 3, it + 2);
            float s = 0.f; const float qi = XQ ? 1.0f / sxv[it] : 0.f;
#pragma unroll
            for (int bj = 0; bj < 2; ++bj) { const int c = col0 + bj * HALF;
                const f32x4 v0 = acc[ai][bj][m][0] + xv[it % 3][bj * 2], v1 = acc[ai][bj][m][1] + xv[it % 3][bj * 2 + 1];
                u32x4 w; w.x = cvt_pk_bf16(v0[0], v0[1]); w.y = cvt_pk_bf16(v0[2], v0[3]); w.z = cvt_pk_bf16(v1[0], v1[1]); w.w = cvt_pk_bf16(v1[2], v1[3]);
                *(u32x4*)(xb + (size_t)r * 2048 + c) = w;
                if (XQ) { u32x2 p; p.x = 0; p.y = 0;
#pragma unroll
                    for (int e = 0; e < 4; ++e) { p.x |= ((unsigned)(int)__builtin_rintf(fminf(fmaxf(v0[e] * qi, -127.0f), 127.0f)) & 0xffu) << (8 * e); p.y |= ((unsigned)(int)__builtin_rintf(fminf(fmaxf(v1[e] * qi, -127.0f), 127.0f)) & 0xffu) << (8 * e); }
                    *(u32x2*)(xq + (size_t)r * 2048 + c) = p; }
                s += ((v0[0] * v0[0] + v0[1] * v0[1]) + (v0[2] * v0[2] + v0[3] * v0[3])) + ((v1[0] * v1[0] + v1[1] * v1[1]) + (v1[2] * v1[2] + v1[3] * v1[3])); }
            s += __shfl_xor(s, 16); s += __shfl_xor(s, 32);
            if (fq == 0) ss[(size_t)r * 32 + u.pn * 4 + wc] = s;
            asm volatile("" ::: "memory"); }
#undef EPR_LOAD
#undef EPR_ROW
    }
};

struct EpiResidI8 {
    static constexpr bool PERM = false, AFTER_DRAIN = false, I8 = true;
    const float* xp; const float* xs; bf16_t* xb; float* ss; const float* sa; const float* sw;
    __device__ __forceinline__ void operator()(const i32x4 (&acc)[2][2][4][2], const Unit& u, int wr, int wc, int fr, int fq) const {
        const int row0 = u.pm * BM + wr * 64 + fr; const int col0 = u.pn * BM + wc * 32 + 4 * fq;
        f32x4 swv[2][2];
#pragma unroll
        for (int bj = 0; bj < 2; ++bj)
#pragma unroll
            for (int n = 0; n < 2; ++n) swv[bj][n] = *(const f32x4*)(sw + col0 + bj * HALF + n * 16);
#pragma unroll
        for (int ai = 0; ai < 2; ++ai)
#pragma unroll
            for (int m = 0; m < 4; ++m) {
                const int r = row0 + ai * HALF + m * 16;
                const float* xrow = (r < 16384) ? (xp + (size_t)r * 2048) : (xs + (size_t)(r - 16384) * 2048);
                const float sar = sa[r];
                float s = 0.f;
#pragma unroll
                for (int bj = 0; bj < 2; ++bj)
#pragma unroll
                    for (int n = 0; n < 2; ++n) { const int c = col0 + bj * HALF + n * 16;
                        const i32x4 a = acc[ai][bj][m][n];
                        const f32x4 v = (f32x4){(float)a[0], (float)a[1], (float)a[2], (float)a[3]} * sar * swv[bj][n] + *(const f32x4*)(xrow + c);
                        u32x2 w; w.x = cvt_pk_bf16(v[0], v[1]); w.y = cvt_pk_bf16(v[2], v[3]);
                        *(u32x2*)(xb + (size_t)r * 2048 + c) = w;
                        s += (v[0] * v[0] + v[1] * v[1]) + (v[2] * v[2] + v[3] * v[3]); }
                s += __shfl_xor(s, 16); s += __shfl_xor(s, 32);
                if (fq == 0) ss[(size_t)r * 32 + u.pn * 4 + wc] = s;
                asm volatile("" ::: "memory"); }
    }
};

template <class Epi, class Sched, bool ALIGN_EPI = false, bool SP2 = false>
__device__ __forceinline__ void gemm_phase(PG8_LAS unsigned char* lds, const Gemm g, const Sched& S, const Epi& E, int wid  ) {
    const int lane = fresh_lane(), tid = wid * 64 + lane, wr = wid >> 2, wc = wid & 3, fr = lane & 15, fq = lane >> 4;
    const int K = g.K, nt = K / BK;
    unsigned voffA[2], voffB[2];
#pragma unroll
    for (int i = 0; i < 2; ++i) { int R, C; stage_rc(tid * 16 + i * 8192, R, C); const int Rb = Epi::PERM ? ((R & ~31) + perm32(R & 31)) : R;
        voffA[i] = (unsigned)(R * K + C) * 2u; voffB[i] = (unsigned)(Rb * K + C) * 2u; }
    const size_t kstep = (size_t)(BK * 2);
    const size_t hstep = (size_t)HALF * K * 2;
    const size_t tstep = 2 * hstep;
    const unsigned ldsw = (unsigned)wid * 1024u;
    const int aoff = lds_byte(wr * 64 + fr, fq * 8), boff = lds_byte(wc * 32 + fr, fq * 8);
#define PG8_SA(b, h) (((b) * 2 + (h)) * HTB)
#define PG8_SB(b, h) ((4 + (b) * 2 + (h)) * HTB)
#define PG8_STAGE(bufoff, gbase, voff) do { _Pragma("unroll") for (int _i = 0; _i < 2; ++_i) \
        __builtin_amdgcn_global_load_lds((const unsigned*)((const char*)(gbase) + (voff)[_i]), (PG8_LAS unsigned*)(lds + (bufoff) + ldsw + _i * 8192), 16, 0, 0); } while (0)
#define PG8_LDA(dst, b, h) do { _Pragma("unroll") for (int m = 0; m < 4; ++m) _Pragma("unroll") for (int k = 0; k < 2; ++k) dst[m][k] = *(const PG8_LAS bf16x8*)(lds + PG8_SA(b, h) + aoff + m * 2048 + k * 1024); } while (0)
#define PG8_LDB(dst, b, h) do { _Pragma("unroll") for (int n = 0; n < 2; ++n) _Pragma("unroll") for (int k = 0; k < 2; ++k) dst[n][k] = *(const PG8_LAS bf16x8*)(lds + PG8_SB(b, h) + boff + n * 2048 + k * 1024); } while (0)
#define PG8_MMA(ai, bj, At, Bt) do { __builtin_amdgcn_s_setprio(1); _Pragma("unroll") for (int m = 0; m < 4; ++m) _Pragma("unroll") for (int n = 0; n < 2; ++n) _Pragma("unroll") for (int k = 0; k < 2; ++k) \
        acc[ai][bj][m][n] = mma16<Epi::I8>(Bt[n][k], At[m][k], acc[ai][bj][m][n]); __builtin_amdgcn_s_setprio(0); } while (0)
#define PG8_WAIT_V(n) asm volatile("s_waitcnt vmcnt(" #n ")" ::: "memory")
#define PG8_WAIT_L(n) asm volatile("s_waitcnt lgkmcnt(" #n ")" ::: "memory")
#define PG8_BAR __builtin_amdgcn_s_barrier()
#define PG8_SCHED __builtin_amdgcn_sched_barrier(0)
    Unit cur, nxt; int ui = 0;
    if (!S.next(0, cur)) return;
    typedef typename AccT<Epi::I8>::type acc_t;
    acc_t acc[2][2][4][2];
#pragma unroll
    for (int a = 0; a < 2; ++a)
#pragma unroll
        for (int b = 0; b < 2; ++b)
#pragma unroll
            for (int m = 0; m < 4; ++m)
#pragma unroll
                for (int n = 0; n < 2; ++n) acc[a][b][m][n] = (acc_t){0, 0, 0, 0};
    bf16x8 At[4][2], B0[2][2], B1[2][2];
    const char* cA = (const char*)g.A + (size_t)cur.pm * tstep; const char* cB = (const char*)g.Bt + (size_t)cur.pn * tstep;
    S.a_ready(cur);
    if constexpr (SP2) {
        PG8_STAGE(PG8_SB(0, 0), cB, voffB); PG8_STAGE(PG8_SB(0, 1), cB + hstep, voffB); PG8_STAGE(PG8_SA(0, 0), cA, voffA); PG8_STAGE(PG8_SA(0, 1), cA + hstep, voffA);
        if (wr == 1) PG8_BAR;
        PG8_WAIT_V(2); PG8_BAR;
        PG8_STAGE(PG8_SB(1, 0), cB + kstep, voffB); PG8_STAGE(PG8_SA(1, 0), cA + kstep, voffA); PG8_STAGE(PG8_SB(1, 1), cB + hstep + kstep, voffB);
        PG8_WAIT_V(6); PG8_BAR;
    } else {
        PG8_STAGE(PG8_SB(0, 0), cB, voffB); PG8_STAGE(PG8_SA(0, 0), cA, voffA); PG8_STAGE(PG8_SB(0, 1), cB + hstep, voffB); PG8_STAGE(PG8_SA(0, 1), cA + hstep, voffA);
        if (wr == 1) PG8_BAR;
        PG8_WAIT_V(4); PG8_BAR;
        PG8_STAGE(PG8_SB(1, 0), cB + kstep, voffB); PG8_STAGE(PG8_SA(1, 0), cA + kstep, voffA); PG8_STAGE(PG8_SB(1, 1), cB + hstep + kstep, voffB);
        PG8_WAIT_V(6); PG8_BAR;
    }
    for (;;) {
        const bool has_next = S.next(ui + 1, nxt);
        const char* nA = has_next ? (const char*)g.A + (size_t)nxt.pm * tstep : cA; const char* nB = has_next ? (const char*)g.Bt + (size_t)nxt.pn * tstep : cB;
        for (int t = 0; t < nt; t += 2) {
            const bool last = (t == nt - 2);
            const char* a1 = cA + (size_t)(t + 1) * kstep;
            const char* a2 = last ? nA : cA + (size_t)(t + 2) * kstep; const char* b2 = last ? nB : cB + (size_t)(t + 2) * kstep;
            const char* a3 = a2 + kstep; const char* b3 = b2 + kstep;
            if (last && has_next) S.a_ready(nxt);
            if constexpr (SP2) {
            PG8_LDB(B0, 0, 0); PG8_LDB(B1, 0, 1); PG8_SCHED; PG8_LDA(At, 0, 0); PG8_STAGE(PG8_SA(1, 1), a1 + hstep, voffA);
            PG8_WAIT_V(8); PG8_WAIT_L(0); PG8_BAR; PG8_MMA(0, 0, At, B0); PG8_MMA(0, 1, At, B1); PG8_BAR; PG8_SCHED;
            PG8_LDA(At, 0, 1); PG8_STAGE(PG8_SB(0, 0), b2, voffB); PG8_STAGE(PG8_SB(0, 1), b2 + hstep, voffB); PG8_STAGE(PG8_SA(0, 0), a2, voffA);
            PG8_WAIT_V(8); PG8_WAIT_L(0); PG8_BAR; PG8_MMA(1, 0, At, B0); PG8_MMA(1, 1, At, B1); PG8_BAR; PG8_SCHED;
            PG8_LDB(B0, 1, 0); PG8_LDB(B1, 1, 1); PG8_SCHED; PG8_LDA(At, 1, 0); PG8_STAGE(PG8_SA(0, 1), a2 + hstep, voffA);
            PG8_WAIT_V(8); PG8_WAIT_L(0); PG8_BAR; PG8_MMA(0, 0, At, B0); PG8_MMA(0, 1, At, B1); PG8_BAR; PG8_SCHED;
            PG8_LDA(At, 1, 1); PG8_STAGE(PG8_SB(1, 0), b3, voffB); PG8_STAGE(PG8_SB(1, 1), b3 + hstep, voffB); PG8_STAGE(PG8_SA(1, 0), a3, voffA);
            PG8_WAIT_V(8); PG8_WAIT_L(0); PG8_BAR; PG8_MMA(1, 0, At, B0); PG8_MMA(1, 1, At, B1); PG8_BAR; PG8_SCHED;
            } else {
            PG8_LDB(B0, 0, 0); PG8_SCHED; PG8_LDA(At, 0, 0); PG8_STAGE(PG8_SA(1, 1), a1 + hstep, voffA);
            PG8_WAIT_L(8); PG8_BAR; PG8_WAIT_L(0); PG8_MMA(0, 0, At, B0); PG8_BAR; PG8_SCHED;
            PG8_LDB(B1, 0, 1); PG8_STAGE(PG8_SB(0, 0), b2, voffB);
            PG8_BAR; PG8_WAIT_L(0); PG8_MMA(0, 1, At, B1); PG8_BAR;
            PG8_LDA(At, 0, 1); PG8_STAGE(PG8_SA(0, 0), a2, voffA);
            PG8_BAR; PG8_WAIT_L(0); PG8_MMA(1, 0, At, B0); PG8_BAR; PG8_SCHED;
            PG8_STAGE(PG8_SB(0, 1), b2 + hstep, voffB);
            PG8_WAIT_V(6); PG8_BAR; PG8_MMA(1, 1, At, B1); PG8_BAR;
            PG8_LDB(B0, 1, 0); PG8_SCHED; PG8_LDA(At, 1, 0); PG8_STAGE(PG8_SA(0, 1), a2 + hstep, voffA);
            PG8_WAIT_L(8); PG8_BAR; PG8_WAIT_L(0); PG8_MMA(0, 0, At, B0); PG8_BAR; PG8_SCHED;
            PG8_LDB(B1, 1, 1); PG8_STAGE(PG8_SB(1, 0), b3, voffB);
            PG8_BAR; PG8_WAIT_L(0); PG8_MMA(0, 1, At, B1); PG8_BAR;
            PG8_LDA(At, 1, 1); PG8_STAGE(PG8_SA(1, 0), a3, voffA);
            PG8_BAR; PG8_WAIT_L(0); PG8_MMA(1, 0, At, B0); PG8_BAR; PG8_SCHED;
            PG8_STAGE(PG8_SB(1, 1), b3 + hstep, voffB);
            PG8_WAIT_V(6); PG8_BAR; PG8_MMA(1, 1, At, B1); PG8_BAR;
            }
        }
        if constexpr (ALIGN_EPI) { if (wr == 0) PG8_BAR; }
        if constexpr (!Epi::AFTER_DRAIN) { E(acc, cur, wr, wc, fr, fq); S.done(cur); }
        if (!has_next) break;
#pragma unroll
        for (int a = 0; a < 2; ++a)
#pragma unroll
            for (int b = 0; b < 2; ++b)
#pragma unroll
                for (int m = 0; m < 4; ++m)
#pragma unroll
                    for (int n = 0; n < 2; ++n) acc[a][b][m][n] = (acc_t){0, 0, 0, 0};
        cur = nxt; cA = nA; cB = nB; ++ui;
        if constexpr (ALIGN_EPI) { if (wr == 1) PG8_BAR; }
    }
    PG8_WAIT_V(0);
    if constexpr (!ALIGN_EPI) { if (wr == 0) PG8_BAR; }
    PG8_BAR;
    if constexpr (Epi::AFTER_DRAIN) { E.fused(acc, cur, wr, wc, fr, fq, lds, wid, lane); }
#undef PG8_SA
#undef PG8_SB
#undef PG8_STAGE
#undef PG8_LDA
#undef PG8_LDB
#undef PG8_MMA
#undef PG8_WAIT_V
#undef PG8_WAIT_L
#undef PG8_BAR
#undef PG8_SCHED
}
}

constexpr int NT_TOK = 24576, DM = 2048, INW = 4608, NPROMPT = 16384;
constexpr int NWAVES = 8, NTHREADS = 512;
constexpr float RMS_EPS = 1e-6f;
constexpr float LOG2E = 1.4426950408889634f;

constexpr size_t MiB = 1u << 20;
constexpr size_t WS_CTL = 0, CTL_ZERO_BYTES = 128 * 1024;
constexpr size_t WS_CMAX_IN = 64 * 1024;
constexpr size_t WS_SWI = 35 * MiB + 640 * 1024;
constexpr size_t WS_SXN = 39 * MiB + 262144;
constexpr size_t WS_SX2 = 39 * MiB + 393216;
constexpr size_t WS_WIN = 1 * MiB;
constexpr size_t WS_WOUT = 19 * MiB;
constexpr size_t WS_SWO = 23 * MiB;
constexpr size_t WS_CMAX = 32 * 1024;
constexpr size_t WS_SA = 39 * MiB + 131072;
constexpr size_t WS_SX = 39 * MiB + 262144;
constexpr size_t WS_SWQ = 31 * MiB;
constexpr size_t WS_CMAX2 = 48 * 1024;
constexpr size_t OUT_X2Q = 0;
constexpr size_t WS_WPQ = 27 * MiB;
constexpr size_t WS_SK = 35 * MiB;
constexpr size_t WS_SS = 36 * MiB;
constexpr size_t WS_US = 39 * MiB;
constexpr size_t WS_VS = 39 * MiB + 65536;
constexpr size_t WS_U = 40 * MiB;
constexpr size_t WS_V = 72 * MiB;
constexpr size_t WS_XN = 168 * MiB;
constexpr size_t WS_PROJ = 264 * MiB;
constexpr size_t WS_MIXED = WS_PROJ;
constexpr size_t WS_X2B = WS_PROJ + 96 * MiB;
constexpr size_t WS_RE16 = WS_PROJ + 192 * MiB;
constexpr size_t WS_RG = WS_PROJ + 198 * MiB;
constexpr size_t WS_CQ = WS_PROJ + 210 * MiB;
constexpr size_t WS_SCQ = WS_PROJ + 213 * MiB;
constexpr size_t WS_SS3 = WS_PROJ + 214 * MiB;
constexpr size_t WS_PD0 = WS_XN;
constexpr size_t WS_PD1 = WS_MIXED;
constexpr size_t WS_END = 480 * MiB;
constexpr int IG_NGRP = 64, IG_TOK = 384, IG_NSUB = 256, IG_SUBT = 96, IG_SPG = IG_TOK / IG_SUBT, IG_PICKS = IG_TOK * 128, IG_PITCH = 272;
constexpr size_t WS_L = 104 * MiB;
constexpr size_t WS_TL = 117 * MiB;
constexpr size_t WS_H = 118 * MiB;
constexpr size_t WS_RSTD2 = 119 * MiB;
constexpr size_t WS_NTL = 119 * MiB + 131072;
constexpr size_t OUT_OA = 0, OUT_OA_STRIDE = 48 * MiB, OUT_LSE = 144 * MiB, OUT_LSE_STRIDE = (size_t)NT_TOK * 16 * 4;

constexpr int LDS_BYTES = 147456;

#define LAS __attribute__((address_space(3)))
typedef unsigned short bf16;
typedef unsigned v4u __attribute__((ext_vector_type(4)));
typedef unsigned v2u __attribute__((ext_vector_type(2)));
typedef float f32x4 __attribute__((ext_vector_type(4)));
typedef float f32x16 __attribute__((ext_vector_type(16)));
typedef short bf16x8 __attribute__((ext_vector_type(8)));
typedef short s16x4 __attribute__((ext_vector_type(4)));
typedef float f32x2 __attribute__((ext_vector_type(2)));

typedef __bf16 bf16x2_t __attribute__((ext_vector_type(2)));
__device__ __forceinline__ unsigned pk2(float lo, float hi) { const f32x2 v = {lo, hi}; return __builtin_bit_cast(unsigned, __builtin_convertvector(v, bf16x2_t)); }
__device__ __forceinline__ float bflo(unsigned w) { return __builtin_bit_cast(float, w << 16); }
__device__ __forceinline__ float bfhi(unsigned w) { return __builtin_bit_cast(float, w & 0xffff0000u); }
__device__ __forceinline__ float wave_sum(float v) {
#pragma unroll
    for (int o = 1; o < 64; o <<= 1) v += __shfl_xor(v, o);
    return v;
}

struct Args { const float* in[14]; float* out; unsigned char* ws; int ph_lo, ph_hi; };

struct Frame {
    LAS unsigned char* lds; unsigned char* lds_g;
    int tid, lane, wave, vcu, G;
    const float *xp, *xs, *norm1_g, *w_in, *a_out_g, *b_out_g, *sink, *w_out, *norm2_g, *w_pq, *sub_keys, *expert_u, *expert_v, *normf_g;
    float* out; unsigned char* ws;
};


#define XB_TMO      128
#define XB_XCNT(j)  (256  + 64 * (j))
#define XB_XSUB(j)  (1280 + 64 * (j))
#define XB_XGEN(j)  (2304 + 64 * (j))
#define XB_TOP      3328
#define XB_TOPGEN   3392
#define XCD_BAR_WORDS 3456
#define XB_SPIN_CAP (1u << 22)
__device__ __forceinline__ unsigned xb_ld(unsigned* p)              { return __hip_atomic_load(p, __ATOMIC_RELAXED, __HIP_MEMORY_SCOPE_AGENT); }
__device__ __forceinline__ unsigned xb_add(unsigned* p, unsigned v) { return __hip_atomic_fetch_add(p, v, __ATOMIC_RELAXED, __HIP_MEMORY_SCOPE_AGENT); }
__device__ __forceinline__ unsigned xb_xcc_id() { return (unsigned)__builtin_amdgcn_s_getreg((3 << 11) | 20) & 0xFu; }
#define XB_SPIN(cond, bar) do { unsigned _sp = 0; while (cond) { __builtin_amdgcn_s_sleep(1); \
    if ((++_sp & 255u) == 0u) { if (xb_ld(&(bar)[XB_TMO])) break; if (_sp > XB_SPIN_CAP) { atomicAdd(&(bar)[XB_TMO], 1u); break; } } } } while (0)
struct XcdBarrier { unsigned* bar; unsigned x; volatile LAS unsigned* st; };
__device__ __forceinline__ XcdBarrier xcd_barrier_post(unsigned* bar, volatile LAS unsigned* st) {
    XcdBarrier b; b.bar = bar; b.x = xb_xcc_id(); b.st = st;
    if (threadIdx.x == 0) st[2] = xb_add(&bar[XB_XCNT(b.x)], 1u);
    return b;
}
__device__ __forceinline__ void xcd_barrier_complete(unsigned* bar, unsigned x, unsigned& nloc, unsigned& nx) {
    const unsigned G = gridDim.x * gridDim.y * gridDim.z;
    unsigned sum, cnt, mine, sp = 0u;
    for (;;) {
        sum = 0u; cnt = 0u; mine = 0u;
#pragma unroll
        for (unsigned j = 0; j < 16; ++j) { const unsigned c = xb_ld(&bar[XB_XCNT(j)]); sum += c; cnt += (c > 0u) ? 1u : 0u; mine = (j == x) ? c : mine; }
        if (sum == G) break;
        __builtin_amdgcn_s_sleep(1);
        if ((++sp & 255u) == 0u) { if (xb_ld(&bar[XB_TMO])) break; if (sp > XB_SPIN_CAP) { atomicAdd(&bar[XB_TMO], 1u); break; } }
    }
    nloc = mine > 0u ? mine : 1u; nx = cnt > 0u ? cnt : 1u;
}
__device__ __forceinline__ void xcd_barrier(const XcdBarrier& b) {
    asm volatile("s_waitcnt vmcnt(0)" ::: "memory");
    __syncthreads();
    if (threadIdx.x == 0) {
        unsigned* bar = b.bar;
        __builtin_amdgcn_s_waitcnt(0);
        unsigned nloc = b.st[0], nx = b.st[1];
        if (nloc == 0u) { xcd_barrier_complete(bar, b.x, nloc, nx); b.st[0] = nloc; b.st[1] = nx; }
        const unsigned old = xb_add(&bar[XB_XSUB(b.x)], 1u);
        const unsigned gen = old / nloc;
        if (old + 1u == (gen + 1u) * nloc) {
            __builtin_amdgcn_fence(__ATOMIC_RELEASE, "agent");
            asm volatile("s_waitcnt vmcnt(0)" ::: "memory");
            const unsigned og = xb_add(&bar[XB_TOP], 1u);
            const unsigned tg = og / nx;
            if (og + 1u == (tg + 1u) * nx) xb_add(&bar[XB_TOPGEN], 1u);
            else XB_SPIN(xb_ld(&bar[XB_TOPGEN]) == tg, bar);
            __builtin_amdgcn_fence(__ATOMIC_ACQUIRE, "agent");
            xb_add(&bar[XB_XGEN(b.x)], 1u);
            asm volatile("s_waitcnt vmcnt(0)" ::: "memory");
        } else {
            XB_SPIN(xb_ld(&bar[XB_XGEN(b.x)]) == gen, bar);
            __builtin_amdgcn_fence(__ATOMIC_ACQUIRE, "agent");
            asm volatile("s_waitcnt vmcnt(0)" ::: "memory");
        }
    }
    __syncthreads();
}
constexpr int MISC_OFF = 131072 + 320;

template <bool HASKS>
__device__ __forceinline__ void p0_transpose_item(const float* W, int K, int N, bf16* WT, const float* kscale, LAS float* scr, int item, int lane) {
    const int nblk = N / 32, kb = item / nblk, nb = item % nblk, k0 = 64 * kb, n0 = 32 * nb;
#pragma unroll 32
    for (int i = 0; i < 32; ++i) { const int kk = 2 * i + (lane >> 5); float v = W[(size_t)(k0 + kk) * N + n0 + (lane & 31)]; if (HASKS) v *= kscale[k0 + kk]; scr[kk * 33 + (lane & 31)] = v; }
    asm volatile("s_waitcnt lgkmcnt(0)" ::: "memory");
    const int c = lane & 7;
#pragma unroll
    for (int j = 0; j < 4; ++j) { const int n = (lane >> 3) + 8 * j; const LAS float* s = scr + (8 * c) * 33 + n;
        v4u o; o.x = pk2(s[0 * 33], s[1 * 33]); o.y = pk2(s[2 * 33], s[3 * 33]); o.z = pk2(s[4 * 33], s[5 * 33]); o.w = pk2(s[6 * 33], s[7 * 33]);
        *(v4u*)(WT + (size_t)(n0 + n) * K + k0 + 8 * c) = o; }
    asm volatile("s_waitcnt lgkmcnt(0)" ::: "memory");
}
template <int NN, bool HASKS>
__device__ __forceinline__ void p1_quant_w(Frame& F, const float* W, const float* kscale, const float* cmax, unsigned char* WQ, float* SW) {
    LAS float* scr = (LAS float*)(F.lds + F.wave * 16384);
    const int gw = F.vcu * NWAVES + F.wave, NGW = F.G * NWAVES, lane = fresh_lane();
    constexpr int NITEM = (DM / 64) * (NN / 32);
    for (int item = gw; item < NITEM; item += NGW) {
        const int nblk = NN / 32, kb = item / nblk, nb = item % nblk, k0 = 64 * kb, n0 = 32 * nb;
        const float cm = cmax[n0 + (lane & 31)]; const float inv = cm > 0.f ? 127.0f / cm : 0.f;
#pragma unroll 32
        for (int i = 0; i < 32; ++i) { const int kk = 2 * i + (lane >> 5); float v = W[(size_t)(k0 + kk) * NN + n0 + (lane & 31)] * inv; if (HASKS) v *= kscale[k0 + kk]; scr[kk * 33 + (lane & 31)] = v; }
        asm volatile("s_waitcnt lgkmcnt(0)" ::: "memory");
        const int c = lane & 3;
#pragma unroll
        for (int j = 0; j < 2; ++j) { const int n = (lane >> 2) + 16 * j; const LAS float* s = scr + (16 * c) * 33 + n; v4u o;
#pragma unroll
            for (int q = 0; q < 4; ++q) { unsigned w = 0;
#pragma unroll
                for (int e = 0; e < 4; ++e) w |= ((unsigned)(int)__builtin_rintf(s[(4 * q + e) * 33]) & 0xffu) << (8 * e);
                o[q] = w; }
            *(v4u*)(WQ + (size_t)(n0 + n) * DM + k0 + 16 * c) = o; }
        if (kb == 0 && lane < 32) SW[n0 + lane] = cm > 0.f ? cm * (1.0f / 127.0f) : 1.0f;
        asm volatile("s_waitcnt lgkmcnt(0)" ::: "memory");
    }
}
__device__ __forceinline__ void p0_prep(Frame& F) {
    LAS float* scr = (LAS float*)(F.lds + F.wave * 16384);
    const int gw = F.vcu * NWAVES + F.wave, NGW = F.G * NWAVES, lane = fresh_lane();
    bf16* WinT = (bf16*)(F.ws + WS_WIN); bf16* WpqT = (bf16*)(F.ws + WS_WPQ);
    constexpr int I_IN = (DM / 64) * (INW / 32), I_OUT = (DM / 64) * (DM / 32), I_PQ = I_OUT;
    for (int it = gw; it < I_IN + I_OUT + I_PQ; it += NGW) {
        int r = it;
#define P0_CMAX_ITEM(W, KS, CM, HASKS) P0_CMAX_ITEM_N(W, KS, CM, DM, HASKS)
#define P0_CMAX_ITEM_N(W, KS, CM, NN, HASKS) do { const int nblk_ = (NN) / 32, kb_ = r / nblk_, nb_ = r % nblk_; float mx_ = 0.f; \
            _Pragma("unroll 32") for (int i_ = 0; i_ < 32; ++i_) { const int k_ = 64 * kb_ + 2 * i_ + (lane >> 5); float v_ = (W)[(size_t)k_ * (NN) + 32 * nb_ + (lane & 31)]; if (HASKS) v_ *= ((const float*)(KS))[k_]; mx_ = fmaxf(mx_, fabsf(v_)); } \
            mx_ = fmaxf(mx_, __shfl_xor(mx_, 32)); \
            if (lane < 32) atomicMax((unsigned*)(F.ws + (CM)) + 32 * nb_ + lane, __builtin_bit_cast(unsigned, mx_)); } while (0)
#if P1_I8
        if (r < I_IN) { P0_CMAX_ITEM_N(F.w_in, (const float*)nullptr, WS_CMAX_IN, INW, 0); continue; } r -= I_IN;
#else
        if (r < I_IN) { p0_transpose_item<false>(F.w_in, DM, INW, WinT, nullptr, scr, r, lane); continue; } r -= I_IN;
#endif
#if P4_I8
        if (r < I_OUT) { P0_CMAX_ITEM(F.w_out, (const float*)nullptr, WS_CMAX, 0); continue; } r -= I_OUT;
#else
        if (r < I_OUT) { p0_transpose_item<false>(F.w_out, DM, DM, (bf16*)(F.ws + WS_WOUT), nullptr, scr, r, lane); continue; } r -= I_OUT;
#endif
#if P5_I8
        P0_CMAX_ITEM(F.w_pq, F.norm2_g, WS_CMAX2, 1); continue;
#endif
#if !P5_I8
        p0_transpose_item<true>(F.w_pq, DM, DM, WpqT, F.norm2_g, scr, r, lane);
#endif
    }
    { bf16* SK = (bf16*)(F.ws + WS_SK);
      for (int i = gw * 64 + lane; i < 65536; i += NGW * 64) { const f32x4 v = ((const f32x4*)F.sub_keys)[i]; v2u o; o.x = pk2(v[0], v[1]); o.y = pk2(v[2], v[3]); ((v2u*)SK)[i] = o; } }
    { unsigned char* U = F.ws + WS_U; unsigned char* V = F.ws + WS_V; float* US = (float*)(F.ws + WS_US); float* VS = (float*)(F.ws + WS_VS);
      float g2[32];
#pragma unroll
      for (int j = 0; j < 2; ++j)
#pragma unroll
          for (int q = 0; q < 4; ++q) { const f32x4 t = *(const f32x4*)(F.norm2_g + 1024 * j + 16 * lane + 4 * q); g2[16 * j + 4 * q] = t[0]; g2[16 * j + 4 * q + 1] = t[1]; g2[16 * j + 4 * q + 2] = t[2]; g2[16 * j + 4 * q + 3] = t[3]; }
#define P0_ROWSRC(row) (((row) < 16384 ? F.expert_u + (size_t)(row) * DM : F.expert_v + (size_t)((row) - 16384) * DM) + 16 * lane)
      f32x4 cur[8], nxt[8];
#define P0_ROWOF(n) ((((n) >> 4) * NGW + gw) * 16 + ((n) & 15))
      if (gw < 2048) { const float* s0 = P0_ROWSRC(P0_ROWOF(0));
#pragma unroll
          for (int q = 0; q < 8; ++q) cur[q] = *(const f32x4*)(s0 + 1024 * (q >> 2) + 4 * (q & 3)); }
#pragma unroll 1
      for (int n = 0; P0_ROWOF(n) < 32768; ++n) {
          const int row = P0_ROWOF(n);
          const bool isu = row < 16384; const int e = isu ? row : row - 16384;
          unsigned char* dst = (isu ? U : V) + (size_t)e * 128;
          { const int rn = (P0_ROWOF(n + 1) < 32768) ? P0_ROWOF(n + 1) : row; const float* sn = P0_ROWSRC(rn);
#pragma unroll
            for (int q = 0; q < 8; ++q) nxt[q] = *(const f32x4*)(sn + 1024 * (q >> 2) + 4 * (q & 3)); }
          float v[32]; float am = 0.f;
#pragma unroll
          for (int q = 0; q < 8; ++q)
#pragma unroll
              for (int c = 0; c < 4; ++c) { float x = cur[q][c]; if (isu) x *= g2[4 * q + c]; v[4 * q + c] = x; am = fmaxf(am, fabsf(x)); }
#pragma unroll
          for (int o = 1; o < 64; o <<= 1) am = fmaxf(am, __shfl_xor(am, o));
          const float inv = am > 0.f ? 127.0f / am : 0.f;
#pragma unroll
          for (int j = 0; j < 2; ++j) { v4u o;
#pragma unroll
              for (int q = 0; q < 4; ++q) { unsigned w = 0;
#pragma unroll
                  for (int c = 0; c < 4; ++c) { const int qi = (int)__builtin_rintf(v[16 * j + 4 * q + c] * inv); w |= ((unsigned)qi & 0xffu) << (8 * c); }
                  o[q] = w; }
#if P7A_INV
              if (isu) { const int cidx = lane + 64 * j;
                  *(v4u*)(U + (size_t)(cidx >> 4) * (1024 * 4096) + (size_t)(e >> 4) * 4096 + ((cidx & 15) >> 2) * 1024 + (((cidx & 3) << 4) + (e & 15)) * 16) = o; }
              else
#endif
              *(v4u*)(dst + (size_t)((lane >> 3) + 8 * j) * (16384 * 128) + 16 * (lane & 7)) = o; }
          if (lane == 0) (isu ? US : VS)[e] = am > 0.f ? am * (1.0f / 127.0f) : 1.0f;
#pragma unroll
          for (int q = 0; q < 8; ++q) cur[q] = nxt[q]; }
#undef P0_ROWSRC
#undef P0_ROWOF
    }
    { bf16* XN = (bf16*)(F.ws + WS_XN);
#define P0_XROW(t) (((t) < NPROMPT ? F.xp + (size_t)(t) * DM : F.xs + (size_t)((t) - NPROMPT) * DM) + 8 * lane)
      f32x4 cur[4][2], nxt[4][2], g1a[4], g1b[4];
#pragma unroll
      for (int j = 0; j < 4; ++j) { g1a[j] = *(const f32x4*)(F.norm1_g + 512 * j + 8 * lane); g1b[j] = *(const f32x4*)(F.norm1_g + 512 * j + 8 * lane + 4); }
      if (gw < NT_TOK) { const float* x0 = P0_XROW(gw);
#pragma unroll
          for (int j = 0; j < 4; ++j) { cur[j][0] = *(const f32x4*)(x0 + 512 * j); cur[j][1] = *(const f32x4*)(x0 + 512 * j + 4); } }
#pragma unroll 1
      for (int t = gw; t < NT_TOK; t += NGW) {
          { const int tn = (t + NGW < NT_TOK) ? t + NGW : t; const float* xn_ = P0_XROW(tn);
#pragma unroll
            for (int j = 0; j < 4; ++j) { nxt[j][0] = *(const f32x4*)(xn_ + 512 * j); nxt[j][1] = *(const f32x4*)(xn_ + 512 * j + 4); } }
          float s = 0.f;
#pragma unroll
          for (int j = 0; j < 4; ++j)
#pragma unroll
              for (int q = 0; q < 2; ++q) s += (cur[j][q][0] * cur[j][q][0] + cur[j][q][1] * cur[j][q][1]) + (cur[j][q][2] * cur[j][q][2] + cur[j][q][3] * cur[j][q][3]);
          const float rstd = 1.0f / sqrtf(wave_sum(s) * (1.0f / DM) + RMS_EPS);
#if P5_I8 == 2
          if (lane == 0) ((float*)(F.ws + WS_SX2))[t] = 6.0f / (127.0f * rstd);
#endif
#if P1_I8
          f32x4 xa[4], xb4[4]; float am = 0.f;
#pragma unroll
          for (int j = 0; j < 4; ++j) { const f32x4 ga = g1a[j], gb = g1b[j];
              xa[j] = cur[j][0] * rstd * ga; xb4[j] = cur[j][1] * rstd * gb;
#pragma unroll
              for (int c = 0; c < 4; ++c) am = fmaxf(am, fmaxf(fabsf(xa[j][c]), fabsf(xb4[j][c]))); }
#pragma unroll
          for (int o = 1; o < 64; o <<= 1) am = fmaxf(am, __shfl_xor(am, o));
          const float inv = am > 0.f ? 127.0f / am : 0.f;
#pragma unroll
          for (int j = 0; j < 4; ++j) { v2u o; unsigned w0 = 0, w1 = 0;
#pragma unroll
              for (int c = 0; c < 4; ++c) { w0 |= ((unsigned)(int)__builtin_rintf(xa[j][c] * inv) & 0xffu) << (8 * c); w1 |= ((unsigned)(int)__builtin_rintf(xb4[j][c] * inv) & 0xffu) << (8 * c); }
              o.x = w0; o.y = w1; *(v2u*)((unsigned char*)XN + (size_t)t * DM + 512 * j + 8 * lane) = o; }
          if (lane == 0) ((float*)(F.ws + WS_SXN))[t] = am > 0.f ? am * (1.0f / 127.0f) : 1.0f;
#else
#pragma unroll
          for (int j = 0; j < 4; ++j) { const f32x4 ga = g1a[j], gb = g1b[j];
              const f32x4 a = cur[j][0] * rstd * ga, b = cur[j][1] * rstd * gb;
              v4u o; o.x = pk2(a[0], a[1]); o.y = pk2(a[2], a[3]); o.z = pk2(b[0], b[1]); o.w = pk2(b[2], b[3]);
              *(v4u*)(XN + (size_t)t * DM + 512 * j + 8 * lane) = o; }
#endif
#pragma unroll
          for (int j = 0; j < 4; ++j) { cur[j][0] = nxt[j][0]; cur[j][1] = nxt[j][1]; } }
#undef P0_XROW
    }
}

constexpr int ATT_KOFF = 0, ATT_VOFF = 65536;
struct AttU { int valid, isB, p, rowbase, Lsub, r, d, q0, kcol, vcol, qcol, head, nh; };
__device__ __forceinline__ AttU att_decode_b(int gb, int kvh, int qp) {
    AttU u; u.valid = 1; u.isB = 1; u.p = 0; u.rowbase = gb < 64 ? (gb >> 4) * 4096 : NPROMPT; u.Lsub = gb < 64 ? 4096 : 8192; u.r = 0; u.d = 1; u.q0 = 256 * (gb < 64 ? (gb & 15) : (gb - 64));
    u.kcol = 4096 + kvh * 64; u.vcol = 4352 + kvh * 64; u.head = kvh * 4 + qp * 2; u.qcol = 3072 + u.head * 64; u.nh = 2; return u;
}
__device__ __forceinline__ AttU att_decode_a(int p, int head, int gb) {
    AttU u; const int d = p == 0 ? 1 : (p == 1 ? 4 : 16); const int L = gb < 64 ? 4096 : 8192; const int idx = gb < 64 ? (gb & 15) : (gb - 64);
    u.valid = 1; u.isB = 0; u.p = p; u.rowbase = gb < 64 ? (gb >> 4) * 4096 : NPROMPT; u.Lsub = L / d; u.r = idx % d; u.d = d; u.q0 = 256 * (idx / d);
    u.kcol = 1024 + head * 64; u.vcol = 2048 + head * 64; u.head = head; u.qcol = head * 64; u.nh = 1; return u;
}
__device__ __forceinline__ AttU att_unit(int vcu, int G, int k) {
    AttU u; u.valid = 0;
    if (G == 256) {
        if (k >= 21) return u;
        const int x = vcu >> 5, lc = vcu & 31;
        if (k < 3) { const int gB = x * 3 + k, rg = gB % 6, kvh = gB / 6; return att_decode_b(16 * rg + (lc >> 1), kvh, lc & 1); }
        const int t = (k - 3) / 3, j = (k - 3) % 3, gp = x * 6 + t, uu0 = lc + 32 * j, group = 2 * gp + uu0 / 48, uu = uu0 % 48;
        return att_decode_a(uu / 16, group / 6, 16 * (group % 6) + (uu % 16));
    }
    const int uidx = vcu + k * G;
    if (uidx >= 768 + 4608) return u;
    if (uidx < 768) return att_decode_b(uidx >> 3, (uidx >> 1) & 3, uidx & 1);
    const int a = uidx - 768; return att_decode_a(a / 1536, (a % 1536) / 96, a % 96);
}
template <int HALFW, bool LDSFLAT = false>
__device__ __forceinline__ void att_wave(int lane, int w, const LAS unsigned char* Ks, const LAS unsigned char* Vs, int kp0  , int Lsub,
                                         const bf16x8 (&qf)[4], float slope2, f32x16& o0, f32x16& o1, float& m_out, float& l_out, int jbeg = 0, int jend = 1 + 2 * HALFW / 32) {
    constexpr int NTILE = 1 + 2 * HALFW / 32, JM = HALFW / 32;
    const int ql = lane & 31, hh = lane >> 5;
    o0 = (f32x16){}; o1 = (f32x16){};
    float m = -1e30f, lsum = 0.f;
    const int i15 = lane & 15, G = (lane >> 4) & 1, ql4 = ql - 4 * hh;
    f32x16 CL, CM, CR;
    { const float sq = slope2 * (float)ql;
#pragma unroll
      for (int reg = 0; reg < 16; ++reg) { const float kb_ = slope2 * (float)((reg & 3) + 8 * (reg >> 2) + 4 * hh); CL[reg] = kb_; CR[reg] = -kb_; CM[reg] = -fabsf(kb_ - sq); } }
    const LAS unsigned char* kb = Ks + (LDSFLAT ? 0 : (32 * w + ql) * 128); const int sw = LDSFLAT ? 0 : ((ql >> 1) & 7);
    int koff[4];
#pragma unroll
    for (int ks = 0; ks < 4; ++ks) koff[ks] = LDSFLAT ? 0 : (((2 * ks + hh) ^ sw) << 4);
    const int c0 = (2 * G + ((i15 & 3) >> 1)) ^ (((i15 >> 3) & 1) << 2);
    const LAS unsigned char* vb0 = LDSFLAT ? Vs : Vs + (32 * w + 4 * hh + (i15 >> 2)) * 128 + (i15 & 1) * 8 + (c0 << 4);
    const LAS unsigned char* vb1 = LDSFLAT ? Vs + 64 : Vs + (32 * w + 4 * hh + (i15 >> 2)) * 128 + (i15 & 1) * 8 + ((c0 ^ 4) << 4);
    bf16x8 kf[4];
#pragma unroll
    for (int ks = 0; ks < 4; ++ks) kf[ks] = *(const LAS bf16x8*)(kb + koff[ks]);
#pragma unroll 1
    for (int j = jbeg; j < jend; ++j) {
        const int kt0 = kp0 + 32 * j;
        const int jn = (j + 1 < NTILE) ? j + 1 : j;
        if (!(kt0 + 31 < 0 || kt0 >= Lsub)) {
            s16x4 vlo[2][2], vhi[2][2];
#pragma unroll
            for (int st = 0; st < 2; ++st) {
                vlo[0][st] = __builtin_bit_cast(s16x4, __builtin_amdgcn_ds_read_tr16_b64_v4i16((LAS s16x4*)(vb0 + 4096 * j + 2048 * st)));
                vhi[0][st] = __builtin_bit_cast(s16x4, __builtin_amdgcn_ds_read_tr16_b64_v4i16((LAS s16x4*)(vb0 + 4096 * j + 2048 * st + 1024)));
                vlo[1][st] = __builtin_bit_cast(s16x4, __builtin_amdgcn_ds_read_tr16_b64_v4i16((LAS s16x4*)(vb1 + 4096 * j + 2048 * st)));
                vhi[1][st] = __builtin_bit_cast(s16x4, __builtin_amdgcn_ds_read_tr16_b64_v4i16((LAS s16x4*)(vb1 + 4096 * j + 2048 * st + 1024))); }
            f32x16 s; float cj;
            const float cl = slope2 * (float)(32 * j - HALFW - ql);
            if (j < JM) { s = __builtin_amdgcn_mfma_f32_32x32x16_bf16(kf[0], qf[0], CL, 0, 0, 0); cj = cl; }
            else if (j == JM) { s = __builtin_amdgcn_mfma_f32_32x32x16_bf16(kf[0], qf[0], CM, 0, 0, 0); cj = 0.f; }
            else { s = __builtin_amdgcn_mfma_f32_32x32x16_bf16(kf[0], qf[0], CR, 0, 0, 0); cj = -cl; }
#pragma unroll
            for (int ks = 1; ks < 4; ++ks) s = __builtin_amdgcn_mfma_f32_32x32x16_bf16(kf[ks], qf[ks], s, 0, 0, 0);
#pragma unroll
            for (int ks = 0; ks < 4; ++ks) kf[ks] = *(const LAS bf16x8*)(kb + 4096 * jn + koff[ks]);
            if (j == 0) {
#pragma unroll
                for (int reg = 0; reg < 16; ++reg) s[reg] = ((reg & 3) + 8 * (reg >> 2) >= ql4) ? s[reg] : -INFINITY;
            } else if (j == NTILE - 1) {
#pragma unroll
                for (int reg = 0; reg < 16; ++reg) s[reg] = ((reg & 3) + 8 * (reg >> 2) <= ql4) ? s[reg] : -INFINITY;
            }
            if (kt0 < 0 || kt0 + 31 >= Lsub) {
                const int kq = kt0 + 4 * hh;
#pragma unroll
                for (int reg = 0; reg < 16; ++reg) { const int kpos = kq + (reg & 3) + 8 * (reg >> 2); s[reg] = ((unsigned)kpos < (unsigned)Lsub) ? s[reg] : -INFINITY; }
            }
            float tmax = fmaxf(fmaxf(s[0], s[1]), s[2]);
#pragma unroll
            for (int reg = 3; reg < 15; reg += 2) tmax = fmaxf(fmaxf(tmax, s[reg]), s[reg + 1]);
            tmax = fmaxf(tmax, s[15]) + cj;
            tmax = fmaxf(tmax, __shfl_xor(tmax, 32));
            if (__any(tmax > m + 8.0f)) { const float mnew = fmaxf(m, tmax); const float alpha = __builtin_amdgcn_exp2f(m - mnew); lsum *= alpha; m = mnew;
#pragma unroll
                for (int reg = 0; reg < 16; ++reg) { o0[reg] *= alpha; o1[reg] *= alpha; } }
            const float dd = cj - m;
            f32x2 ps2 = {0.f, 0.f}; const f32x2 dd2 = {dd, dd};
#pragma unroll
            for (int rp = 0; rp < 8; ++rp) { f32x2 t; { const f32x2 in_ = {s[2 * rp], s[2 * rp + 1]}; asm("v_pk_add_f32 %0, %1, %2" : "=v"(t) : "v"(in_), "v"(dd2)); } t[0] = __builtin_amdgcn_exp2f(t[0]); t[1] = __builtin_amdgcn_exp2f(t[1]); s[2 * rp] = t[0]; s[2 * rp + 1] = t[1]; asm("v_pk_add_f32 %0, %1, %2" : "=v"(ps2) : "v"(ps2), "v"(t)); }
            lsum += ps2[0] + ps2[1];
            bf16x8 pf[2];
#pragma unroll
            for (int st = 0; st < 2; ++st) { v4u t; t.x = pk2(s[8 * st + 0], s[8 * st + 1]); t.y = pk2(s[8 * st + 2], s[8 * st + 3]); t.z = pk2(s[8 * st + 4], s[8 * st + 5]); t.w = pk2(s[8 * st + 6], s[8 * st + 7]); pf[st] = __builtin_bit_cast(bf16x8, t); }
#pragma unroll
            for (int st = 0; st < 2; ++st) {
                const bf16x8 v0 = (bf16x8){vlo[0][st][0], vlo[0][st][1], vlo[0][st][2], vlo[0][st][3], vhi[0][st][0], vhi[0][st][1], vhi[0][st][2], vhi[0][st][3]};
                const bf16x8 v1 = (bf16x8){vlo[1][st][0], vlo[1][st][1], vlo[1][st][2], vlo[1][st][3], vhi[1][st][0], vhi[1][st][1], vhi[1][st][2], vhi[1][st][3]};
                o0 = __builtin_amdgcn_mfma_f32_32x32x16_bf16(v0, pf[st], o0, 0, 0, 0);
                o1 = __builtin_amdgcn_mfma_f32_32x32x16_bf16(v1, pf[st], o1, 0, 0, 0); }
        } else {
#pragma unroll
            for (int ks = 0; ks < 4; ++ks) kf[ks] = *(const LAS bf16x8*)(kb + 4096 * jn + koff[ks]);
        }
    }
    lsum += __shfl_xor(lsum, 32);
    m_out = m; l_out = lsum;
}
__device__ __forceinline__ void att_store(bf16* orow, const f32x16& o0, const f32x16& o1, float scale, int hh) {
#pragma unroll
    for (int dt = 0; dt < 2; ++dt)
#pragma unroll
        for (int k = 0; k < 4; k += 2) {
            const f32x16& o = dt ? o1 : o0;
            const unsigned ax = pk2(o[4 * k] * scale, o[4 * k + 1] * scale), ay = pk2(o[4 * k + 2] * scale, o[4 * k + 3] * scale);
            const unsigned bx = pk2(o[4 * k + 4] * scale, o[4 * k + 5] * scale), by = pk2(o[4 * k + 6] * scale, o[4 * k + 7] * scale);
            const auto sx = __builtin_amdgcn_permlane32_swap(ax, bx, false, false), sy = __builtin_amdgcn_permlane32_swap(ay, by, false, false);
            v4u w; w.x = sx[0]; w.y = sy[0]; w.z = sx[1]; w.w = sy[1];
            *(v4u*)(orow + 32 * dt + 8 * (k + hh)) = w; }
}
template <int MODE  >
__device__ __forceinline__ void p2_attention(Frame& F) {
    const bf16* proj = (const bf16*)(F.ws + WS_PROJ);
    bf16* OB = (bf16*)(F.ws + WS_XN + (MODE >= 2 ? 48 * MiB : 0));
    unsigned char* outb = (unsigned char*)F.out;
    const int w = F.wave;
#define ATT_LOADKV(U) do { const int nk_ = (U).isB ? 512 : 384, iv0_ = (U).q0 - ((U).isB ? 128 : 64); \
        _Pragma("unroll") for (int it_ = 0; it_ < 8; ++it_) { const int idx_ = tid + it_ * NTHREADS, row_ = idx_ >> 3, ch_ = idx_ & 7, i_ = iv0_ + row_; const bool ok_ = (row_ < nk_) && (i_ >= 0) && (i_ < (U).Lsub); \
            const bf16* src_ = proj + (size_t)((U).rowbase + (U).r + (U).d * (ok_ ? i_ : 0)) * INW + ch_ * 8; \
            kk[it_] = ok_ ? *(const v4u*)(src_ + (U).kcol) : (v4u){0u, 0u, 0u, 0u}; vv[it_] = ok_ ? *(const v4u*)(src_ + (U).vcol) : (v4u){0u, 0u, 0u, 0u}; } } while (0)
#define ATT_WRITEKV(U) do { const int nk_ = (U).isB ? 512 : 384; const int row0_ = tid >> 3, ch_ = tid & 7;     \
        LAS unsigned char* kb_ = F.lds + ATT_KOFF + row0_ * 128 + ((ch_ ^ ((row0_ >> 1) & 7)) << 4); LAS unsigned char* vb_ = F.lds + ATT_VOFF + row0_ * 128 + ((ch_ ^ (((row0_ >> 1) & 1) << 2)) << 4); \
        _Pragma("unroll") for (int it_ = 0; it_ < 8; ++it_) { if (row0_ + 64 * it_ < nk_) { *(LAS v4u*)(kb_ + 8192 * it_) = kk[it_]; *(LAS v4u*)(vb_ + 8192 * it_) = vv[it_]; } } } while (0)
#define ATT_QLOAD(dst, U, h) do { const int tok_ = (U).rowbase + (U).r + (U).d * ((U).q0 + 32 * w + ql); const bf16* qp_ = proj + (size_t)tok_ * INW + (U).qcol + 64 * (h) + 8 * hh; \
        _Pragma("unroll") for (int ks_ = 0; ks_ < 4; ++ks_) dst[ks_] = *(const bf16x8*)(qp_ + 16 * ks_); } while (0)
    v4u kk[8], vv[8];
    const LAS unsigned char* Ks = F.lds + ATT_KOFF; const LAS unsigned char* Vs = F.lds + ATT_VOFF;
#pragma unroll 1
    for (int k = 0;; ++k) {
        const AttU cur = att_unit(F.vcu, F.G, k);
        if (!cur.valid) break;
        const int lane = fresh_lane();
        const int ql = lane & 31, hh = lane >> 5, tid = w * 64 + lane;
        bf16x8 qc[4];
        if (MODE == 0) ATT_QLOAD(qc, cur, 0);
        __syncthreads();
        if (MODE < 2) { ATT_LOADKV(cur); ATT_WRITEKV(cur); }
        __syncthreads();
        if (MODE == 1) continue;
#pragma unroll 1
        for (int h = 0; h < cur.nh; ++h) {
            if (MODE == 4) { const bf16* qp_ = proj + (size_t)ql * INW + 8 * hh;
#pragma unroll
                for (int ks_ = 0; ks_ < 4; ++ks_) qc[ks_] = *(const bf16x8*)(qp_ + 16 * ks_); }
            else if (MODE != 0 || h > 0) ATT_QLOAD(qc, cur, h);
            const int ln = lane;
            f32x16 o0, o1; float m, l;
            if (cur.isB) {
                const int hq = cur.head + h;
                const float slope = exp2f(-0.5f * (float)(hq + 1));
                att_wave<128, MODE == 6>(ln, w, Ks, Vs, cur.q0 - 128 + 32 * w, cur.Lsub, qc, slope * LOG2E, o0, o1, m, l, MODE == 5 ? 4 : 0, MODE == 5 ? 5 : 9);
                const int l2 = fresh_lane(), hh2 = l2 >> 5; const int tok0_ = cur.rowbase + cur.r + cur.d * (cur.q0 + 32 * w + (l2 & 31)); const int tok = (MODE >= 2) ? (tok0_ & 255) : tok0_;
                const float sk2 = F.sink[hq] * LOG2E; const float mf = fmaxf(m, sk2);
                const float sc = __builtin_amdgcn_exp2f(m - mf); const float den = l * sc + __builtin_amdgcn_exp2f(sk2 - mf);
                if (MODE >= 3) { const float z_ = sc / den; asm volatile("" :: "v"(o0), "v"(o1), "v"(z_)); }
                else att_store(OB + (size_t)tok * 1024 + hq * 64, o0, o1, sc / den, hh2);
            } else {
                const float slope = exp2f(-0.25f * (float)(2 * cur.head + 1));
                att_wave<64, MODE == 6>(ln, w, Ks, Vs, cur.q0 - 64 + 32 * w, cur.Lsub, qc, slope * (float)cur.d * LOG2E, o0, o1, m, l, MODE == 5 ? 2 : 0, MODE == 5 ? 3 : 5);
                const int l2 = fresh_lane(), hh2 = l2 >> 5; const int tok0_ = cur.rowbase + cur.r + cur.d * (cur.q0 + 32 * w + (l2 & 31)); const int tok = (MODE >= 2) ? (tok0_ & 255) : tok0_;
                bf16* OA = (MODE >= 2) ? (bf16*)(outb + 150 * MiB) : (bf16*)(outb + OUT_OA + (size_t)cur.p * OUT_OA_STRIDE);
                float* LSE = (MODE >= 2) ? (float*)(outb + 152 * MiB) : (float*)(outb + OUT_LSE + (size_t)cur.p * OUT_LSE_STRIDE);
                if (MODE >= 3) { const float z_ = m + l; asm volatile("" :: "v"(o0), "v"(o1), "v"(z_)); }
                else { att_store(OA + (size_t)tok * 1024 + cur.head * 64, o0, o1, 1.0f / l, hh2);
                    if (hh2 == 0) LSE[(size_t)tok * 16 + cur.head] = m + __builtin_amdgcn_logf(l); }
            }
        }
    }
#undef ATT_LOADKV
#undef ATT_WRITEKV
#undef ATT_QLOAD
    __syncthreads();
}

__device__ __forceinline__ void p3_finalize(Frame& F) {
    const int gw = F.vcu * NWAVES + F.wave, NGW = F.G * NWAVES, lane = fresh_lane();
    const unsigned char* outb = (const unsigned char*)F.out;
    const bf16* OB = (const bf16*)(F.ws + WS_XN);
    unsigned char* MIXQ = F.ws + WS_MIXED; float* SA = (float*)(F.ws + WS_SA); bf16* MIXED = (bf16*)(F.ws + WS_MIXED); (void)MIXQ; (void)SA; (void)MIXED;
    const int head = lane >> 2;
    f32x4 gaq[4], gbq[4];
#pragma unroll
    for (int q = 0; q < 4; ++q) { gaq[q] = *(const f32x4*)(F.a_out_g + 16 * lane + 4 * q); gbq[q] = *(const f32x4*)(F.b_out_g + 16 * lane + 4 * q); }
    for (int t = gw; t < NT_TOK; t += NGW) {
        float ls[3]; v4u oa[3][2];
#pragma unroll
        for (int p = 0; p < 3; ++p) { ls[p] = ((const float*)(outb + OUT_LSE + (size_t)p * OUT_LSE_STRIDE))[(size_t)t * 16 + head];
            const v4u* src = (const v4u*)((const bf16*)(outb + OUT_OA + (size_t)p * OUT_OA_STRIDE) + (size_t)t * 1024 + 16 * lane); oa[p][0] = src[0]; oa[p][1] = src[1]; }
        const v4u* sb = (const v4u*)(OB + (size_t)t * 1024 + 16 * lane); const v4u ob0 = sb[0], ob1 = sb[1];
        const float mx = fmaxf(fmaxf(ls[0], ls[1]), ls[2]);
        float w0 = __builtin_amdgcn_exp2f(ls[0] - mx), w1 = __builtin_amdgcn_exp2f(ls[1] - mx), w2 = __builtin_amdgcn_exp2f(ls[2] - mx);
        const float inv = 1.0f / (w0 + w1 + w2); w0 *= inv; w1 *= inv; w2 *= inv;
        float a[16], b[16]; float sa = 0.f, sbq = 0.f;
#pragma unroll
        for (int q = 0; q < 2; ++q)
#pragma unroll
            for (int e = 0; e < 4; ++e) {
                const unsigned x0 = oa[0][q][e], x1 = oa[1][q][e], x2 = oa[2][q][e], y = (q == 0 ? ob0 : ob1)[e];
                const float lo = w0 * bflo(x0) + w1 * bflo(x1) + w2 * bflo(x2), hi = w0 * bfhi(x0) + w1 * bfhi(x1) + w2 * bfhi(x2);
                a[q * 8 + e * 2] = lo; a[q * 8 + e * 2 + 1] = hi; sa += lo * lo + hi * hi;
                const float bl = bflo(y), bh = bfhi(y); b[q * 8 + e * 2] = bl; b[q * 8 + e * 2 + 1] = bh; sbq += bl * bl + bh * bh; }
        const float ra = 1.0f / sqrtf(wave_sum(sa) * (1.0f / 1024.0f) + RMS_EPS), rb = 1.0f / sqrtf(wave_sum(sbq) * (1.0f / 1024.0f) + RMS_EPS);
#if P4_I8
        float am = 0.f;
#pragma unroll
        for (int q = 0; q < 2; ++q) {
            const f32x4 ga0 = *(const f32x4*)(F.a_out_g + 16 * lane + 8 * q), ga1 = *(const f32x4*)(F.a_out_g + 16 * lane + 8 * q + 4);
            const f32x4 gb0 = *(const f32x4*)(F.b_out_g + 16 * lane + 8 * q), gb1 = *(const f32x4*)(F.b_out_g + 16 * lane + 8 * q + 4);
#pragma unroll
            for (int e = 0; e < 4; ++e) { a[8 * q + e] *= ra * ga0[e]; a[8 * q + 4 + e] *= ra * ga1[e]; b[8 * q + e] *= rb * gb0[e]; b[8 * q + 4 + e] *= rb * gb1[e];
                am = fmaxf(am, fmaxf(fmaxf(fabsf(a[8 * q + e]), fabsf(a[8 * q + 4 + e])), fmaxf(fabsf(b[8 * q + e]), fabsf(b[8 * q + 4 + e])))); } }
#pragma unroll
        for (int o = 1; o < 64; o <<= 1) am = fmaxf(am, __shfl_xor(am, o));
        const float qinv = am > 0.f ? 127.0f / am : 0.f;
        v4u oa8, ob8;
#pragma unroll
        for (int q = 0; q < 4; ++q) { unsigned wa = 0, wb = 0;
#pragma unroll
            for (int e = 0; e < 4; ++e) { wa |= ((unsigned)(int)__builtin_rintf(a[4 * q + e] * qinv) & 0xffu) << (8 * e); wb |= ((unsigned)(int)__builtin_rintf(b[4 * q + e] * qinv) & 0xffu) << (8 * e); }
            oa8[q] = wa; ob8[q] = wb; }
        *(v4u*)(MIXQ + (size_t)t * DM + 16 * lane) = oa8; *(v4u*)(MIXQ + (size_t)t * DM + 1024 + 16 * lane) = ob8;
        if (lane == 0) SA[t] = am > 0.f ? am * (1.0f / 127.0f) : 1.0f;
#else
        v4u o[2], o2[2];
#pragma unroll
        for (int q = 0; q < 2; ++q) {
            const f32x4 ga0 = gaq[2 * q], ga1 = gaq[2 * q + 1];
            const f32x4 gb0 = gbq[2 * q], gb1 = gbq[2 * q + 1];
            o[q].x = pk2(a[8 * q + 0] * ra * ga0[0], a[8 * q + 1] * ra * ga0[1]); o[q].y = pk2(a[8 * q + 2] * ra * ga0[2], a[8 * q + 3] * ra * ga0[3]);
            o[q].z = pk2(a[8 * q + 4] * ra * ga1[0], a[8 * q + 5] * ra * ga1[1]); o[q].w = pk2(a[8 * q + 6] * ra * ga1[2], a[8 * q + 7] * ra * ga1[3]);
            o2[q].x = pk2(b[8 * q + 0] * rb * gb0[0], b[8 * q + 1] * rb * gb0[1]); o2[q].y = pk2(b[8 * q + 2] * rb * gb0[2], b[8 * q + 3] * rb * gb0[3]);
            o2[q].z = pk2(b[8 * q + 4] * rb * gb1[0], b[8 * q + 5] * rb * gb1[1]); o2[q].w = pk2(b[8 * q + 6] * rb * gb1[2], b[8 * q + 7] * rb * gb1[3]); }
        v4u* dst = (v4u*)(MIXED + (size_t)t * DM + 16 * lane); dst[0] = o[0]; dst[1] = o[1];
        v4u* dst2 = (v4u*)(MIXED + (size_t)t * DM + 1024 + 16 * lane); dst2[0] = o2[0]; dst2[1] = o2[1];
#endif
    }
}

__device__ __forceinline__ int f2key(float v) { const int b = __builtin_bit_cast(int, v); return b ^ ((b >> 31) & 0x7fffffff); }
__device__ __forceinline__ float key2f(int k) { return __builtin_bit_cast(float, k ^ ((k >> 31) & 0x7fffffff)); }
#define P6_CE(x, y) do { const int hi_ = max(x, y), lo_ = min(x, y); x = hi_; y = lo_; } while (0)
__device__ __forceinline__ void p6_sort16(int (&a)[16]) {
    P6_CE(a[0], a[1]); P6_CE(a[3], a[2]); P6_CE(a[4], a[5]); P6_CE(a[7], a[6]); P6_CE(a[8], a[9]); P6_CE(a[11], a[10]); P6_CE(a[12], a[13]); P6_CE(a[15], a[14]); P6_CE(a[0], a[2]); P6_CE(a[1], a[3]); P6_CE(a[6], a[4]); P6_CE(a[7], a[5]); P6_CE(a[8], a[10]); P6_CE(a[9], a[11]); P6_CE(a[14], a[12]); P6_CE(a[15], a[13]); P6_CE(a[0], a[1]); P6_CE(a[2], a[3]); P6_CE(a[5], a[4]); P6_CE(a[7], a[6]); P6_CE(a[8], a[9]); P6_CE(a[10], a[11]); P6_CE(a[13], a[12]); P6_CE(a[15], a[14]); P6_CE(a[0], a[4]); P6_CE(a[1], a[5]); P6_CE(a[2], a[6]); P6_CE(a[3], a[7]); P6_CE(a[12], a[8]); P6_CE(a[13], a[9]); P6_CE(a[14], a[10]); P6_CE(a[15], a[11]); P6_CE(a[0], a[2]); P6_CE(a[1], a[3]); P6_CE(a[4], a[6]); P6_CE(a[5], a[7]); P6_CE(a[10], a[8]); P6_CE(a[11], a[9]); P6_CE(a[14], a[12]); P6_CE(a[15], a[13]); P6_CE(a[0], a[1]); P6_CE(a[2], a[3]); P6_CE(a[4], a[5]); P6_CE(a[6], a[7]); P6_CE(a[9], a[8]); P6_CE(a[11], a[10]); P6_CE(a[13], a[12]); P6_CE(a[15], a[14]); P6_CE(a[0], a[8]); P6_CE(a[1], a[9]); P6_CE(a[2], a[10]); P6_CE(a[3], a[11]); P6_CE(a[4], a[12]); P6_CE(a[5], a[13]); P6_CE(a[6], a[14]); P6_CE(a[7], a[15]); P6_CE(a[0], a[4]); P6_CE(a[1], a[5]); P6_CE(a[2], a[6]); P6_CE(a[3], a[7]); P6_CE(a[8], a[12]); P6_CE(a[9], a[13]); P6_CE(a[10], a[14]); P6_CE(a[11], a[15]); P6_CE(a[0], a[2]); P6_CE(a[1], a[3]); P6_CE(a[4], a[6]); P6_CE(a[5], a[7]); P6_CE(a[8], a[10]); P6_CE(a[9], a[11]); P6_CE(a[12], a[14]); P6_CE(a[13], a[15]); P6_CE(a[0], a[1]); P6_CE(a[2], a[3]); P6_CE(a[4], a[5]); P6_CE(a[6], a[7]); P6_CE(a[8], a[9]); P6_CE(a[10], a[11]); P6_CE(a[12], a[13]); P6_CE(a[14], a[15]);
}
__device__ __forceinline__ void p6_merge16(int (&a)[16]) {
    P6_CE(a[0], a[8]); P6_CE(a[1], a[9]); P6_CE(a[2], a[10]); P6_CE(a[3], a[11]); P6_CE(a[4], a[12]); P6_CE(a[5], a[13]); P6_CE(a[6], a[14]); P6_CE(a[7], a[15]); P6_CE(a[0], a[4]); P6_CE(a[1], a[5]); P6_CE(a[2], a[6]); P6_CE(a[3], a[7]); P6_CE(a[8], a[12]); P6_CE(a[9], a[13]); P6_CE(a[10], a[14]); P6_CE(a[11], a[15]); P6_CE(a[0], a[2]); P6_CE(a[1], a[3]); P6_CE(a[4], a[6]); P6_CE(a[5], a[7]); P6_CE(a[8], a[10]); P6_CE(a[9], a[11]); P6_CE(a[12], a[14]); P6_CE(a[13], a[15]); P6_CE(a[0], a[1]); P6_CE(a[2], a[3]); P6_CE(a[4], a[5]); P6_CE(a[6], a[7]); P6_CE(a[8], a[9]); P6_CE(a[10], a[11]); P6_CE(a[12], a[13]); P6_CE(a[14], a[15]);
}
#undef P6_CE
__device__ __forceinline__ void p6_top16(int (&a)[16], const int (&b)[16]) {
#pragma unroll
    for (int i = 0; i < 16; ++i) a[i] = max(a[i], b[15 - i]);
    p6_merge16(a);
}
__device__ __forceinline__ void p6_top16_partner(int (&a)[16]) {
    int t[16];
#pragma unroll
    for (int i = 0; i < 16; ++i) t[i] = __shfl_xor(a[15 - i], 32);
#pragma unroll
    for (int i = 0; i < 16; ++i) a[i] = max(a[i], t[i]);
    p6_merge16(a);
}
template <bool FROM_LDS>
__device__ __forceinline__ void p6_task(unsigned char* ws, int lane, int h, int tok, const bf16* qrow_g, const LAS unsigned char* qrow_l, int rsw, LAS unsigned char* scr) {
    const int ql = lane & 31, hh = lane >> 5;
    const bf16* SK = (const bf16*)(ws + WS_SK);
    unsigned char* RE16b = ws + WS_RE16; float* RG = (float*)(ws + WS_RG);
    constexpr int INT_MINV = -2147483647 - 1;
    {
        int k1[2][16];
        bf16x8 kfa[1][8];
#define P6_LOADKF(BUF, STEP) do { const bf16* skb_ = SK + (size_t)(h * 2 + ((STEP) >> 2)) * 128 * 128 + (size_t)ql * 128 + 8 * hh + (size_t)((STEP) & 3) * 32 * 128; \
            _Pragma("unroll") for (int ks_ = 0; ks_ < 8; ++ks_) kfa[BUF][ks_] = *(const bf16x8*)(skb_ + 16 * ks_); } while (0)
        P6_LOADKF(0, 0);
#pragma unroll
        for (int p = 0; p < 2; ++p) {
            bf16x8 qf[8];
#pragma unroll
            for (int ks = 0; ks < 8; ++ks) qf[ks] = FROM_LDS ? *(const LAS bf16x8*)(qrow_l + (((16 * p + 2 * ks + hh) ^ rsw) << 4)) : *(const bf16x8*)(qrow_g + p * 128 + 8 * hh + 16 * ks);
            int g0[16], g1[16];
#pragma unroll
            for (int kt = 0; kt < 4; ++kt) { f32x16 s = (f32x16){};
                const int step = 4 * p + kt;
#pragma unroll
                for (int ks = 0; ks < 8; ++ks) s = __builtin_amdgcn_mfma_f32_32x32x16_bf16(kfa[0][ks], qf[ks], s, 0, 0, 0);
                __builtin_amdgcn_sched_barrier(0);
                if (step + 1 < 8) { P6_LOADKF(0, step + 1); }
                __builtin_amdgcn_sched_barrier(0);
                int g[16];
#pragma unroll
                for (int reg = 0; reg < 16; ++reg) { const int n = 32 * kt + (reg & 3) + 8 * (reg >> 2) + 4 * hh; g[reg] = (f2key(s[reg]) & ~127) | n; }
                p6_sort16(g);
                if (kt == 0) {
#pragma unroll
                    for (int i = 0; i < 16; ++i) g0[i] = g[i];
                } else if (kt == 1) p6_top16(g0, g);
                else if (kt == 2) {
#pragma unroll
                    for (int i = 0; i < 16; ++i) g1[i] = g[i];
                } else p6_top16(g1, g);
            }
            p6_top16(g0, g1);
            p6_top16_partner(g0);
#pragma unroll
            for (int i = 0; i < 16; ++i) k1[p][i] = g0[i];
        }
        float v1[16], v2[16];
#pragma unroll
        for (int i = 0; i < 16; ++i) { v1[i] = key2f(k1[0][i] & ~127); v2[i] = key2f(k1[1][i] & ~127); }
        { v4u w;
#pragma unroll
          for (int q = 0; q < 4; ++q) { unsigned x = 0;
#pragma unroll
              for (int c = 0; c < 4; ++c) x |= (unsigned)((hh ? k1[1][4 * q + c] : k1[0][4 * q + c]) & 127) << (8 * c);
              w[q] = x; }
          *(LAS v4u*)(scr + 16 * hh) = w; }
        int ca[16], cb[16];
#define P6_SLOT(k) ((k) < 16 ? ca[(k)] : cb[(k) - 16])
#define P6_CAND(k, Ia, Ja, Ib, Jb) do { const float sa_ = v1[Ia] + v2[Ja], sb_ = v1[Ib] + v2[Jb]; \
            const int key_ = (f2key(hh ? sb_ : sa_) & ~255) | (hh ? ((Ib) << 4 | (Jb)) : ((Ia) << 4 | (Ja))); if ((k) < 16) ca[(k) & 15] = key_; else cb[(k) & 15] = key_; } while (0)
        P6_CAND(0, 0, 0, 0, 1);
        P6_CAND(1, 0, 2, 0, 3);
        P6_CAND(2, 0, 4, 0, 5);
        P6_CAND(3, 0, 6, 0, 7);
        P6_CAND(4, 0, 8, 0, 9);
        P6_CAND(5, 0, 10, 0, 11);
        P6_CAND(6, 0, 12, 0, 13);
        P6_CAND(7, 0, 14, 0, 15);
        P6_CAND(8, 1, 0, 1, 1);
        P6_CAND(9, 1, 2, 1, 3);
        P6_CAND(10, 1, 4, 1, 5);
        P6_CAND(11, 1, 6, 1, 7);
        P6_CAND(12, 2, 0, 2, 1);
        P6_CAND(13, 2, 2, 2, 3);
        P6_CAND(14, 2, 4, 3, 0);
        P6_CAND(15, 3, 1, 3, 2);
        P6_CAND(16, 3, 3, 4, 0);
        P6_CAND(17, 4, 1, 4, 2);
        P6_CAND(18, 5, 0, 5, 1);
        P6_CAND(19, 6, 0, 6, 1);
        P6_CAND(20, 7, 0, 7, 1);
        P6_CAND(21, 8, 0, 9, 0);
        P6_CAND(22, 10, 0, 11, 0);
        P6_CAND(23, 12, 0, 13, 0);
        P6_CAND(24, 14, 0, 15, 0);
#undef P6_CAND
#undef P6_LOADKF
#undef P6_SLOT
#pragma unroll
        for (int i = 9; i < 16; ++i) cb[i] = INT_MINV;
        p6_sort16(ca); p6_sort16(cb); p6_top16(ca, cb); p6_top16_partner(ca);
        asm volatile("s_waitcnt lgkmcnt(0)" ::: "memory");
        float top[16], gs = 0.f;
        const float smax = key2f(ca[0] & ~255);
#pragma unroll
        for (int i = 0; i < 16; ++i) ca[i] = ((ca[i] & 255) << 24) | (int)((unsigned)ca[i] >> 8);
        p6_sort16(ca);
#pragma unroll
        for (int i = 0; i < 16; ++i) ca[i] = (ca[i] << 8) | ((ca[i] >> 24) & 255);
#pragma unroll
        for (int i = 0; i < 16; ++i) { top[i] = key2f(ca[i] & ~255); }
#pragma unroll
        for (int i = 0; i < 16; ++i) { top[i] = __expf(top[i] - smax); gs += top[i]; }
        const float ginv = 1.0f / gs;
        unsigned short* re = (unsigned short*)(RE16b + (size_t)tok * 256) + 2 * h + hh;
        float gq[8];
#pragma unroll
        for (int r = 0; r < 8; ++r) { const int key = hh ? ca[r + 8] : ca[r]; const int ci = (key >> 4) & 15, cj = key & 15;
            const int e = (int)scr[ci] * 128 + (int)scr[16 + cj];
            re[r * 16] = (unsigned short)e; gq[r] = (hh ? top[r + 8] : top[r]) * ginv; }
        float* rg = RG + ((size_t)tok * 8 + h) * 16 + 8 * hh;
        *(f32x4*)rg = (f32x4){gq[0], gq[1], gq[2], gq[3]}; *(f32x4*)(rg + 4) = (f32x4){gq[4], gq[5], gq[6], gq[7]};
        asm volatile("s_waitcnt lgkmcnt(0)" ::: "memory");
    }
}
__device__ __forceinline__ void p6_route(Frame& F) {
    const int gw = F.vcu * NWAVES + F.wave, NGW = F.G * NWAVES, lane = fresh_lane(), ql = lane & 31;
    const bf16* Q = (const bf16*)(F.ws + WS_MIXED);
    LAS unsigned char* scr = F.lds + F.wave * 1024 + ql * 32;
#pragma unroll 1
    for (int task = gw; task < 768 * 8; task += NGW) {
        const int h = task / 768, tile = task % 768, tok = tile * 32 + ql;
        p6_task<false>(F.ws, lane, h, tok, Q + (size_t)tok * DM + h * 256, nullptr, 0, scr);
    }
}
template <bool I8_>
struct EpiRouteT {
    static constexpr bool PERM = true, AFTER_DRAIN = true, I8 = I8_;
    const float* ss; unsigned char* ws; const float* sx; const float* sw;
    __device__ __forceinline__ void fused(typename pg8::AccT<I8_>::type (&acc)[2][2][4][2], const pg8::Unit& u, int wr, int wc, int fr, int fq, LAS unsigned char* lds, int wid, int lane) const {
        LAS float* rsl = (LAS float*)(lds + 131072 + 10240);
        if (lane < 32) { const int r = 32 * wid + lane;
            const f32x4* p = (const f32x4*)(ss + (size_t)(u.pm * 256 + r) * 32); f32x4 v[8];
#pragma unroll
            for (int i = 0; i < 8; ++i) v[i] = p[i];
            float s = 0.f;
#pragma unroll
            for (int i = 0; i < 8; ++i) s += (v[i][0] + v[i][1]) + (v[i][2] + v[i][3]);
            float sc = 1.0f / sqrtf(s * (1.0f / 2048.0f) + 1e-6f);
            if (I8_) sc *= sx[u.pm * 256 + r];
            rsl[r] = sc; }
        asm volatile("s_waitcnt lgkmcnt(0)" ::: "memory"); __builtin_amdgcn_s_barrier(); asm volatile("" ::: "memory");
#pragma unroll
        for (int ai = 0; ai < 2; ++ai)
#pragma unroll
            for (int m = 0; m < 4; ++m) {
                const int r = 128 * ai + 64 * wr + 16 * m + fr;
                const float sc = rsl[r];
#pragma unroll
                for (int bj = 0; bj < 2; ++bj) { f32x4 v0, v1;
                    if constexpr (I8_) { const int cb = u.pn * 256 + 128 * bj + 32 * wc + 8 * fq; const f32x4 w0 = *(const f32x4*)(sw + cb), w1 = *(const f32x4*)(sw + cb + 4);
                        const pg8::i32x4 a0 = acc[ai][bj][m][0], a1 = acc[ai][bj][m][1];
                        v0 = (f32x4){(float)a0[0], (float)a0[1], (float)a0[2], (float)a0[3]} * w0 * sc; v1 = (f32x4){(float)a1[0], (float)a1[1], (float)a1[2], (float)a1[3]} * w1 * sc; }
                    else { v0 = acc[ai][bj][m][0] * sc; v1 = acc[ai][bj][m][1] * sc; }
                    v4u w; w.x = pk2(v0[0], v0[1]); w.y = pk2(v0[2], v0[3]); w.z = pk2(v1[0], v1[1]); w.w = pk2(v1[2], v1[3]);
                    const int c = 16 * bj + 4 * wc + fq;
                    *(LAS v4u*)(lds + r * 512 + ((c ^ (r & 15)) << 4)) = w; } }
        asm volatile("s_waitcnt lgkmcnt(0)" ::: "memory"); __builtin_amdgcn_s_barrier(); asm volatile("" ::: "memory");
        const int ql = lane & 31, rowl = 32 * wid + ql;
        p6_task<true>(ws, lane, u.pn, u.pm * 256 + rowl, nullptr, lds + rowl * 512, rowl & 15, lds + 131072 + 1024 + wid * 1024 + ql * 32);
        asm volatile("s_waitcnt lgkmcnt(0)" ::: "memory"); __builtin_amdgcn_s_barrier(); asm volatile("" ::: "memory");
    }
};


template <int CTRL> __device__ __forceinline__ int dpp_i(int x) { return __builtin_amdgcn_update_dpp(0, x, CTRL, 0xf, 0xf, true); }
__device__ __forceinline__ int red8_add(int v) { v += dpp_i<0xB1>(v); v += dpp_i<0x4E>(v); v += dpp_i<0x141>(v); return v; }
__device__ __forceinline__ float red8_max(float v) {
    v = fmaxf(v, __builtin_bit_cast(float, dpp_i<0xB1>(__builtin_bit_cast(int, v)))); v = fmaxf(v, __builtin_bit_cast(float, dpp_i<0x4E>(__builtin_bit_cast(int, v))));
    v = fmaxf(v, __builtin_bit_cast(float, dpp_i<0x141>(__builtin_bit_cast(int, v)))); return v; }
struct SliceOwn { unsigned n_mine, vx, npop; };
__device__ __forceinline__ SliceOwn slice_census(unsigned* bar, unsigned x) {
    SliceOwn s; s.n_mine = 1u; s.vx = 0u; s.npop = 0u;
#pragma unroll
    for (unsigned j = 0; j < 16; ++j) { const unsigned c = (unsigned)__builtin_amdgcn_readfirstlane((int)xb_ld(&bar[XB_XCNT(j)])); if (c > 0u) { if (j < x) ++s.vx; ++s.npop; } if (j == x) s.n_mine = c > 0u ? c : 1u; }
    if (s.npop == 0u) s.npop = 1u;
    return s;
}
#define P7_EID(R0, R1, i) ((((i) & 1) ? (((i) < 8 ? R0 : R1)[((i) >> 1) & 3] >> 16) : (((i) < 8 ? R0 : R1)[((i) >> 1) & 3] & 0xffffu)))

__device__ __forceinline__ void p7a_udots(Frame& F, unsigned* bar, unsigned x, unsigned rank) {
    const int lane = fresh_lane(), r = lane >> 3, seg = lane & 7;
    const SliceOwn so = slice_census(bar, x);
    const int gwl = (int)rank * NWAVES + F.wave, stride = (int)so.n_mine * NWAVES;
    const bf16* X2B = (const bf16*)(F.ws + WS_X2B); const unsigned char* RE16b = F.ws + WS_RE16;
#pragma unroll 1
    for (int pass = 0; pass < 16; ++pass) {
        const int hs = (2 * (int)so.vx + pass) & 15; if ((unsigned)(hs >> 1) % so.npop != so.vx) continue;
        float* PD = (float*)(F.ws + (hs < 8 ? WS_PD0 : WS_PD1)) + (size_t)(hs & 7) * NT_TOK * 128;
        const unsigned char* Ub = F.ws + WS_U + (size_t)hs * (16384 * 128) + 16 * seg;
        const unsigned char* rp0 = RE16b + r * 32; const bf16* xp0 = X2B + 128 * hs + 16 * seg;
#define P7A_LOADA(R0, R1, X0, X1, t) do { const int tt_ = (t) < NT_TOK ? (t) : NT_TOK - 1; const unsigned char* rp_ = rp0 + (size_t)tt_ * 256; R0 = *(const v4u*)rp_; R1 = *(const v4u*)(rp_ + 16); \
            const bf16* xp_ = xp0 + (size_t)tt_ * DM; X0 = *(const v4u*)xp_; X1 = *(const v4u*)(xp_ + 8); } while (0)
#define P7A_ISSUE(G, R0, R1) do { __builtin_amdgcn_s_setprio(3); _Pragma("unroll") for (int i_ = 0; i_ < 16; ++i_) { const unsigned e_ = P7_EID(R0, R1, i_); G[i_] = *(const v4u*)(Ub + (size_t)e_ * 128); } __builtin_amdgcn_s_setprio(0); } while (0)
#define P7A_COMP(G, X0, X1, t) do { float xf_[16]; float am_ = 0.f; \
            _Pragma("unroll") for (int c_ = 0; c_ < 4; ++c_) { xf_[2 * c_] = bflo(X0[c_]); xf_[2 * c_ + 1] = bfhi(X0[c_]); xf_[8 + 2 * c_] = bflo(X1[c_]); xf_[8 + 2 * c_ + 1] = bfhi(X1[c_]); } \
            _Pragma("unroll") for (int c_ = 0; c_ < 16; ++c_) am_ = fmaxf(am_, fabsf(xf_[c_])); \
            am_ = red8_max(am_); const float inv_ = am_ > 0.f ? 127.0f / am_ : 0.f, hsc_ = am_ * (1.0f / 127.0f); \
            int hq_[4]; _Pragma("unroll") for (int w_ = 0; w_ < 4; ++w_) { unsigned p_ = 0; _Pragma("unroll") for (int c_ = 0; c_ < 4; ++c_) p_ |= ((unsigned)(int)__builtin_rintf(xf_[4 * w_ + c_] * inv_) & 0xffu) << (8 * c_); hq_[w_] = (int)p_; } \
            int res0_ = 0, res1_ = 0; \
            _Pragma("unroll") for (int i_ = 0; i_ < 16; ++i_) { int d_ = 0; _Pragma("unroll") for (int w_ = 0; w_ < 4; ++w_) d_ = __builtin_amdgcn_sdot4((int)G[i_][w_], hq_[w_], d_, false); \
                d_ = red8_add(d_); if ((i_ & 7) == seg) { if (i_ < 8) res0_ = d_; else res1_ = d_; } } \
            if ((t) < NT_TOK) { float* pd_ = PD + (size_t)(t) * 128 + 8 * seg + r; pd_[0] = (float)res0_ * hsc_; pd_[64] = (float)res1_ * hsc_; } } while (0)
        v4u GA[16], GB[16], ra0, ra1, xa0, xa1, rb0, rb1, xb0, xb1, xA0, xA1, xB0, xB1;
        P7A_LOADA(ra0, ra1, xa0, xa1, gwl);
        P7A_LOADA(rb0, rb1, xb0, xb1, gwl + stride);
        P7A_ISSUE(GA, ra0, ra1); xA0 = xa0; xA1 = xa1;
#pragma unroll 1
        for (int t = gwl; t < NT_TOK; t += 2 * stride) {
            P7A_LOADA(ra0, ra1, xa0, xa1, t + 2 * stride); P7A_ISSUE(GB, rb0, rb1); xB0 = xb0; xB1 = xb1; P7A_COMP(GA, xA0, xA1, t);
            P7A_LOADA(rb0, rb1, xb0, xb1, t + 3 * stride); P7A_ISSUE(GA, ra0, ra1); xA0 = xa0; xA1 = xa1; P7A_COMP(GB, xB0, xB1, t + stride);
        }
#undef P7A_LOADA
#undef P7A_ISSUE
#undef P7A_COMP
    }
}
__device__ __forceinline__ void p7b_coef(Frame& F) {
    const int gw = F.vcu * NWAVES + F.wave, NGW = F.G * NWAVES, lane = fresh_lane();
    const float* PD0 = (const float*)(F.ws + WS_PD0); const float* PD1 = (const float*)(F.ws + WS_PD1);
    const unsigned char* RE16b = F.ws + WS_RE16; const float* RG = (const float*)(F.ws + WS_RG); const float* SS = (const float*)(F.ws + WS_SS);
    const float* US = (const float*)(F.ws + WS_US); const float* VS = (const float*)(F.ws + WS_VS);
    unsigned* CQ = (unsigned*)(F.ws + WS_CQ); float* SCQ = (float*)(F.ws + WS_SCQ);
#pragma unroll 1
    for (int t = gw; t < NT_TOK; t += NGW) {
        float da = 0.f, db = 0.f;
#pragma unroll
        for (int hs = 0; hs < 8; ++hs) { const size_t o = ((size_t)hs * NT_TOK + t) * 128 + lane; da += PD0[o] + PD1[o]; db += PD0[o + 64] + PD1[o + 64]; }
        float rstd; { const float sp = (lane < 32) ? SS[(size_t)t * 32 + lane] : 0.f; rstd = 1.0f / sqrtf(wave_sum(sp) * (1.0f / DM) + RMS_EPS); }
        const unsigned short* rp = (const unsigned short*)(RE16b + (size_t)t * 256 + (lane & 7) * 32) + (lane >> 3);
        const int ea = rp[0], eb = rp[8];
        const float ga = RG[(size_t)t * 128 + lane], gb = RG[(size_t)t * 128 + 64 + lane];
        const float za = da * US[ea] * rstd, zb = db * US[eb] * rstd;
        const float ca = ga * 0.5f * za * (1.0f + erff(za * 0.70710678118654752f)) * VS[ea], cb = gb * 0.5f * zb * (1.0f + erff(zb * 0.70710678118654752f)) * VS[eb];
        float am = fmaxf(fabsf(ca), fabsf(cb));
#pragma unroll
        for (int o = 1; o < 64; o <<= 1) am = fmaxf(am, __shfl_xor(am, o));
        const float inv = am > 0.f ? 127.0f / am : 0.f;
        const int qa = (int)__builtin_rintf(ca * inv) & 0xff, qb = (int)__builtin_rintf(cb * inv) & 0xff;
        const int wa = qa | (__shfl_down(qa, 8) << 8) | (__shfl_down(qa, 16) << 16) | (__shfl_down(qa, 24) << 24);
        const int wb = qb | (__shfl_down(qb, 8) << 8) | (__shfl_down(qb, 16) << 16) | (__shfl_down(qb, 24) << 24);
        if (((lane >> 3) & 3) == 0) { unsigned* cq = CQ + (size_t)t * 32 + (lane & 7) * 4 + (lane >> 5); cq[0] = (unsigned)wa; cq[2] = (unsigned)wb; }
        if (lane == 0) SCQ[t] = am * (1.0f / 127.0f);
    }
}

#if P7A_INV
__device__ __forceinline__ void lds_inc(LAS unsigned* p) { (void)__hip_atomic_fetch_add(p, 1u, __ATOMIC_RELAXED, __HIP_MEMORY_SCOPE_WORKGROUP); }
__device__ __forceinline__ unsigned lds_inc_rtn(LAS unsigned* p) { return __hip_atomic_fetch_add(p, 1u, __ATOMIC_RELAXED, __HIP_MEMORY_SCOPE_WORKGROUP); }
__device__ __forceinline__ void p6a_hist(Frame& F) {
    const int lane = fresh_lane(), tid = F.wave * 64 + lane;
    LAS unsigned* cnt = (LAS unsigned*)F.lds;
    unsigned* H = (unsigned*)(F.ws + WS_H); const float* SS = (const float*)(F.ws + WS_SS); float* RSTD2 = (float*)(F.ws + WS_RSTD2);
#pragma unroll 1
    for (int j = F.vcu; j < IG_NSUB; j += F.G) {
        cnt[tid] = 0u; cnt[tid + 512] = 0u;
        __syncthreads();
        const v4u* re = (const v4u*)(F.ws + WS_RE16 + (size_t)j * IG_SUBT * 256);
        v4u rv[3];
#pragma unroll
        for (int k = 0; k < 3; ++k) rv[k] = re[tid + 512 * k];
#pragma unroll
        for (int k = 0; k < 3; ++k) { const v4u v = rv[k];
#pragma unroll
            for (int c = 0; c < 4; ++c) { lds_inc(&cnt[(v[c] & 0xffffu) >> 4]); lds_inc(&cnt[v[c] >> 20]); } }
        if (tid < IG_SUBT) { const int t = j * IG_SUBT + tid; const f32x4* p = (const f32x4*)(SS + (size_t)t * 32); float s = 0.f;
#pragma unroll
            for (int i = 0; i < 8; ++i) { const f32x4 v = p[i]; s += (v[0] + v[1]) + (v[2] + v[3]); }
            float rs_ = 1.0f / sqrtf(s * (1.0f / DM) + RMS_EPS);
#if P7A_X2Q
            rs_ *= ((const float*)(F.ws + WS_SX2))[t];
#endif
            RSTD2[t] = rs_; }
        __syncthreads();
        H[j * 1024 + tid] = cnt[tid]; H[j * 1024 + tid + 512] = cnt[tid + 512];
        __syncthreads();
    }
}
__device__ __forceinline__ void p6b_scatter(Frame& F) {
    const int lane = fresh_lane(), tid = F.wave * 64 + lane;
    LAS unsigned* cnt = (LAS unsigned*)F.lds; LAS unsigned* wsum = cnt + 1024;
    const unsigned* H = (const unsigned*)(F.ws + WS_H); unsigned* L = (unsigned*)(F.ws + WS_L); unsigned* TL = (unsigned*)(F.ws + WS_TL);
#pragma unroll 1
    for (int j = F.vcu; j < IG_NSUB; j += F.G) {
        const int g = j / IG_SPG, c = j % IG_SPG;
        unsigned t0 = 0, t1 = 0, p0 = 0, p1 = 0;
#pragma unroll
        for (int cc = 0; cc < IG_SPG; ++cc) { const v2u h = *(const v2u*)(H + (size_t)(IG_SPG * g + cc) * 1024 + 2 * tid); t0 += h.x; t1 += h.y; if (cc < c) { p0 += h.x; p1 += h.y; } }
        const unsigned k0 = t0 | (((t0 + 15u) >> 4) << 18), k1 = t1 | (((t1 + 15u) >> 4) << 18), s = k0 + k1;
        unsigned inc = s;
#pragma unroll
        for (int o = 1; o < 64; o <<= 1) { const unsigned v = (unsigned)__shfl_up((int)inc, o); if (lane >= o) inc += v; }
        if (lane == 63) wsum[F.wave] = inc;
        __syncthreads();
        unsigned wo = 0;
#pragma unroll
        for (int w = 0; w < 8; ++w) { const unsigned v = wsum[w]; if (w < F.wave) wo += v; }
        const unsigned e0 = wo + inc - s, e1 = e0 + k0;
        cnt[2 * tid] = (e0 & 0x3ffffu) + p0; cnt[2 * tid + 1] = (e1 & 0x3ffffu) + p1;
        if (c == 0) { unsigned* of = TL + (size_t)g * 1040; of[2 * tid] = e0 & 0x3ffffu; of[2 * tid + 1] = e1 & 0x3ffffu; if (tid == 511) of[1024] = (e1 & 0x3ffffu) + t1; }
        __syncthreads();
        const v4u* re = (const v4u*)(F.ws + WS_RE16 + (size_t)j * IG_SUBT * 256);
        unsigned* Lg = L + (size_t)g * IG_PICKS;
        v4u rv[3];
#pragma unroll
        for (int k = 0; k < 3; ++k) rv[k] = re[tid + 512 * k];
#pragma unroll
        for (int k = 0; k < 3; ++k) { const v4u v = rv[k]; const unsigned ix0 = (unsigned)(tid + 512 * k) * 8u;
            const unsigned tl7 = ((unsigned)c * IG_SUBT + (ix0 >> 7)) << 7, ri0 = ix0 & 127u;
#pragma unroll
            for (int cc = 0; cc < 8; ++cc) { const unsigned e = (cc & 1) ? (v[cc >> 1] >> 16) : (v[cc >> 1] & 0xffffu); const unsigned ri = ri0 + cc, pair = 8u * (ri & 15u) + (ri >> 4);
                const unsigned pos = lds_inc_rtn(&cnt[e >> 4]); Lg[pos] = (e << 17) | tl7 | pair; } }
        __syncthreads();
    }
}
typedef int v4i __attribute__((ext_vector_type(4)));
__device__ __forceinline__ float red16_max(float v) { v = red8_max(v); return fmaxf(v, __builtin_bit_cast(float, dpp_i<0x140>(__builtin_bit_cast(int, v)))); }
template <int MODE  >
__device__ __forceinline__ void p7a_inv(Frame& F, unsigned* bar, unsigned x, unsigned rank) {
    const int lane = fresh_lane();
    const SliceOwn so = slice_census(bar, x);
    const bf16* X2B = (const bf16*)(F.ws + WS_X2B);
    const unsigned* L = (const unsigned*)(F.ws + WS_L); const unsigned* OFF = (const unsigned*)(F.ws + WS_TL);
    LAS unsigned* OFl = (LAS unsigned*)(F.lds + 2048);
    LAS unsigned char* XS = F.lds + 8192;
#pragma unroll 1
    for (int sp = 0; sp < 8; ++sp) {
        if ((unsigned)sp % so.npop != so.vx) continue;
#pragma unroll 1
        for (int g = (int)rank; g < IG_NGRP; g += (int)so.n_mine) {
            {
                const int r4 = lane >> 4, seg = lane & 15;
                const bf16* xp0 = X2B + (size_t)(g * IG_TOK + r4) * DM + 256 * sp + 16 * seg;
#if P7A_X2Q
                {
                    const unsigned char* qp0 = (const unsigned char*)F.out + OUT_X2Q + (size_t)(g * IG_TOK + r4) * DM + 256 * sp + 16 * seg;
                    v4u XQv[12];
#pragma unroll
                    for (int k = 0; k < 12; ++k) XQv[k] = *(const v4u*)(qp0 + (size_t)(F.wave + k * NWAVES) * 4 * DM);
#pragma unroll
                    for (int k = 0; k < 12; ++k) { const int tl = (F.wave + k * NWAVES) * 4 + r4; *(LAS v4u*)(XS + tl * IG_PITCH + seg * 16) = XQv[k]; }
                }
#else
#pragma unroll 1
                for (int it0 = F.wave; it0 < IG_TOK / 4; it0 += 4 * NWAVES) {
                    v4u XA[4], XB[4];
#pragma unroll
                    for (int k = 0; k < 4; ++k) { const int it = it0 + k * NWAVES < IG_TOK / 4 ? it0 + k * NWAVES : it0; const bf16* xp = xp0 + (size_t)it * 4 * DM; XA[k] = *(const v4u*)xp; XB[k] = *(const v4u*)(xp + 8); }
#pragma unroll
                    for (int k = 0; k < 4; ++k) { const int it = it0 + k * NWAVES; if (it < IG_TOK / 4) { const v4u X0 = XA[k], X1 = XB[k];
                    float xf[16]; float am = 0.f;
#pragma unroll
                    for (int c = 0; c < 4; ++c) { xf[2 * c] = bflo(X0[c]); xf[2 * c + 1] = bfhi(X0[c]); xf[8 + 2 * c] = bflo(X1[c]); xf[8 + 2 * c + 1] = bfhi(X1[c]); }
#pragma unroll
                    for (int c = 0; c < 16; ++c) am = fmaxf(am, fabsf(xf[c]));
                    am = red16_max(am); const float inv = am > 0.f ? 127.0f / am : 0.f;
                    v4u hq;
#pragma unroll
                    for (int w = 0; w < 4; ++w) { unsigned p = 0;
#pragma unroll
                        for (int c = 0; c < 4; ++c) p |= ((unsigned)(int)__builtin_rintf(xf[4 * w + c] * inv) & 0xffu) << (8 * c);
                        hq[w] = p; }
                    const int tl = it * 4 + r4;
                    *(LAS v4u*)(XS + tl * IG_PITCH + seg * 16) = hq;
                    if (seg == 0) *(LAS float*)(XS + tl * IG_PITCH + 256) = am * (1.0f / 127.0f); } }
                }
#endif
                const int tid = F.wave * 64 + lane;
                OFl[tid] = OFF[(size_t)g * 1040 + tid]; OFl[tid + 512] = OFF[(size_t)g * 1040 + tid + 512]; if (tid < 8) OFl[1024 + tid] = OFF[(size_t)g * 1040 + 1024];
            }
            __syncthreads();
            {
                const int lane2 = fresh_lane(), i16 = lane2 & 15; const unsigned q = (unsigned)lane2 >> 4, qsh = q << 4;
                const unsigned* Lgu = L + (size_t)g * IG_PICKS;
                float* PDu = (float*)(F.ws + ((MODE & 4) ? WS_PD1 : WS_PD0)) + (size_t)sp * NT_TOK * 128 + (size_t)g * IG_PICKS;
                const unsigned char* Ub = F.ws + WS_U + (size_t)sp * (1024 * 4096) + lane2 * 16;
                const unsigned stg_ = 112640u + (unsigned)F.wave * 768u + (unsigned)lane2 * 4u, own_ = 112640u + (unsigned)F.wave * 768u + (unsigned)i16 * 4u, dmy_ = stg_ + 256u;
                float* DMG = (float*)(F.ws + WS_NTL); (void)DMG;
                const __amdgpu_buffer_rsrc_t rsU = __builtin_amdgcn_make_buffer_rsrc((void*)(F.ws + WS_U + (size_t)sp * (1024 * 4096)), 0, 1024 * 4096, 0x00020000);
                const __amdgpu_buffer_rsrc_t rsL = __builtin_amdgcn_make_buffer_rsrc((void*)Lgu, 0, (IG_PICKS + 256) * 4, 0x00020000);
                const __amdgpu_buffer_rsrc_t rsP = __builtin_amdgcn_make_buffer_rsrc((void*)PDu, 0, IG_PICKS * 4, 0x00020000);
                const int voU = lane2 * 16, voL = i16 * 4;
#define IG_LDU(B, M) __builtin_bit_cast(v4i, __builtin_amdgcn_raw_buffer_load_b128(rsU, voU, (B) * 4096 + (M) * 1024, 0))
#define IG_LDR(P) __builtin_amdgcn_raw_buffer_load_b32(rsL, voL, (int)((P) * 4u), 0)
#define IG_OFF(b) ((unsigned)__builtin_amdgcn_readfirstlane((int)OFl[b]))
#define IG_LD(j, R) do { const unsigned rec_ = R[j]; const unsigned t_ = ((MODE & 16) ? (unsigned)i16 : __builtin_amdgcn_ubfe(rec_, 7, 10)) * (unsigned)IG_PITCH + qsh; \
                    B0[j] = *(const LAS v4i*)(XS + t_); B1[j] = *(const LAS v4i*)(XS + t_ + 64); B2[j] = *(const LAS v4i*)(XS + t_ + 128); B3[j] = *(const LAS v4i*)(XS + t_ + 192); \
                    if (!P7A_X2Q) hv[j] = *(const LAS float*)(XS + (t_ - qsh) + 256); } while (0)
#define IG_MM(j, A) do { if (MODE & 8) { B0[j] = B0[j] | B1[j] | B2[j] | B3[j]; break; } const v4i z_ = {0, 0, 0, 0}; B0[j] = __builtin_amdgcn_mfma_i32_16x16x64_i8(A[0], B0[j], z_, 0, 0, 0); B0[j] = __builtin_amdgcn_mfma_i32_16x16x64_i8(A[1], B1[j], B0[j], 0, 0, 0); \
                    B0[j] = __builtin_amdgcn_mfma_i32_16x16x64_i8(A[2], B2[j], B0[j], 0, 0, 0); B0[j] = __builtin_amdgcn_mfma_i32_16x16x64_i8(A[3], B3[j], B0[j], 0, 0, 0); } while (0)
#define IG_ST(j, R) do { const unsigned rec_ = R[j]; const int lo_ = (rec_ & 0x20000u) ? B0[j][1] : B0[j][0], hi_ = (rec_ & 0x20000u) ? B0[j][3] : B0[j][2], val_ = (rec_ & 0x40000u) ? hi_ : lo_; \
                    const float o_ = P7A_X2Q ? (float)val_ : (float)val_ * hv[j]; \
                    *(LAS float*)(F.lds + (__builtin_amdgcn_ubfe(rec_, 19, 2) == q ? own_ : dmy_) + 64 * (j)) = o_; } while (0)
#define IG_STG(R, P0, NREM) do { const unsigned rec_ = R[0]; const int lo_ = (rec_ & 0x20000u) ? B0[0][1] : B0[0][0], hi_ = (rec_ & 0x20000u) ? B0[0][3] : B0[0][2], val_ = (rec_ & 0x40000u) ? hi_ : lo_; \
                    const float o_ = P7A_X2Q ? (float)val_ : (float)val_ * hv[0]; \
                    if (__builtin_amdgcn_ubfe(rec_, 19, 2) == q && (unsigned)i16 < (NREM)) (PDu + (P0))[i16] = o_; } while (0)
#define IG_BIDX(BI) (F.wave + NWAVES * (BI))
#define IG_BLOCK(AC, RC, AN, RN, BI) do { \
                    const unsigned s4_ = (unsigned)__builtin_amdgcn_readfirstlane((int)vS), e4_ = (unsigned)__builtin_amdgcn_readfirstlane((int)vE);     \
                    { const int b5_ = IG_BIDX((BI) + 4) < 1023 ? IG_BIDX((BI) + 4) : 1023; vS = OFl[b5_]; vE = OFl[b5_ + 1]; } \
                    const int bp_ = IG_BIDX((BI) + 3), bpc_ = (MODE & 1) ? 0 : (bp_ < 1023 ? bp_ : 1023); \
                    v4i B0[4], B1[4], B2[4], B3[4]; float hv[4]; \
                    const unsigned nrem_ = e0 - s0; const bool h3_ = nrem_ > 48u; \
                    IG_LD(0, RC); IG_LD(1, RC); IG_LD(2, RC); \
                    if (h3_) IG_LD(3, RC); \
                    __builtin_amdgcn_sched_barrier(0); \
                    AN[0] = IG_LDU(bpc_, 0); AN[1] = IG_LDU(bpc_, 1); \
                    __builtin_amdgcn_sched_barrier(0); \
                    IG_MM(0, AC); IG_MM(1, AC); \
                    __builtin_amdgcn_sched_barrier(0); \
                    AN[2] = IG_LDU(bpc_, 2); AN[3] = IG_LDU(bpc_, 3); \
                    __builtin_amdgcn_sched_barrier(0); \
                    IG_MM(2, AC); \
                    IG_ST(0, RC); IG_ST(1, RC); \
                    __builtin_amdgcn_sched_barrier(0); \
                    RN[0] = IG_LDR(((MODE & 2) ? 0u : s4_)); RN[1] = IG_LDR(((MODE & 2) ? 0u : s4_) + 16u); \
                    __builtin_amdgcn_sched_barrier(0); \
                    IG_ST(2, RC); \
                    if (h3_) { IG_MM(3, AC); IG_ST(3, RC); } \
                    __builtin_amdgcn_sched_barrier(0); \
                    RN[2] = IG_LDR(((MODE & 2) ? 0u : s4_) + 32u); RN[3] = IG_LDR(((MODE & 2) ? 0u : s4_) + 48u); \
                    __builtin_amdgcn_sched_barrier(0); \
                    { const float v_ = *(const LAS float*)(F.lds + stg_); __builtin_amdgcn_raw_buffer_store_b32(__builtin_bit_cast(unsigned, v_), rsP, (unsigned)lane2 < nrem_ ? lane2 * 4 : 0x7fffff00, (int)(s0 * 4u), 0); }     \
                    _Pragma("unroll 1") for (unsigned tb_ = s0 + 64u; tb_ < e0; tb_ += 16u) {     \
                        unsigned rr_[1]; rr_[0] = (Lgu + tb_)[i16]; IG_LD(0, rr_); IG_MM(0, AC); IG_STG(rr_, tb_, e0 - tb_); } \
                    s0 = s1; e0 = e1; s1 = s2; e1 = e2; s2 = s4_; e2 = e4_; } while (0)
#define IG_LOADSET(A, R, B, S) do { A[0] = IG_LDU(B, 0); A[1] = IG_LDU(B, 1); A[2] = IG_LDU(B, 2); A[3] = IG_LDU(B, 3); \
                    _Pragma("unroll") for (int j_ = 0; j_ < 4; ++j_) R[j_] = IG_LDR((S) + 16u * j_); } while (0)
                unsigned s0 = IG_OFF(IG_BIDX(0)), e0 = IG_OFF(IG_BIDX(0) + 1), s1 = IG_OFF(IG_BIDX(1)), e1 = IG_OFF(IG_BIDX(1) + 1), s2 = IG_OFF(IG_BIDX(2)), e2 = IG_OFF(IG_BIDX(2) + 1);
                unsigned vS = OFl[IG_BIDX(3)], vE = OFl[IG_BIDX(3) + 1];
                v4i A0s[4], A1s[4], A2s[4], A3s[4]; unsigned R0s[4], R1s[4], R2s[4], R3s[4];
                IG_LOADSET(A0s, R0s, IG_BIDX(0), s0); IG_LOADSET(A1s, R1s, IG_BIDX(1), s1); IG_LOADSET(A2s, R2s, IG_BIDX(2), s2);
#pragma unroll 1
                for (int bi = 0; bi < 128; bi += 4) { IG_BLOCK(A0s, R0s, A3s, R3s, bi); IG_BLOCK(A1s, R1s, A0s, R0s, bi + 1); IG_BLOCK(A2s, R2s, A1s, R1s, bi + 2); IG_BLOCK(A3s, R3s, A2s, R2s, bi + 3); }
#undef IG_BIDX
#undef IG_LOADSET
#undef IG_LDU
#undef IG_LDR
#undef IG_BLOCK
#undef IG_ST
#undef IG_STG
#undef IG_MM
#undef IG_LD
#undef IG_OFF
            }
            __syncthreads();
        }
    }
}
__device__ __forceinline__ void p7b_sorted(Frame& F) {
    const int lane = fresh_lane(), tid = F.wave * 64 + lane;
    const float* PD = (const float*)(F.ws + WS_PD0);
    const unsigned* L = (const unsigned*)(F.ws + WS_L); float* RG = (float*)(F.ws + WS_RG); const float* RSTD2 = (const float*)(F.ws + WS_RSTD2);
    const float* US = (const float*)(F.ws + WS_US); const float* VS = (const float*)(F.ws + WS_VS);
    constexpr int NQ = IG_NGRP * IG_PICKS / 4, QPG = IG_PICKS / 4, QB = 3;
    const int q_lo = (int)((long long)F.vcu * NQ / F.G), q_hi = (int)((long long)(F.vcu + 1) * NQ / F.G);
#pragma unroll 1
    for (int q0 = q_lo + tid; q0 < q_hi; q0 += QB * NTHREADS) {
        v4u rec[QB]; f32x4 d[QB];
#pragma unroll
        for (int k = 0; k < QB; ++k) { const int qq = q0 + k * NTHREADS; const size_t pos = (size_t)(qq < q_hi ? qq : q_lo) * 4; rec[k] = *(const v4u*)(L + pos); f32x4 s = {0.f, 0.f, 0.f, 0.f};
#pragma unroll
            for (int sp = 0; sp < 8; ++sp) s += *(const f32x4*)(PD + (size_t)sp * NT_TOK * 128 + pos);
            d[k] = s; }
        float us[QB][4], vs[QB][4], rs[QB][4], gg[QB][4];
#pragma unroll
        for (int k = 0; k < QB; ++k) { const int qq = q0 + k * NTHREADS < q_hi ? q0 + k * NTHREADS : q_lo; const int g = qq / QPG;
#pragma unroll
            for (int c = 0; c < 4; ++c) { const unsigned r = rec[k][c]; const unsigned e = r >> 17; const int t = g * IG_TOK + (int)((r >> 7) & 1023u), pair = (int)(r & 127u);
                us[k][c] = US[e]; vs[k][c] = VS[e]; rs[k][c] = RSTD2[t]; gg[k][c] = RG[(size_t)t * 128 + pair]; } }
        asm volatile("s_waitcnt vmcnt(0)" ::: "memory");
#pragma unroll
        for (int k = 0; k < QB; ++k) { const int qq = q0 + k * NTHREADS; if (qq < q_hi) { const int g = qq / QPG;
#pragma unroll
            for (int c = 0; c < 4; ++c) { const unsigned r = rec[k][c]; const int t = g * IG_TOK + (int)((r >> 7) & 1023u), pair = (int)(r & 127u);
                const float z = d[k][c] * us[k][c] * rs[k][c];
                RG[(size_t)t * 128 + pair] = gg[k][c] * 0.5f * z * (1.0f + erff(z * 0.70710678118654752f)) * vs[k][c]; } } }
    }
}
__device__ __forceinline__ void p7b_quant(Frame& F) {
    const int gw = F.vcu * NWAVES + F.wave, NGW = F.G * NWAVES, lane = fresh_lane();
    const float* RG = (const float*)(F.ws + WS_RG); unsigned* CQ = (unsigned*)(F.ws + WS_CQ); float* SCQ = (float*)(F.ws + WS_SCQ);
#pragma unroll 1
    for (int t0 = gw; t0 < NT_TOK; t0 += 4 * NGW) {
        float ca[4], cb[4];
#pragma unroll
        for (int k = 0; k < 4; ++k) { const int t = t0 + k * NGW < NT_TOK ? t0 + k * NGW : t0; ca[k] = RG[(size_t)t * 128 + lane]; cb[k] = RG[(size_t)t * 128 + 64 + lane]; }
#pragma unroll
        for (int k = 0; k < 4; ++k) { const int t = t0 + k * NGW; if (t < NT_TOK) {
            float am = fmaxf(fabsf(ca[k]), fabsf(cb[k]));
#pragma unroll
            for (int o = 1; o < 64; o <<= 1) am = fmaxf(am, __shfl_xor(am, o));
            const float inv = am > 0.f ? 127.0f / am : 0.f;
            const int qa = (int)__builtin_rintf(ca[k] * inv) & 0xff, qb = (int)__builtin_rintf(cb[k] * inv) & 0xff;
            const int wa = qa | (__shfl_down(qa, 8) << 8) | (__shfl_down(qa, 16) << 16) | (__shfl_down(qa, 24) << 24);
            const int wb = qb | (__shfl_down(qb, 8) << 8) | (__shfl_down(qb, 16) << 16) | (__shfl_down(qb, 24) << 24);
            if (((lane >> 3) & 3) == 0) { unsigned* cq = CQ + (size_t)t * 32 + (lane & 7) * 4 + (lane >> 5); cq[0] = (unsigned)wa; cq[2] = (unsigned)wb; }
            if (lane == 0) SCQ[t] = am * (1.0f / 127.0f); } }
    }
}
#endif
__device__ __forceinline__ void p7c_vaxpy(Frame& F, unsigned* bar, unsigned x, unsigned rank) {
    const int lane = fresh_lane(), r = lane >> 3, seg = lane & 7;
    const SliceOwn so = slice_census(bar, x);
    const int gwl = (int)rank * NWAVES + F.wave, stride = (int)so.n_mine * NWAVES;
    const unsigned char* RE16b = F.ws + WS_RE16; const unsigned char* CQb = F.ws + WS_CQ; const float* SCQ = (const float*)(F.ws + WS_SCQ);
    float* SS3 = (float*)(F.ws + WS_SS3); bf16* X2Bw = (bf16*)(F.ws + WS_X2B);
#pragma unroll 1
    for (int pass = 0; pass < 16; ++pass) {
        const int hs = (2 * (int)so.vx + pass) & 15; if ((unsigned)(hs >> 1) % so.npop != so.vx) continue;
        const unsigned char* Vb = F.ws + WS_V + (size_t)hs * (16384 * 128) + 16 * seg;
        const unsigned char* rp0 = RE16b + r * 32; const unsigned char* cp0 = CQb + r * 16;
#define P7C_LOADA(R0, R1, C, S, X, t) do { const int tt_ = (t) < NT_TOK ? (t) : NT_TOK - 1; const unsigned char* rp_ = rp0 + (size_t)tt_ * 256; R0 = *(const v4u*)rp_; R1 = *(const v4u*)(rp_ + 16); \
            C = *(const v4u*)(cp0 + (size_t)tt_ * 128); S = SCQ[tt_]; X = *(const unsigned*)(X2Bw + (size_t)tt_ * DM + 128 * hs + 16 * seg + 2 * r); } while (0)
#define P7C_ISSUE(G, R0, R1) do { __builtin_amdgcn_s_setprio(3); _Pragma("unroll") for (int i_ = 0; i_ < 16; ++i_) { const unsigned e_ = P7_EID(R0, R1, i_); G[i_] = *(const v4u*)(Vb + (size_t)e_ * 128); } __builtin_amdgcn_s_setprio(0); } while (0)
#define P7C_COMP(G, C, S, X, t) do { int acc_[16]; _Pragma("unroll") for (int c_ = 0; c_ < 16; ++c_) acc_[c_] = 0; \
            _Pragma("unroll") for (int gi_ = 0; gi_ < 4; ++gi_) { const int cq_ = (int)C[gi_]; \
                _Pragma("unroll") for (int w_ = 0; w_ < 4; ++w_) { const unsigned A0 = G[4 * gi_][w_], A1 = G[4 * gi_ + 1][w_], A2 = G[4 * gi_ + 2][w_], A3 = G[4 * gi_ + 3][w_]; \
                    const unsigned lo01 = __builtin_amdgcn_perm(A1, A0, 0x05010400u), hi01 = __builtin_amdgcn_perm(A1, A0, 0x07030602u), lo23 = __builtin_amdgcn_perm(A3, A2, 0x05010400u), hi23 = __builtin_amdgcn_perm(A3, A2, 0x07030602u); \
                    acc_[4 * w_ + 0] = __builtin_amdgcn_sdot4((int)__builtin_amdgcn_perm(lo23, lo01, 0x05040100u), cq_, acc_[4 * w_ + 0], false); \
                    acc_[4 * w_ + 1] = __builtin_amdgcn_sdot4((int)__builtin_amdgcn_perm(lo23, lo01, 0x07060302u), cq_, acc_[4 * w_ + 1], false); \
                    acc_[4 * w_ + 2] = __builtin_amdgcn_sdot4((int)__builtin_amdgcn_perm(hi23, hi01, 0x05040100u), cq_, acc_[4 * w_ + 2], false); \
                    acc_[4 * w_ + 3] = __builtin_amdgcn_sdot4((int)__builtin_amdgcn_perm(hi23, hi01, 0x07060302u), cq_, acc_[4 * w_ + 3], false); } } \
            int a8_[8], a4_[4], a2_[2]; \
            { const bool up_ = (lane & 32) != 0; _Pragma("unroll") for (int c_ = 0; c_ < 8; ++c_) { const int keep_ = up_ ? acc_[c_ + 8] : acc_[c_], send_ = up_ ? acc_[c_] : acc_[c_ + 8]; a8_[c_] = keep_ + __shfl_xor(send_, 32); } } \
            { const bool up_ = (lane & 16) != 0; _Pragma("unroll") for (int c_ = 0; c_ < 4; ++c_) { const int keep_ = up_ ? a8_[c_ + 4] : a8_[c_], send_ = up_ ? a8_[c_] : a8_[c_ + 4]; a4_[c_] = keep_ + __shfl_xor(send_, 16); } } \
            { const bool up_ = (lane & 8) != 0; _Pragma("unroll") for (int c_ = 0; c_ < 2; ++c_) { const int keep_ = up_ ? a4_[c_ + 2] : a4_[c_], send_ = up_ ? a4_[c_] : a4_[c_ + 2]; a2_[c_] = keep_ + __shfl_xor(send_, 8); } } \
            const int tt_ = (t) < NT_TOK ? (t) : NT_TOK - 1; bf16* op_ = X2Bw + (size_t)tt_ * DM + 128 * hs + 16 * seg + 2 * r; \
            const float o0_ = bflo(X) + (float)a2_[0] * S, o1_ = bfhi(X) + (float)a2_[1] * S; \
            const float s3_ = wave_sum(o0_ * o0_ + o1_ * o1_); \
            if ((t) < NT_TOK) { *(unsigned*)op_ = pk2(o0_, o1_); if (lane == 0) SS3[(size_t)(t) * 16 + hs] = s3_; } } while (0)
        v4u GA[16], GB[16], ra0, ra1, ca, rb0, rb1, cb, cA, cB; float sa, sb, sA, sB; unsigned xa, xb2, xA, xB;
        P7C_LOADA(ra0, ra1, ca, sa, xa, gwl);
        P7C_LOADA(rb0, rb1, cb, sb, xb2, gwl + stride);
        P7C_ISSUE(GA, ra0, ra1); cA = ca; sA = sa; xA = xa;
#pragma unroll 1
        for (int t = gwl; t < NT_TOK; t += 2 * stride) {
            P7C_LOADA(ra0, ra1, ca, sa, xa, t + 2 * stride); P7C_ISSUE(GB, rb0, rb1); cB = cb; sB = sb; xB = xb2; P7C_COMP(GA, cA, sA, xA, t);
            P7C_LOADA(rb0, rb1, cb, sb, xb2, t + 3 * stride); P7C_ISSUE(GA, ra0, ra1); cA = ca; sA = sa; xA = xa; P7C_COMP(GB, cB, sB, xB, t + stride);
        }
#undef P7C_LOADA
#undef P7C_ISSUE
#undef P7C_COMP
    }
}
__device__ __forceinline__ void p7d_final(Frame& F) {
    const int gw = F.vcu * NWAVES + F.wave, NGW = F.G * NWAVES, lane = fresh_lane();
    const float* SS3 = (const float*)(F.ws + WS_SS3);
    f32x4 gf[8];
#pragma unroll
    for (int j = 0; j < 8; ++j) gf[j] = *(const f32x4*)(F.normf_g + 512 * (j >> 1) + 8 * lane + 4 * (j & 1));
#pragma unroll 1
    for (int t = gw; t < NT_TOK; t += NGW) {
        const float sp = (lane < 16) ? SS3[(size_t)t * 16 + lane] : 0.f; const float r3 = 1.0f / sqrtf(wave_sum(sp) * (1.0f / DM) + RMS_EPS);
        const v4u* xin = (const v4u*)((const bf16*)(F.ws + WS_X2B) + (size_t)t * DM) + lane;
        f32x4* row = (f32x4*)(F.out + (size_t)t * DM);
        v4u v[4];
#pragma unroll
        for (int j = 0; j < 4; ++j) v[j] = xin[64 * j];
#pragma unroll
        for (int j = 0; j < 4; ++j) {
            const f32x4 a = (f32x4){bflo(v[j].x), bfhi(v[j].x), bflo(v[j].y), bfhi(v[j].y)} * r3 * gf[2 * j], b = (f32x4){bflo(v[j].z), bfhi(v[j].z), bflo(v[j].w), bfhi(v[j].w)} * r3 * gf[2 * j + 1];
            row[128 * j + 2 * lane] = a; row[128 * j + 2 * lane + 1] = b; }
    }
}

__device__ __forceinline__ void p4b_quant_x2(Frame& F) {
    const int gw = F.vcu * NWAVES + F.wave, NGW = F.G * NWAVES, lane = fresh_lane();
    const bf16* X2B = (const bf16*)(F.ws + WS_X2B); unsigned char* X2Q = (unsigned char*)F.out + OUT_X2Q; float* SX = (float*)(F.ws + WS_SX);
    v4u cur[4], nxt[4];
    if (gw < NT_TOK) {
#pragma unroll
        for (int j = 0; j < 4; ++j) cur[j] = *(const v4u*)(X2B + (size_t)gw * DM + 512 * j + 8 * lane); }
#pragma unroll 1
    for (int t = gw; t < NT_TOK; t += NGW) {
        { const int tn = (t + NGW < NT_TOK) ? t + NGW : t;
#pragma unroll
          for (int j = 0; j < 4; ++j) nxt[j] = *(const v4u*)(X2B + (size_t)tn * DM + 512 * j + 8 * lane); }
        float v[32]; float am = 0.f;
#pragma unroll
        for (int j = 0; j < 4; ++j)
#pragma unroll
            for (int c = 0; c < 4; ++c) { v[8 * j + 2 * c] = bflo(cur[j][c]); v[8 * j + 2 * c + 1] = bfhi(cur[j][c]); am = fmaxf(am, fmaxf(fabsf(v[8 * j + 2 * c]), fabsf(v[8 * j + 2 * c + 1]))); }
#pragma unroll
        for (int o = 1; o < 64; o <<= 1) am = fmaxf(am, __shfl_xor(am, o));
        const float inv = am > 0.f ? 127.0f / am : 0.f;
#pragma unroll
        for (int j = 0; j < 4; ++j) { v2u o;
#pragma unroll
            for (int q = 0; q < 2; ++q) { unsigned w = 0;
#pragma unroll
                for (int e = 0; e < 4; ++e) w |= ((unsigned)(int)__builtin_rintf(v[8 * j + 4 * q + e] * inv) & 0xffu) << (8 * e);
                o[q] = w; }
            *(v2u*)(X2Q + (size_t)t * DM + 512 * j + 8 * lane) = o; }
        if (lane == 0) SX[t] = am > 0.f ? am * (1.0f / 127.0f) : 1.0f;
#pragma unroll
        for (int j = 0; j < 4; ++j) cur[j] = nxt[j];
    }
}
__global__ void __launch_bounds__(NTHREADS, 2) hymba_fwd(Args args) {
    extern __shared__ __attribute__((aligned(16))) unsigned char lds[];
    Frame F;
    F.lds = (LAS unsigned char*)lds; F.lds_g = lds;
    F.tid = threadIdx.x; F.lane = F.tid & 63; F.wave = __builtin_amdgcn_readfirstlane(F.tid >> 6);
    F.G = gridDim.x; { const int bx = blockIdx.x; F.vcu = (F.G % 8 == 0) ? (bx % 8) * (F.G / 8) + bx / 8 : bx; }
    F.xp = args.in[0]; F.xs = args.in[1]; F.norm1_g = args.in[2]; F.w_in = args.in[3]; F.a_out_g = args.in[4]; F.b_out_g = args.in[5]; F.sink = args.in[6];
    F.w_out = args.in[7]; F.norm2_g = args.in[8]; F.w_pq = args.in[9]; F.sub_keys = args.in[10]; F.expert_u = args.in[11]; F.expert_v = args.in[12]; F.normf_g = args.in[13];
    F.out = args.out; F.ws = args.ws;
    volatile LAS unsigned* MISC = (volatile LAS unsigned*)(F.lds + MISC_OFF);
    if (F.tid < 32) MISC[F.tid] = 0u;
    __syncthreads();
    unsigned* bar = (unsigned*)(F.ws + WS_CTL);
    XcdBarrier xb = xcd_barrier_post(bar, MISC + 8);
#define GRID_BAR() xcd_barrier(xb)
#ifndef PROBE_REP
#define PROBE_REP -1
#endif
#define REPS(k) ((PROBE_REP == (k)) ? 3 : 1)
    for (int rep = 0; rep < REPS(0); ++rep) p0_prep(F);
    GRID_BAR();
    {
#if P1_I8
        pg8::Gemm g{(const bf16*)(F.ws + WS_XN), (const bf16*)(F.ws + WS_WIN), NT_TOK, INW, DM / 2}; pg8::StaticOrder S; S.init(NT_TOK, INW, F.G, (int)blockIdx.x);
        pg8::EpiBf16I8 E{(bf16*)(F.ws + WS_PROJ), INW, (const float*)(F.ws + WS_SXN), (const float*)(F.ws + WS_SWI), 0.125f * LOG2E};
        p1_quant_w<INW, false>(F, F.w_in, nullptr, (const float*)(F.ws + WS_CMAX_IN), F.ws + WS_WIN, (float*)(F.ws + WS_SWI));
        typedef pg8::EpiBf16I8 EpiP1;
#else
        pg8::Gemm g{(const bf16*)(F.ws + WS_XN), (const bf16*)(F.ws + WS_WIN), NT_TOK, INW, DM}; pg8::StaticOrder S; S.init(NT_TOK, INW, F.G, (int)blockIdx.x);
        pg8::EpiBf16 E{(bf16*)(F.ws + WS_PROJ), INW, nullptr, 0.125f * LOG2E};
        typedef pg8::EpiBf16 EpiP1;
#endif
#if P4_I8
        p1_quant_w<DM, false>(F, F.w_out, nullptr, (const float*)(F.ws + WS_CMAX), F.ws + WS_WOUT, (float*)(F.ws + WS_SWO));
#endif
#if P1_I8
        GRID_BAR();
#else
        __syncthreads();
#endif
        for (int rep = 0; rep < REPS(1); ++rep) pg8::gemm_phase<EpiP1, pg8::StaticOrder, true, true>(F.lds, g, S, E, F.wave);
    }
    GRID_BAR();
    p2_attention<0>(F);
#if PROBE_REP == 21
    p2_attention<1>(F); p2_attention<1>(F);
#elif PROBE_REP == 22
    p2_attention<2>(F); p2_attention<2>(F);
#elif PROBE_REP == 23
    p2_attention<3>(F); p2_attention<3>(F);
#elif PROBE_REP == 24
    p2_attention<4>(F); p2_attention<4>(F);
#elif PROBE_REP == 25
    p2_attention<5>(F); p2_attention<5>(F);
#elif PROBE_REP == 26
    p2_attention<6>(F); p2_attention<6>(F);
#elif PROBE_REP == 2
    p2_attention<0>(F); p2_attention<0>(F);
#endif
    GRID_BAR();
    for (int rep = 0; rep < REPS(3); ++rep) p3_finalize(F);
#if P5_I8
    __syncthreads();
    p1_quant_w<DM, true>(F, F.w_pq, F.norm2_g, (const float*)(F.ws + WS_CMAX2), F.ws + WS_WPQ, (float*)(F.ws + WS_SWQ));
#endif
    GRID_BAR();
    {
#if P4_I8
        pg8::Gemm g{(const bf16*)(F.ws + WS_MIXED), (const bf16*)(F.ws + WS_WOUT), NT_TOK, DM, DM / 2}; pg8::StaticOrder S; S.init(NT_TOK, DM, F.G, (int)blockIdx.x);
        pg8::EpiResidI8 E{F.xp, F.xs, (bf16*)(F.ws + WS_X2B), (float*)(F.ws + WS_SS), (const float*)(F.ws + WS_SA), (const float*)(F.ws + WS_SWO)};
        for (int rep = 0; rep < REPS(4); ++rep) pg8::gemm_phase<pg8::EpiResidI8, pg8::StaticOrder, true, true>(F.lds, g, S, E, F.wave);
#else
        pg8::Gemm g{(const bf16*)(F.ws + WS_MIXED), (const bf16*)(F.ws + WS_WOUT), NT_TOK, DM, DM}; pg8::StaticOrder S; S.init(NT_TOK, DM, F.G, (int)blockIdx.x);
        pg8::EpiResid E{F.xp, F.xs, F.out, (bf16*)(F.ws + WS_X2B), (float*)(F.ws + WS_SS), (unsigned char*)F.out + OUT_X2Q, (const float*)(F.ws + WS_SX2)};
        for (int rep = 0; rep < REPS(4); ++rep) pg8::gemm_phase<pg8::EpiResid, pg8::StaticOrder, true, true>(F.lds, g, S, E, F.wave);
#endif
    }
    GRID_BAR();
#if P5_I8 == 1
    p4b_quant_x2(F);
    GRID_BAR();
#endif
    {
#if P5_I8
        pg8::Gemm g{(const bf16*)((const unsigned char*)F.out + OUT_X2Q), (const bf16*)(F.ws + WS_WPQ), NT_TOK, DM, DM / 2}; pg8::StaticOrder S; S.init(NT_TOK, DM, F.G, (int)blockIdx.x);
        typedef EpiRouteT<true> EpiRoute;
        EpiRoute E{(const float*)(F.ws + WS_SS), F.ws, (const float*)(F.ws + WS_SX2), (const float*)(F.ws + WS_SWQ)};
#else
        pg8::Gemm g{(const bf16*)(F.ws + WS_X2B), (const bf16*)(F.ws + WS_WPQ), NT_TOK, DM, DM}; pg8::StaticOrder S; S.init(NT_TOK, DM, F.G, (int)blockIdx.x);
        typedef EpiRouteT<false> EpiRoute;
        EpiRoute E{(const float*)(F.ws + WS_SS), F.ws, nullptr, nullptr};
#endif
#pragma unroll 1
        for (int rep = 0; rep < REPS(5); ++rep)
#pragma unroll 1
        for (int i = 0;; ++i) { pg8::OneUnit O; if (!S.next(i, O.u)) break; pg8::gemm_phase<EpiRoute, pg8::OneUnit, false, true>(F.lds, g, O, E, F.wave); }
    }
    GRID_BAR();
    const unsigned rank = MISC[10];
#if P7A_INV
    for (int rep = 0; rep < REPS(9); ++rep) p6a_hist(F);
    GRID_BAR();
    for (int rep = 0; rep < REPS(10); ++rep) p6b_scatter(F);
    GRID_BAR();
    p7a_inv<0>(F, bar, xb.x, rank);
#if PROBE_REP == 7
    p7a_inv<4>(F, bar, xb.x, rank); p7a_inv<4>(F, bar, xb.x, rank);
#elif PROBE_REP == 71
    p7a_inv<5>(F, bar, xb.x, rank); p7a_inv<5>(F, bar, xb.x, rank);
#elif PROBE_REP == 72
    p7a_inv<6>(F, bar, xb.x, rank); p7a_inv<6>(F, bar, xb.x, rank);
#elif PROBE_REP == 73
    p7a_inv<7>(F, bar, xb.x, rank); p7a_inv<7>(F, bar, xb.x, rank);
#elif PROBE_REP == 74
    p7a_inv<12>(F, bar, xb.x, rank); p7a_inv<12>(F, bar, xb.x, rank);
#elif PROBE_REP == 75
    p7a_inv<20>(F, bar, xb.x, rank); p7a_inv<20>(F, bar, xb.x, rank);
#endif
    GRID_BAR();
    p7b_sorted(F);
    GRID_BAR();
    for (int rep = 0; rep < REPS(11); ++rep) p7b_quant(F);
    GRID_BAR();
#else
    for (int rep = 0; rep < REPS(7); ++rep) p7a_udots(F, bar, xb.x, rank);
    GRID_BAR();
    for (int rep = 0; rep < REPS(8); ++rep) p7b_coef(F);
    GRID_BAR();
#endif
    p7c_vaxpy(F, bar, xb.x, rank);
    GRID_BAR();
    p7d_final(F);
#undef GRID_BAR
}

extern "C" void kernel_launch(void* const* d_in, const int* in_sizes, int n_in, void* d_out, int out_size, void* d_ws, size_t ws_size, hipStream_t stream) {
    static int grid = 0;
    if (grid == 0) {
        if (n_in != 14 || out_size != NT_TOK * DM || ws_size < WS_END) { fprintf(stderr, "kernel_launch: unexpected shapes (n_in %d out %d ws %zu)\n", n_in, out_size, ws_size); grid = -1; return; }
        int dev = 0, cus = 0, per_cu = 0;
        (void)hipGetDevice(&dev); (void)hipDeviceGetAttribute(&cus, hipDeviceAttributeMultiprocessorCount, dev);
        (void)hipFuncSetAttribute((const void*)hymba_fwd, hipFuncAttributeMaxDynamicSharedMemorySize, LDS_BYTES);
        (void)hipOccupancyMaxActiveBlocksPerMultiprocessor(&per_cu, (const void*)hymba_fwd, NTHREADS, LDS_BYTES);
        if (per_cu < 1) { fprintf(stderr, "kernel_launch: occupancy query says %d blocks per CU\n", per_cu); per_cu = 1; }
        (void)hipGetLastError();
        grid = cus;
    }
    if (grid < 0) return;
    Args a{};
    for (int i = 0; i < 14; ++i) a.in[i] = (const float*)d_in[i];
    a.out = (float*)d_out; a.ws = (unsigned char*)d_ws; a.ph_lo = 0; a.ph_hi = 0;
    if (hipMemsetAsync((char*)d_ws + WS_CTL, 0, CTL_ZERO_BYTES, stream) != hipSuccess) { fprintf(stderr, "kernel_launch: memset failed\n"); return; }
    void* kargs[] = {&a};
    hipError_t e = hipLaunchCooperativeKernel((const void*)hymba_fwd, dim3(grid), dim3(NTHREADS), kargs, LDS_BYTES, stream);
    if (e != hipSuccess) fprintf(stderr, "cooperative launch failed: %s (grid %d)\n", hipGetErrorString(e), grid);
}
```

```cpp
#include <hip/hip_runtime.h>
#include <hip/hip_cooperative_groups.h>
#include <cstdio>
#include <cstdint>
namespace cg = cooperative_groups;

#ifndef PROBE_REP
#define PROBE_REP -1
#endif
#ifndef P4_I8
#define P4_I8 0
#endif
#ifndef P1_I8
#define P1_I8 1
#endif
#ifndef P5_I8
#define P5_I8 2
#endif
#ifndef P7A_INV
#define P7A_INV 1
#endif
#ifndef P7A_X2Q
#define P7A_X2Q 1
#endif
#ifndef MK_N_LAUNCHES
#define MK_N_LAUNCHES 1
#endif

__device__ __forceinline__ int fresh_lane() { int l; asm volatile("v_mbcnt_lo_u32_b32 %0, -1, 0\n\tv_mbcnt_hi_u32_b32 %0, -1, %0" : "=v"(l)); return l; }
namespace pg8 {
#define PG8_LAS __attribute__((address_space(3)))
typedef unsigned short bf16_t;
typedef short bf16x8 __attribute__((ext_vector_type(8)));
typedef float f32x4 __attribute__((ext_vector_type(4)));
typedef unsigned u32x4 __attribute__((ext_vector_type(4)));
typedef unsigned u32x2 __attribute__((ext_vector_type(2)));
typedef int i32x4 __attribute__((ext_vector_type(4)));
template <bool I8> struct AccT { typedef f32x4 type; };
template <> struct AccT<true> { typedef i32x4 type; };
template <bool I8> __device__ __forceinline__ typename AccT<I8>::type mma16(bf16x8 b, bf16x8 a, typename AccT<I8>::type c) {
    if constexpr (I8) return __builtin_amdgcn_mfma_i32_16x16x64_i8(__builtin_bit_cast(i32x4, b), __builtin_bit_cast(i32x4, a), c, 0, 0, 0);
    else return __builtin_amdgcn_mfma_f32_16x16x32_bf16(b, a, c, 0, 0, 0);
}
constexpr int BM = 256, BK = 64, HALF = 128, HTB = HALF * BK * 2, STAGE_BYTES = 8 * HTB, NXCD = 8, WGM = 8;

__host__ __device__ __forceinline__ int lds_byte(int r, int c) { const int st = (r >> 4) * 2 + (c >> 5), rr = r & 15, cc = c & 31, ob = rr * 64 + cc * 2; return st * 1024 + (ob ^ (((ob >> 9) & 1) << 5)); }
__host__ __device__ __forceinline__ void stage_rc(int b, int& R, int& C) { const int st = b / 1024, sb = b % 1024, swz = sb ^ (((sb >> 9) & 1) << 5); R = (st >> 1) * 16 + swz / 64; C = (st & 1) * 32 + (swz % 64) / 2; }
__host__ __device__ __forceinline__ int perm32(int rho) { const int n = rho >> 4, i = rho & 15; return 8 * (i >> 2) + 4 * n + (i & 3); }

struct Unit { int pm, pn; };
struct Gemm { const bf16_t* A; const bf16_t* Bt; int M, N, K; };

struct StaticOrder {
    int nM, nN, nwg, G, c;
    __host__ __device__ void init(int M, int N, int G_, int c_) { nM = M / BM; nN = N / BM; nwg = nM * nN; G = G_; c = c_; }
    __host__ __device__ bool next(int i, Unit& u) const {
        const long L = (long)i * G + c; if (L >= nwg) return false;
        int wgid = (int)L; { const int q = nwg / NXCD, r = nwg % NXCD, xcd = wgid % NXCD, off = wgid / NXCD; wgid = (xcd < r ? xcd * (q + 1) : r * (q + 1) + (xcd - r) * q) + off; }
        const int nig = WGM * nN, gid = wgid / nig, fm = gid * WGM, gsz = (nM - fm) < WGM ? (nM - fm) : WGM;
        u.pm = fm + ((wgid % nig) % gsz); u.pn = (wgid % nig) / gsz; return true;
    }
    __device__ __forceinline__ void a_ready(const Unit&) const {}
    __device__ __forceinline__ void done(const Unit&) const {}
};

struct OneUnit { Unit u;
    __device__ __forceinline__ bool next(int i, Unit& o) const { if (i != 0) return false; o = u; return true; }
    __device__ __forceinline__ void a_ready(const Unit&) const {}
    __device__ __forceinline__ void done(const Unit&) const {}
};

__device__ __forceinline__ unsigned cvt_pk_bf16(float lo, float hi) { unsigned r; asm volatile("v_cvt_pk_bf16_f32 %0, %1, %2" : "=v"(r) : "v"(lo), "v"(hi)); return r; }

struct EpiBf16 {
    static constexpr bool PERM = true, AFTER_DRAIN = false, I8 = false;
    bf16_t* O; int ldc; const float* ss;
    float qscale;
    __device__ __forceinline__ void operator()(const f32x4 (&acc)[2][2][4][2], const Unit& u, int wr, int wc, int fr, int fq) const {
        const int row0 = u.pm * BM + wr * 64 + fr; const int col0 = u.pn * BM + wc * 32 + 8 * fq;
#pragma unroll
        for (int ai = 0; ai < 2; ++ai)
#pragma unroll
            for (int m = 0; m < 4; ++m) {
                const int r = row0 + ai * HALF + m * 16;
                float sc = (qscale != 0.f && (u.pn < 4 || (u.pn >= 12 && u.pn < 16))) ? qscale : 1.f;
                if (ss) { const f32x4* p = (const f32x4*)(ss + (size_t)r * 32); float s = 0.f;
#pragma unroll
                    for (int i = 0; i < 8; ++i) { const f32x4 v = p[i]; s += (v[0] + v[1]) + (v[2] + v[3]); }
                    sc *= 1.0f / sqrtf(s * (1.0f / 2048.0f) + 1e-6f); }
                bf16_t* rowp = O + (size_t)r * ldc + col0;
#pragma unroll
                for (int bj = 0; bj < 2; ++bj) { const f32x4 v0 = acc[ai][bj][m][0] * sc, v1 = acc[ai][bj][m][1] * sc;
                    u32x4 w; w.x = cvt_pk_bf16(v0[0], v0[1]); w.y = cvt_pk_bf16(v0[2], v0[3]); w.z = cvt_pk_bf16(v1[0], v1[1]); w.w = cvt_pk_bf16(v1[2], v1[3]);
                    *(u32x4*)(rowp + bj * HALF) = w; } }
    }
};
struct EpiBf16I8 {
    static constexpr bool PERM = true, AFTER_DRAIN = false, I8 = true;
    bf16_t* O; int ldc; const float* sa; const float* sw; float qscale;
    __device__ __forceinline__ void operator()(const i32x4 (&acc)[2][2][4][2], const Unit& u, int wr, int wc, int fr, int fq) const {
        const int row0 = u.pm * BM + wr * 64 + fr; const int col0 = u.pn * BM + wc * 32 + 8 * fq;
        f32x4 w0[2], w1[2]; float sav[8];
#pragma unroll
        for (int bj = 0; bj < 2; ++bj) { w0[bj] = *(const f32x4*)(sw + col0 + bj * HALF); w1[bj] = *(const f32x4*)(sw + col0 + bj * HALF + 4); }
#pragma unroll
        for (int i = 0; i < 8; ++i) sav[i] = sa[row0 + (i >> 2) * HALF + (i & 3) * 16];
#pragma unroll
        for (int ai = 0; ai < 2; ++ai)
#pragma unroll
            for (int m = 0; m < 4; ++m) {
                const int r = row0 + ai * HALF + m * 16;
                float sc = sav[4 * ai + m]; if (qscale != 0.f && (u.pn < 4 || (u.pn >= 12 && u.pn < 16))) sc *= qscale;
                bf16_t* rowp = O + (size_t)r * ldc + col0;
#pragma unroll
                for (int bj = 0; bj < 2; ++bj) { const i32x4 a0 = acc[ai][bj][m][0], a1 = acc[ai][bj][m][1];
                    const f32x4 v0 = (f32x4){(float)a0[0], (float)a0[1], (float)a0[2], (float)a0[3]} * w0[bj] * sc, v1 = (f32x4){(float)a1[0], (float)a1[1], (float)a1[2], (float)a1[3]} * w1[bj] * sc;
                    u32x4 w; w.x = cvt_pk_bf16(v0[0], v0[1]); w.y = cvt_pk_bf16(v0[2], v0[3]); w.z = cvt_pk_bf16(v1[0], v1[1]); w.w = cvt_pk_bf16(v1[2], v1[3]);
                    *(u32x4*)(rowp + bj * HALF) = w; } }
    }
};
struct EpiResid {
    static constexpr bool PERM = true, AFTER_DRAIN = false, I8 = false, XQ = (P5_I8 == 2);
    const float* xp; const float* xs; float* out; bf16_t* xb; float* ss; unsigned char* xq; const float* sx;
    __device__ __forceinline__ void operator()(const f32x4 (&acc)[2][2][4][2], const Unit& u, int wr, int wc, int fr, int fq) const {
        const int row0 = u.pm * BM + wr * 64 + fr; const int col0 = u.pn * BM + wc * 32 + 8 * fq;
        f32x4 xv[3][4];
#define EPR_ROW(it) (row0 + ((it) >> 2) * HALF + ((it) & 3) * 16)
#define EPR_LOAD(buf, it) do { const int r_ = EPR_ROW(it); const float* xrow_ = (r_ < 16384) ? (xp + (size_t)r_ * 2048) : (xs + (size_t)(r_ - 16384) * 2048); \
            _Pragma("unroll") for (int q_ = 0; q_ < 4; ++q_) xv[buf][q_] = *(const f32x4*)(xrow_ + col0 + (q_ >> 1) * HALF + (q_ & 1) * 4); } while (0)
        float sxv[8];
#pragma unroll
        for (int i = 0; i < 8; ++i) sxv[i] = XQ ? sx[EPR_ROW(i)] : 1.0f;
        EPR_LOAD(0, 0); EPR_LOAD(1, 1);
#pragma unroll
        for (int it = 0; it < 8; ++it) {
            const int ai = it >> 2, m = it & 3, r = EPR_ROW(it);
            if (it + 2 < 8) EPR_LOAD((it + 2) % 3, it + 2);
            float s = 0.f; const float qi = XQ ? 1.0f / sxv[it] : 0.f;
#pragma unroll
            for (int bj = 0; bj < 2; ++bj) { const int c = col0 + bj * HALF;
                const f32x4 v0 = acc[ai][bj][m][0] + xv[it % 3][bj * 2], v1 = acc[ai][bj][m][1] + xv[it % 3][bj * 2 + 1];
                u32x4 w; w.x = cvt_pk_bf16(v0[0], v0[1]); w.y = cvt_pk_bf16(v0[2], v0[3]); w.z = cvt_pk_bf16(v1[0], v1[1]); w.w = cvt_pk_bf16(v1[2], v1[3]);
                *(u32x4*)(xb + (size_t)r * 2048 + c) = w;
                if (XQ) { u32x2 p; p.x = 0; p.y = 0;
#pragma unroll
                    for (int e = 0; e < 4; ++e) { p.x |= ((unsigned)(int)__builtin_rintf(fminf(fmaxf(v0[e] * qi, -127.0f), 127.0f)) & 0xffu) << (8 * e); p.y |= ((unsigned)(int)__builtin_rintf(fminf(fmaxf(v1[e] * qi, -127.0f), 127.0f)) & 0xffu) << (8 * e); }
                    *(u32x2*)(xq + (size_t)r * 2048 + c) = p; }
                s += ((v0[0] * v0[0] + v0[1] * v0[1]) + (v0[2] * v0[2] + v0[3] * v0[3])) + ((v1[0] * v1[0] + v1[1] * v1[1]) + (v1[2] * v1[2] + v1[3] * v1[3])); }
            s += __shfl_xor(s, 16); s += __shfl_xor(s, 32);
            if (fq == 0) ss[(size_t)r * 32 + u.pn * 4 + wc] = s;
            asm volatile("" ::: "memory"); }
#undef EPR_LOAD
#undef EPR_ROW
    }
};

struct EpiResidI8 {
    static constexpr bool PERM = false, AFTER_DRAIN = false, I8 = true;
    const float* xp; const float* xs; bf16_t* xb; float* ss; const float* sa; const float* sw;
    __device__ __forceinline__ void operator()(const i32x4 (&acc)[2][2][4][2], const Unit& u, int wr, int wc, int fr, int fq) const {
        const int row0 = u.pm * BM + wr * 64 + fr; const int col0 = u.pn * BM + wc * 32 + 4 * fq;
        f32x4 swv[2][2];
#pragma unroll
        for (int bj = 0; bj < 2; ++bj)
#pragma unroll
            for (int n = 0; n < 2; ++n) swv[bj][n] = *(const f32x4*)(sw + col0 + bj * HALF + n * 16);
#pragma unroll
        for (int ai = 0; ai < 2; ++ai)
#pragma unroll
            for (int m = 0; m < 4; ++m) {
                const int r = row0 + ai * HALF + m * 16;
                const float* xrow = (r < 16384) ? (xp + (size_t)r * 2048) : (xs + (size_t)(r - 16384) * 2048);
                const float sar = sa[r];
                float s = 0.f;
#pragma unroll
                for (int bj = 0; bj < 2; ++bj)
#pragma unroll
                    for (int n = 0; n < 2; ++n) { const int c = col0 + bj * HALF + n * 16;
                        const i32x4 a = acc[ai][bj][m][n];
                        const f32x4 v = (f32x4){(float)a[0], (float)a[1], (float)a[2], (float)a[3]} * sar * swv[bj][n] + *(const f32x4*)(xrow + c);
                        u32x2 w; w.x = cvt_pk_bf16(v[0], v[1]); w.y = cvt_pk_bf16(v[2], v[3]);
                        *(u32x2*)(xb + (size_t)r * 2048 + c) = w;
                        s += (v[0] * v[0] + v[1] * v[1]) + (v[2] * v[2] + v[3] * v[3]); }
                s += __shfl_xor(s, 16); s += __shfl_xor(s, 32);
                if (fq == 0) ss[(size_t)r * 32 + u.pn * 4 + wc] = s;
                asm volatile("" ::: "memory"); }
    }
};

template <class Epi, class Sched, bool ALIGN_EPI = false, bool SP2 = false>
__device__ __forceinline__ void gemm_phase(PG8_LAS unsigned char* lds, const Gemm g, const Sched& S, const Epi& E, int wid  ) {
    const int lane = fresh_lane(), tid = wid * 64 + lane, wr = wid >> 2, wc = wid & 3, fr = lane & 15, fq = lane >> 4;
    const int K = g.K, nt = K / BK;
    unsigned voffA[2], voffB[2];
#pragma unroll
    for (int i = 0; i < 2; ++i) { int R, C; stage_rc(tid * 16 + i * 8192, R, C); const int Rb = Epi::PERM ? ((R & ~31) + perm32(R & 31)) : R;
        voffA[i] = (unsigned)(R * K + C) * 2u; voffB[i] = (unsigned)(Rb * K + C) * 2u; }
    const size_t kstep = (size_t)(BK * 2);
    const size_t hstep = (size_t)HALF * K * 2;
    const size_t tstep = 2 * hstep;
    const unsigned ldsw = (unsigned)wid * 1024u;
    const int aoff = lds_byte(wr * 64 + fr, fq * 8), boff = lds_byte(wc * 32 + fr, fq * 8);
#define PG8_SA(b, h) (((b) * 2 + (h)) * HTB)
#define PG8_SB(b, h) ((4 + (b) * 2 + (h)) * HTB)
#define PG8_STAGE(bufoff, gbase, voff) do { _Pragma("unroll") for (int _i = 0; _i < 2; ++_i) \
        __builtin_amdgcn_global_load_lds((const unsigned*)((const char*)(gbase) + (voff)[_i]), (PG8_LAS unsigned*)(lds + (bufoff) + ldsw + _i * 8192), 16, 0, 0); } while (0)
#define PG8_LDA(dst, b, h) do { _Pragma("unroll") for (int m = 0; m < 4; ++m) _Pragma("unroll") for (int k = 0; k < 2; ++k) dst[m][k] = *(const PG8_LAS bf16x8*)(lds + PG8_SA(b, h) + aoff + m * 2048 + k * 1024); } while (0)
#define PG8_LDB(dst, b, h) do { _Pragma("unroll") for (int n = 0; n < 2; ++n) _Pragma("unroll") for (int k = 0; k < 2; ++k) dst[n][k] = *(const PG8_LAS bf16x8*)(lds + PG8_SB(b, h) + boff + n * 2048 + k * 1024); } while (0)
#define PG8_MMA(ai, bj, At, Bt) do { __builtin_amdgcn_s_setprio(1); _Pragma("unroll") for (int m = 0; m < 4; ++m) _Pragma("unroll") for (int n = 0; n < 2; ++n) _Pragma("unroll") for (int k = 0; k < 2; ++k) \
        acc[ai][bj][m][n] = mma16<Epi::I8>(Bt[n][k], At[m][k], acc[ai][bj][m][n]); __builtin_amdgcn_s_setprio(0); } while (0)
#define PG8_WAIT_V(n) asm volatile("s_waitcnt vmcnt(" #n ")" ::: "memory")
#define PG8_WAIT_L(n) asm volatile("s_waitcnt lgkmcnt(" #n ")" ::: "memory")
#define PG8_BAR __builtin_amdgcn_s_barrier()
#define PG8_SCHED __builtin_amdgcn_sched_barrier(0)
    Unit cur, nxt; int ui = 0;
    if (!S.next(0, cur)) return;
    typedef typename AccT<Epi::I8>::type acc_t;
    acc_t acc[2][2][4][2];
#pragma unroll
    for (int a = 0; a < 2; ++a)
#pragma unroll
        for (int b = 0; b < 2; ++b)
#pragma unroll
            for (int m = 0; m < 4; ++m)
#pragma unroll
                for (int n = 0; n < 2; ++n) acc[a][b][m][n] = (acc_t){0, 0, 0, 0};
    bf16x8 At[4][2], B0[2][2], B1[2][2];
    const char* cA = (const char*)g.A + (size_t)cur.pm * tstep; const char* cB = (const char*)g.Bt + (size_t)cur.pn * tstep;
    S.a_ready(cur);
    if constexpr (SP2) {
        PG8_STAGE(PG8_SB(0, 0), cB, voffB); PG8_STAGE(PG8_SB(0, 1), cB + hstep, voffB); PG8_STAGE(PG8_SA(0, 0), cA, voffA); PG8_STAGE(PG8_SA(0, 1), cA + hstep, voffA);
        if (wr == 1) PG8_BAR;
        PG8_WAIT_V(2); PG8_BAR;
        PG8_STAGE(PG8_SB(1, 0), cB + kstep, voffB); PG8_STAGE(PG8_SA(1, 0), cA + kstep, voffA); PG8_STAGE(PG8_SB(1, 1), cB + hstep + kstep, voffB);
        PG8_WAIT_V(6); PG8_BAR;
    } else {
        PG8_STAGE(PG8_SB(0, 0), cB, voffB); PG8_STAGE(PG8_SA(0, 0), cA, voffA); PG8_STAGE(PG8_SB(0, 1), cB + hstep, voffB); PG8_STAGE(PG8_SA(0, 1), cA + hstep, voffA);
        if (wr == 1) PG8_BAR;
        PG8_WAIT_V(4); PG8_BAR;
        PG8_STAGE(PG8_SB(1, 0), cB + kstep, voffB); PG8_STAGE(PG8_SA(1, 0), cA + kstep, voffA); PG8_STAGE(PG8_SB(1, 1), cB + hstep + kstep, voffB);
        PG8_WAIT_V(6); PG8_BAR;
    }
    for (;;) {
        const bool has_next = S.next(ui + 1, nxt);
        const char* nA = has_next ? (const char*)g.A + (size_t)nxt.pm * tstep : cA; const char* nB = has_next ? (const char*)g.Bt + (size_t)nxt.pn * tstep : cB;
        for (int t = 0; t < nt; t += 2) {
            const bool last = (t == nt - 2);
            const char* a1 = cA + (size_t)(t + 1) * kstep;
            const char* a2 = last ? nA : cA + (size_t)(t + 2) * kstep; const char* b2 = last ? nB : cB + (size_t)(t + 2) * kstep;
            const char* a3 = a2 + kstep; const char* b3 = b2 + kstep;
            if (last && has_next) S.a_ready(nxt);
            if constexpr (SP2) {
            PG8_LDB(B0, 0, 0); PG8_LDB(B1, 0, 1); PG8_SCHED; PG8_LDA(At, 0, 0); PG8_STAGE(PG8_SA(1, 1), a1 + hstep, voffA);
            PG8_WAIT_V(8); PG8_WAIT_L(0); PG8_BAR; PG8_MMA(0, 0, At, B0); PG8_MMA(0, 1, At, B1); PG8_BAR; PG8_SCHED;
            PG8_LDA(At, 0, 1); PG8_STAGE(PG8_SB(0, 0), b2, voffB); PG8_STAGE(PG8_SB(0, 1), b2 + hstep, voffB); PG8_STAGE(PG8_SA(0, 0), a2, voffA);
            PG8_WAIT_V(8); PG8_WAIT_L(0); PG8_BAR; PG8_MMA(1, 0, At, B0); PG8_MMA(1, 1, At, B1); PG8_BAR; PG8_SCHED;
            PG8_LDB(B0, 1, 0); PG8_LDB(B1, 1, 1); PG8_SCHED; PG8_LDA(At, 1, 0); PG8_STAGE(PG8_SA(0, 1), a2 + hstep, voffA);
            PG8_WAIT_V(8); PG8_WAIT_L(0); PG8_BAR; PG8_MMA(0, 0, At, B0); PG8_MMA(0, 1, At, B1); PG8_BAR; PG8_SCHED;
            PG8_LDA(At, 1, 1); PG8_STAGE(PG8_SB(1, 0), b3, voffB); PG8_STAGE(PG8_SB(1, 1), b3 + hstep, voffB); PG8_STAGE(PG8_SA(1, 0), a3, voffA);
            PG8_WAIT_V(8); PG8_WAIT_L(0); PG8_BAR; PG8_MMA(1, 0, At, B0); PG8_MMA(1, 1, At, B1); PG8_BAR; PG8_SCHED;
            } else {
            PG8_LDB(B0, 0, 0); PG8_SCHED; PG8_LDA(At, 0, 0); PG8_STAGE(PG8_SA(1, 1), a1 + hstep, voffA);
            PG8_WAIT_L(8); PG8_BAR; PG8_WAIT_L(0); PG8_MMA(0, 0, At, B0); PG8_BAR; PG8_SCHED;
            PG8_LDB(B1, 0, 1); PG8_STAGE(PG8_SB(0, 0), b2, voffB);
            PG8_BAR; PG8_WAIT_L(0); PG8_MMA(0, 1, At, B1); PG8_BAR;
            PG8_LDA(At, 0, 1); PG8_STAGE(PG8_SA(0, 0), a2, voffA);
            PG8_BAR; PG8_WAIT_L(0); PG8_MMA(1, 0, At, B0); PG8_BAR; PG8_SCHED;
            PG8_STAGE(PG8_SB(0, 1), b2 + hstep, voffB);
            PG8_WAIT_V(6); PG8_BAR; PG8_MMA(1, 1, At, B1); PG8_BAR;
            PG8_LDB(B0, 1, 0); PG8_SCHED; PG8_LDA(At, 1, 0); PG8_STAGE(PG8_SA(0, 1), a2 + hstep, voffA);
            PG8_WAIT_L(8); PG8_BAR; PG8_WAIT_L(0); PG8_MMA(0, 0, At, B0); PG8_BAR; PG8_SCHED;
            PG8_LDB(B1, 1, 1); PG8_STAGE(PG8_SB(1, 0), b3, voffB);
            PG8_BAR; PG8_WAIT_L(0); PG8_MMA(0, 1, At, B1); PG8_BAR;
            PG8_LDA(At, 1, 1); PG8_STAGE(PG8_SA(1, 0), a3, voffA);
            PG8_BAR; PG8_WAIT_L(0); PG8_MMA(1, 0, At, B0); PG8_BAR; PG8_SCHED;
            PG8_STAGE(PG8_SB(1, 1), b3 + hstep, voffB);
            PG8_WAIT_V(6); PG8_BAR; PG8_MMA(1, 1, At, B1); PG8_BAR;
            }
        }
        if constexpr (ALIGN_EPI) { if (wr == 0) PG8_BAR; }
        if constexpr (!Epi::AFTER_DRAIN) { E(acc, cur, wr, wc, fr, fq); S.done(cur); }
        if (!has_next) break;
#pragma unroll
        for (int a = 0; a < 2; ++a)
#pragma unroll
            for (int b = 0; b < 2; ++b)
#pragma unroll
                for (int m = 0; m < 4; ++m)
#pragma unroll
                    for (int n = 0; n < 2; ++n) acc[a][b][m][n] = (acc_t){0, 0, 0, 0};
        cur = nxt; cA = nA; cB = nB; ++ui;
        if constexpr (ALIGN_EPI) { if (wr == 1) PG8_BAR; }
    }
    PG8_WAIT_V(0);
    if constexpr (!ALIGN_EPI) { if (wr == 0) PG8_BAR; }
    PG8_BAR;
    if constexpr (Epi::AFTER_DRAIN) { E.fused(acc, cur, wr, wc, fr, fq, lds, wid, lane); }
#undef PG8_SA
#undef PG8_SB
#undef PG8_STAGE
#undef PG8_LDA
#undef PG8_LDB
#undef PG8_MMA
#undef PG8_WAIT_V
#undef PG8_WAIT_L
#undef PG8_BAR
#undef PG8_SCHED
}
}

constexpr int NT_TOK = 24576, DM = 2048, INW = 4608, NPROMPT = 16384;
constexpr int NWAVES = 8, NTHREADS = 512;
constexpr float RMS_EPS = 1e-6f;
constexpr float LOG2E = 1.4426950408889634f;

constexpr size_t MiB = 1u << 20;
constexpr size_t WS_CTL = 0, CTL_ZERO_BYTES = 128 * 1024;
constexpr size_t WS_CMAX_IN = 64 * 1024;
constexpr size_t WS_SWI = 35 * MiB + 640 * 1024;
constexpr size_t WS_SXN = 39 * MiB + 262144;
constexpr size_t WS_SX2 = 39 * MiB + 393216;
constexpr size_t WS_WIN = 1 * MiB;
constexpr size_t WS_WOUT = 19 * MiB;
constexpr size_t WS_SWO = 23 * MiB;
constexpr size_t WS_CMAX = 32 * 1024;
constexpr size_t WS_SA = 39 * MiB + 131072;
constexpr size_t WS_SX = 39 * MiB + 262144;
constexpr size_t WS_SWQ = 31 * MiB;
constexpr size_t WS_CMAX2 = 48 * 1024;
constexpr size_t OUT_X2Q = 0;
constexpr size_t WS_WPQ = 27 * MiB;
constexpr size_t WS_SK = 35 * MiB;
constexpr size_t WS_SS = 36 * MiB;
constexpr size_t WS_US = 39 * MiB;
constexpr size_t WS_VS = 39 * MiB + 65536;
constexpr size_t WS_U = 40 * MiB;
constexpr size_t WS_V = 72 * MiB;
constexpr size_t WS_XN = 168 * MiB;
constexpr size_t WS_PROJ = 264 * MiB;
constexpr size_t WS_MIXED = WS_PROJ;
constexpr size_t WS_X2B = WS_PROJ + 96 * MiB;
constexpr size_t WS_RE16 = WS_PROJ + 192 * MiB;
constexpr size_t WS_RG = WS_PROJ + 198 * MiB;
constexpr size_t WS_CQ = WS_PROJ + 210 * MiB;
constexpr size_t WS_SCQ = WS_PROJ + 213 * MiB;
constexpr size_t WS_SS3 = WS_PROJ + 214 * MiB;
constexpr size_t WS_PD0 = WS_XN;
constexpr size_t WS_PD1 = WS_MIXED;
constexpr size_t WS_END = 480 * MiB;
constexpr int IG_NGRP = 64, IG_TOK = 384, IG_NSUB = 256, IG_SUBT = 96, IG_SPG = IG_TOK / IG_SUBT, IG_PICKS = IG_TOK * 128, IG_PITCH = 272;
constexpr size_t WS_L = 104 * MiB;
constexpr size_t WS_TL = 117 * MiB;
constexpr size_t WS_H = 118 * MiB;
constexpr size_t WS_RSTD2 = 119 * MiB;
constexpr size_t WS_NTL = 119 * MiB + 131072;
constexpr size_t OUT_OA = 0, OUT_OA_STRIDE = 48 * MiB, OUT_LSE = 144 * MiB, OUT_LSE_STRIDE = (size_t)NT_TOK * 16 * 4;

constexpr int LDS_BYTES = 147456;

#define LAS __attribute__((address_space(3)))
typedef unsigned short bf16;
typedef unsigned v4u __attribute__((ext_vector_type(4)));
typedef unsigned v2u __attribute__((ext_vector_type(2)));
typedef float f32x4 __attribute__((ext_vector_type(4)));
typedef float f32x16 __attribute__((ext_vector_type(16)));
typedef short bf16x8 __attribute__((ext_vector_type(8)));
typedef short s16x4 __attribute__((ext_vector_type(4)));
typedef float f32x2 __attribute__((ext_vector_type(2)));

typedef __bf16 bf16x2_t __attribute__((ext_vector_type(2)));
__device__ __forceinline__ unsigned pk2(float lo, float hi) { const f32x2 v = {lo, hi}; return __builtin_bit_cast(unsigned, __builtin_convertvector(v, bf16x2_t)); }
__device__ __forceinline__ float bflo(unsigned w) { return __builtin_bit_cast(float, w << 16); }
__device__ __forceinline__ float bfhi(unsigned w) { return __builtin_bit_cast(float, w & 0xffff0000u); }
__device__ __forceinline__ float wave_sum(float v) {
#pragma unroll
    for (int o = 1; o < 64; o <<= 1) v += __shfl_xor(v, o);
    return v;
}

struct Args { const float* in[14]; float* out; unsigned char* ws; int ph_lo, ph_hi; };

struct Frame {
    LAS unsigned char* lds; unsigned char* lds_g;
    int tid, lane, wave, vcu, G;
    const float *xp, *xs, *norm1_g, *w_in, *a_out_g, *b_out_g, *sink, *w_out, *norm2_g, *w_pq, *sub_keys, *expert_u, *expert_v, *normf_g;
    float* out; unsigned char* ws;
};


#define XB_TMO      128
#define XB_XCNT(j)  (256  + 64 * (j))
#define XB_XSUB(j)  (1280 + 64 * (j))
#define XB_XGEN(j)  (2304 + 64 * (j))
#define XB_TOP      3328
#define XB_TOPGEN   3392
#define XCD_BAR_WORDS 3456
#define XB_SPIN_CAP (1u << 22)
__device__ __forceinline__ unsigned xb_ld(unsigned* p)              { return __hip_atomic_load(p, __ATOMIC_RELAXED, __HIP_MEMORY_SCOPE_AGENT); }
__device__ __forceinline__ unsigned xb_add(unsigned* p, unsigned v) { return __hip_atomic_fetch_add(p, v, __ATOMIC_RELAXED, __HIP_MEMORY_SCOPE_AGENT); }
__device__ __forceinline__ unsigned xb_xcc_id() { return (unsigned)__builtin_amdgcn_s_getreg((3 << 11) | 20) & 0xFu; }
#define XB_SPIN(cond, bar) do { unsigned _sp = 0; while (cond) { __builtin_amdgcn_s_sleep(1); \
    if ((++_sp & 255u) == 0u) { if (xb_ld(&(bar)[XB_TMO])) break; if (_sp > XB_SPIN_CAP) { atomicAdd(&(bar)[XB_TMO], 1u); break; } } } } while (0)
struct XcdBarrier { unsigned* bar; unsigned x; volatile LAS unsigned* st; };
__device__ __forceinline__ XcdBarrier xcd_barrier_post(unsigned* bar, volatile LAS unsigned* st) {
    XcdBarrier b; b.bar = bar; b.x = xb_xcc_id(); b.st = st;
    if (threadIdx.x == 0) st[2] = xb_add(&bar[XB_XCNT(b.x)], 1u);
    return b;
}
__device__ __forceinline__ void xcd_barrier_complete(unsigned* bar, unsigned x, unsigned& nloc, unsigned& nx) {
    const unsigned G = gridDim.x * gridDim.y * gridDim.z;
    unsigned sum, cnt, mine, sp = 0u;
    for (;;) {
        sum = 0u; cnt = 0u; mine = 0u;
#pragma unroll
        for (unsigned j = 0; j < 16; ++j) { const unsigned c = xb_ld(&bar[XB_XCNT(j)]); sum += c; cnt += (c > 0u) ? 1u : 0u; mine = (j == x) ? c : mine; }
        if (sum == G) break;
        __builtin_amdgcn_s_sleep(1);
        if ((++sp & 255u) == 0u) { if (xb_ld(&bar[XB_TMO])) break; if (sp > XB_SPIN_CAP) { atomicAdd(&bar[XB_TMO], 1u); break; } }
    }
    nloc = mine > 0u ? mine : 1u; nx = cnt > 0u ? cnt : 1u;
}
__device__ __forceinline__ void xcd_barrier(const XcdBarrier& b) {
    asm volatile("s_waitcnt vmcnt(0)" ::: "memory");
    __syncthreads();
    if (threadIdx.x == 0) {
        unsigned* bar = b.bar;
        __builtin_amdgcn_s_waitcnt(0);
        unsigned nloc = b.st[0], nx = b.st[1];
        if (nloc == 0u) { xcd_barrier_complete(bar, b.x, nloc, nx); b.st[0] = nloc; b.st[1] = nx; }
        const unsigned old = xb_add(&bar[XB_XSUB(b.x)], 1u);
        const unsigned gen = old / nloc;
        if (old + 1u == (gen + 1u) * nloc) {
            __builtin_amdgcn_fence(__ATOMIC_RELEASE, "agent");
            asm volatile("s_waitcnt vmcnt(0)" ::: "memory");
            const unsigned og = xb_add(&bar[XB_TOP], 1u);
            const unsigned tg = og / nx;
            if (og + 1u == (tg + 1u) * nx) xb_add(&bar[XB_TOPGEN], 1u);
            else XB_SPIN(xb_ld(&bar[XB_TOPGEN]) == tg, bar);
            __builtin_amdgcn_fence(__ATOMIC_ACQUIRE, "agent");
            xb_add(&bar[XB_XGEN(b.x)], 1u);
            asm volatile("s_waitcnt vmcnt(0)" ::: "memory");
        } else {
            XB_SPIN(xb_ld(&bar[XB_XGEN(b.x)]) == gen, bar);
            __builtin_amdgcn_fence(__ATOMIC_ACQUIRE, "agent");
            asm volatile("s_waitcnt vmcnt(0)" ::: "memory");
        }
    }
    __syncthreads();
}
constexpr int MISC_OFF = 131072 + 320;

template <bool HASKS>
__device__ __forceinline__ void p0_transpose_item(const float* W, int K, int N, bf16* WT, const float* kscale, LAS float* scr, int item, int lane) {
    const int nblk = N / 32, kb = item / nblk, nb = item % nblk, k0 = 64 * kb, n0 = 32 * nb;
#pragma unroll 32
    for (int i = 0; i < 32; ++i) { const int kk = 2 * i + (lane >> 5); float v = W[(size_t)(k0 + kk) * N + n0 + (lane & 31)]; if (HASKS) v *= kscale[k0 + kk]; scr[kk * 33 + (lane & 31)] = v; }
    asm volatile("s_waitcnt lgkmcnt(0)" ::: "memory");
    const int c = lane & 7;
#pragma unroll
    for (int j = 0; j < 4; ++j) { const int n = (lane >> 3) + 8 * j; const LAS float* s = scr + (8 * c) * 33 + n;
        v4u o; o.x = pk2(s[0 * 33], s[1 * 33]); o.y = pk2(s[2 * 33], s[3 * 33]); o.z = pk2(s[4 * 33], s[5 * 33]); o.w = pk2(s[6 * 33], s[7 * 33]);
        *(v4u*)(WT + (size_t)(n0 + n) * K + k0 + 8 * c) = o; }
    asm volatile("s_waitcnt lgkmcnt(0)" ::: "memory");
}
template <int NN, bool HASKS>
__device__ __forceinline__ void p1_quant_w(Frame& F, const float* W, const float* kscale, const float* cmax, unsigned char* WQ, float* SW) {
    LAS float* scr = (LAS float*)(F.lds + F.wave * 16384);
    const int gw = F.vcu * NWAVES + F.wave, NGW = F.G * NWAVES, lane = fresh_lane();
    constexpr int NITEM = (DM / 64) * (NN / 32);
    for (int item = gw; item < NITEM; item += NGW) {
        const int nblk = NN / 32, kb = item / nblk, nb = item % nblk, k0 = 64 * kb, n0 = 32 * nb;
        const float cm = cmax[n0 + (lane & 31)]; const float inv = cm > 0.f ? 127.0f / cm : 0.f;
#pragma unroll 32
        for (int i = 0; i < 32; ++i) { const int kk = 2 * i + (lane >> 5); float v = W[(size_t)(k0 + kk) * NN + n0 + (lane & 31)] * inv; if (HASKS) v *= kscale[k0 + kk]; scr[kk * 33 + (lane & 31)] = v; }
        asm volatile("s_waitcnt lgkmcnt(0)" ::: "memory");
        const int c = lane & 3;
#pragma unroll
        for (int j = 0; j < 2; ++j) { const int n = (lane >> 2) + 16 * j; const LAS float* s = scr + (16 * c) * 33 + n; v4u o;
#pragma unroll
            for (int q = 0; q < 4; ++q) { unsigned w = 0;
#pragma unroll
                for (int e = 0; e < 4; ++e) w |= ((unsigned)(int)__builtin_rintf(s[(4 * q + e) * 33]) & 0xffu) << (8 * e);
                o[q] = w; }
            *(v4u*)(WQ + (size_t)(n0 + n) * DM + k0 + 16 * c) = o; }
        if (kb == 0 && lane < 32) SW[n0 + lane] = cm > 0.f ? cm * (1.0f / 127.0f) : 1.0f;
        asm volatile("s_waitcnt lgkmcnt(0)" ::: "memory");
    }
}
__device__ __forceinline__ void p0_prep(Frame& F) {
    LAS float* scr = (LAS float*)(F.lds + F.wave * 16384);
    const int gw = F.vcu * NWAVES + F.wave, NGW = F.G * NWAVES, lane = fresh_lane();
    bf16* WinT = (bf16*)(F.ws + WS_WIN); bf16* WpqT = (bf16*)(F.ws + WS_WPQ);
    constexpr int I_IN = (DM / 64) * (INW / 32), I_OUT = (DM / 64) * (DM / 32), I_PQ = I_OUT;
    for (int it = gw; it < I_IN + I_OUT + I_PQ; it += NGW) {
        int r = it;
#define P0_CMAX_ITEM(W, KS, CM, HASKS) P0_CMAX_ITEM_N(W, KS, CM, DM, HASKS)
#define P0_CMAX_ITEM_N(W, KS, CM, NN, HASKS) do { const int nblk_ = (NN) / 32, kb_ = r / nblk_, nb_ = r % nblk_; float mx_ = 0.f; \
            _Pragma("unroll 32") for (int i_ = 0; i_ < 32; ++i_) { const int k_ = 64 * kb_ + 2 * i_ + (lane >> 5); float v_ = (W)[(size_t)k_ * (NN) + 32 * nb_ + (lane & 31)]; if (HASKS) v_ *= ((const float*)(KS))[k_]; mx_ = fmaxf(mx_, fabsf(v_)); } \
            mx_ = fmaxf(mx_, __shfl_xor(mx_, 32)); \
            if (lane < 32) atomicMax((unsigned*)(F.ws + (CM)) + 32 * nb_ + lane, __builtin_bit_cast(unsigned, mx_)); } while (0)
#if P1_I8
        if (r < I_IN) { P0_CMAX_ITEM_N(F.w_in, (const float*)nullptr, WS_CMAX_IN, INW, 0); continue; } r -= I_IN;
#else
        if (r < I_IN) { p0_transpose_item<false>(F.w_in, DM, INW, WinT, nullptr, scr, r, lane); continue; } r -= I_IN;
#endif
#if P4_I8
        if (r < I_OUT) { P0_CMAX_ITEM(F.w_out, (const float*)nullptr, WS_CMAX, 0); continue; } r -= I_OUT;
#else
        if (r < I_OUT) { p0_transpose_item<false>(F.w_out, DM, DM, (bf16*)(F.ws + WS_WOUT), nullptr, scr, r, lane); continue; } r -= I_OUT;
#endif
#if P5_I8
        P0_CMAX_ITEM(F.w_pq, F.norm2_g, WS_CMAX2, 1); continue;
#endif
#if !P5_I8
        p0_transpose_item<true>(F.w_pq, DM, DM, WpqT, F.norm2_g, scr, r, lane);
#endif
    }
    { bf16* SK = (bf16*)(F.ws + WS_SK);
      for (int i = gw * 64 + lane; i < 65536; i += NGW * 64) { const f32x4 v = ((const f32x4*)F.sub_keys)[i]; v2u o; o.x = pk2(v[0], v[1]); o.y = pk2(v[2], v[3]); ((v2u*)SK)[i] = o; } }
    { unsigned char* U = F.ws + WS_U; unsigned char* V = F.ws + WS_V; float* US = (float*)(F.ws + WS_US); float* VS = (float*)(F.ws + WS_VS);
      float g2[32];
#pragma unroll
      for (int j = 0; j < 2; ++j)
#pragma unroll
          for (int q = 0; q < 4; ++q) { const f32x4 t = *(const f32x4*)(F.norm2_g + 1024 * j + 16 * lane + 4 * q); g2[16 * j + 4 * q] = t[0]; g2[16 * j + 4 * q + 1] = t[1]; g2[16 * j + 4 * q + 2] = t[2]; g2[16 * j + 4 * q + 3] = t[3]; }
#define P0_ROWSRC(row) (((row) < 16384 ? F.expert_u + (size_t)(row) * DM : F.expert_v + (size_t)((row) - 16384) * DM) + 16 * lane)
      f32x4 cur[8], nxt[8];
#define P0_ROWOF(n) ((((n) >> 4) * NGW + gw) * 16 + ((n) & 15))
      if (gw < 2048) { const float* s0 = P0_ROWSRC(P0_ROWOF(0));
#pragma unroll
          for (int q = 0; q < 8; ++q) cur[q] = *(const f32x4*)(s0 + 1024 * (q >> 2) + 4 * (q & 3)); }
#pragma unroll 1
      for (int n = 0; P0_ROWOF(n) < 32768; ++n) {
          const int row = P0_ROWOF(n);
          const bool isu = row < 16384; const int e = isu ? row : row - 16384;
          unsigned char* dst = (isu ? U : V) + (size_t)e * 128;
          { const int rn = (P0_ROWOF(n + 1) < 32768) ? P0_ROWOF(n + 1) : row; const float* sn = P0_ROWSRC(rn);
#pragma unroll
            for (int q = 0; q < 8; ++q) nxt[q] = *(const f32x4*)(sn + 1024 * (q >> 2) + 4 * (q & 3)); }
          float v[32]; float am = 0.f;
#pragma unroll
          for (int q = 0; q < 8; ++q)
#pragma unroll
              for (int c = 0; c < 4; ++c) { float x = cur[q][c]; if (isu) x *= g2[4 * q + c]; v[4 * q + c] = x; am = fmaxf(am, fabsf(x)); }
#pragma unroll
          for (int o = 1; o < 64; o <<= 1) am = fmaxf(am, __shfl_xor(am, o));
          const float inv = am > 0.f ? 127.0f / am : 0.f;
#pragma unroll
          for (int j = 0; j < 2; ++j) { v4u o;
#pragma unroll
              for (int q = 0; q < 4; ++q) { unsigned w = 0;
#pragma unroll
                  for (int c = 0; c < 4; ++c) { const int qi = (int)__builtin_rintf(v[16 * j + 4 * q + c] * inv); w |= ((unsigned)qi & 0xffu) << (8 * c); }
                  o[q] = w; }
#if P7A_INV
              if (isu) { const int cidx = lane + 64 * j;
                  *(v4u*)(U + (size_t)(cidx >> 4) * (1024 * 4096) + (size_t)(e >> 4) * 4096 + ((cidx & 15) >> 2) * 1024 + (((cidx & 3) << 4) + (e & 15)) * 16) = o; }
              else
#endif
              *(v4u*)(dst + (size_t)((lane >> 3) + 8 * j) * (16384 * 128) + 16 * (lane & 7)) = o; }
          if (lane == 0) (isu ? US : VS)[e] = am > 0.f ? am * (1.0f / 127.0f) : 1.0f;
#pragma unroll
          for (int q = 0; q < 8; ++q) cur[q] = nxt[q]; }
#undef P0_ROWSRC
#undef P0_ROWOF
    }
    { bf16* XN = (bf16*)(F.ws + WS_XN);
#define P0_XROW(t) (((t) < NPROMPT ? F.xp + (size_t)(t) * DM : F.xs + (size_t)((t) - NPROMPT) * DM) + 8 * lane)
      f32x4 cur[4][2], nxt[4][2], g1a[4], g1b[4];
#pragma unroll
      for (int j = 0; j < 4; ++j) { g1a[j] = *(const f32x4*)(F.norm1_g + 512 * j + 8 * lane); g1b[j] = *(const f32x4*)(F.norm1_g + 512 * j + 8 * lane + 4); }
      if (gw < NT_TOK) { const float* x0 = P0_XROW(gw);
#pragma unroll
          for (int j = 0; j < 4; ++j) { cur[j][0] = *(const f32x4*)(x0 + 512 * j); cur[j][1] = *(const f32x4*)(x0 + 512 * j + 4); } }
#pragma unroll 1
      for (int t = gw; t < NT_TOK; t += NGW) {
          { const int tn = (t + NGW < NT_TOK) ? t + NGW : t; const float* xn_ = P0_XROW(tn);
#pragma unroll
            for (int j = 0; j < 4; ++j) { nxt[j][0] = *(const f32x4*)(xn_ + 512 * j); nxt[j][1] = *(const f32x4*)(xn_ + 512 * j + 4); } }
          float s = 0.f;
#pragma unroll
          for (int j = 0; j < 4; ++j)
#pragma unroll
              for (int q = 0; q < 2; ++q) s += (cur[j][q][0] * cur[j][q][0] + cur[j][q][1] * cur[j][q][1]) + (cur[j][q][2] * cur[j][q][2] + cur[j][q][3] * cur[j][q][3]);
          const float rstd = 1.0f / sqrtf(wave_sum(s) * (1.0f / DM) + RMS_EPS);
#if P5_I8 == 2
          if (lane == 0) ((float*)(F.ws + WS_SX2))[t] = 6.0f / (127.0f * rstd);
#endif
#if P1_I8
          f32x4 xa[4], xb4[4]; float am = 0.f;
#pragma unroll
          for (int j = 0; j < 4; ++j) { const f32x4 ga = g1a[j], gb = g1b[j];
              xa[j] = cur[j][0] * rstd * ga; xb4[j] = cur[j][1] * rstd * gb;
#pragma unroll
              for (int c = 0; c < 4; ++c) am = fmaxf(am, fmaxf(fabsf(xa[j][c]), fabsf(xb4[j][c]))); }
#pragma unroll
          for (int o = 1; o < 64; o <<= 1) am = fmaxf(am, __shfl_xor(am, o));
          const float inv = am > 0.f ? 127.0f / am : 0.f;
#pragma unroll
          for (int j = 0; j < 4; ++j) { v2u o; unsigned w0 = 0, w1 = 0;
#pragma unroll
              for (int c = 0; c < 4; ++c) { w0 |= ((unsigned)(int)__builtin_rintf(xa[j][c] * inv) & 0xffu) << (8 * c); w1 |= ((unsigned)(int)__builtin_rintf(xb4[j][c] * inv) & 0xffu) << (8 * c); }
              o.x = w0; o.y = w1; *(v2u*)((unsigned char*)XN + (size_t)t * DM + 512 * j + 8 * lane) = o; }
          if (lane == 0) ((float*)(F.ws + WS_SXN))[t] = am > 0.f ? am * (1.0f / 127.0f) : 1.0f;
#else
#pragma unroll
          for (int j = 0; j < 4; ++j) { const f32x4 ga = g1a[j], gb = g1b[j];
              const f32x4 a = cur[j][0] * rstd * ga, b = cur[j][1] * rstd * gb;
              v4u o; o.x = pk2(a[0], a[1]); o.y = pk2(a[2], a[3]); o.z = pk2(b[0], b[1]); o.w = pk2(b[2], b[3]);
              *(v4u*)(XN + (size_t)t * DM + 512 * j + 8 * lane) = o; }
#endif
#pragma unroll
          for (int j = 0; j < 4; ++j) { cur[j][0] = nxt[j][0]; cur[j][1] = nxt[j][1]; } }
#undef P0_XROW
    }
}

constexpr int ATT_KOFF = 0, ATT_VOFF = 65536;
struct AttU { int valid, isB, p, rowbase, Lsub, r, d, q0, kcol, vcol, qcol, head, nh; };
__device__ __forceinline__ AttU att_decode_b(int gb, int kvh, int qp) {
    AttU u; u.valid = 1; u.isB = 1; u.p = 0; u.rowbase = gb < 64 ? (gb >> 4) * 4096 : NPROMPT; u.Lsub = gb < 64 ? 4096 : 8192; u.r = 0; u.d = 1; u.q0 = 256 * (gb < 64 ? (gb & 15) : (gb - 64));
    u.kcol = 4096 + kvh * 64; u.vcol = 4352 + kvh * 64; u.head = kvh * 4 + qp * 2; u.qcol = 3072 + u.head * 64; u.nh = 2; return u;
}
__device__ __forceinline__ AttU att_decode_a(int p, int head, int gb) {
    AttU u; const int d = p == 0 ? 1 : (p == 1 ? 4 : 16); const int L = gb < 64 ? 4096 : 8192; const int idx = gb < 64 ? (gb & 15) : (gb - 64);
    u.valid = 1; u.isB = 0; u.p = p; u.rowbase = gb < 64 ? (gb >> 4) * 4096 : NPROMPT; u.Lsub = L / d; u.r = idx % d; u.d = d; u.q0 = 256 * (idx / d);
    u.kcol = 1024 + head * 64; u.vcol = 2048 + head * 64; u.head = head; u.qcol = head * 64; u.nh = 1; return u;
}
__device__ __forceinline__ AttU att_unit(int vcu, int G, int k) {
    AttU u; u.valid = 0;
    if (G == 256) {
        if (k >= 21) return u;
        const int x = vcu >> 5, lc = vcu & 31;
        if (k < 3) { const int gB = x * 3 + k, rg = gB % 6, kvh = gB / 6; return att_decode_b(16 * rg + (lc >> 1), kvh, lc & 1); }
        const int t = (k - 3) / 3, j = (k - 3) % 3, gp = x * 6 + t, uu0 = lc + 32 * j, group = 2 * gp + uu0 / 48, uu = uu0 % 48;
        return att_decode_a(uu / 16, group / 6, 16 * (group % 6) + (uu % 16));
    }
    const int uidx = vcu + k * G;
    if (uidx >= 768 + 4608) return u;
    if (uidx < 768) return att_decode_b(uidx >> 3, (uidx >> 1) & 3, uidx & 1);
    const int a = uidx - 768; return att_decode_a(a / 1536, (a % 1536) / 96, a % 96);
}
template <int HALFW, bool LDSFLAT = false>
__device__ __forceinline__ void att_wave(int lane, int w, const LAS unsigned char* Ks, const LAS unsigned char* Vs, int kp0  , int Lsub,
                                         const bf16x8 (&qf)[4], float slope2, f32x16& o0, f32x16& o1, float& m_out, float& l_out, int jbeg = 0, int jend = 1 + 2 * HALFW / 32) {
    constexpr int NTILE = 1 + 2 * HALFW / 32, JM = HALFW / 32;
    const int ql = lane & 31, hh = lane >> 5;
    o0 = (f32x16){}; o1 = (f32x16){};
    float m = -1e30f, lsum = 0.f;
    const int i15 = lane & 15, G = (lane >> 4) & 1, ql4 = ql - 4 * hh;
    f32x16 CL, CM, CR;
    { const float sq = slope2 * (float)ql;
#pragma unroll
      for (int reg = 0; reg < 16; ++reg) { const float kb_ = slope2 * (float)((reg & 3) + 8 * (reg >> 2) + 4 * hh); CL[reg] = kb_; CR[reg] = -kb_; CM[reg] = -fabsf(kb_ - sq); } }
    const LAS unsigned char* kb = Ks + (LDSFLAT ? 0 : (32 * w + ql) * 128); const int sw = LDSFLAT ? 0 : ((ql >> 1) & 7);
    int koff[4];
#pragma unroll
    for (int ks = 0; ks < 4; ++ks) koff[ks] = LDSFLAT ? 0 : (((2 * ks + hh) ^ sw) << 4);
    const int c0 = (2 * G + ((i15 & 3) >> 1)) ^ (((i15 >> 3) & 1) << 2);
    const LAS unsigned char* vb0 = LDSFLAT ? Vs : Vs + (32 * w + 4 * hh + (i15 >> 2)) * 128 + (i15 & 1) * 8 + (c0 << 4);
    const LAS unsigned char* vb1 = LDSFLAT ? Vs + 64 : Vs + (32 * w + 4 * hh + (i15 >> 2)) * 128 + (i15 & 1) * 8 + ((c0 ^ 4) << 4);
    bf16x8 kf[4];
#pragma unroll
    for (int ks = 0; ks < 4; ++ks) kf[ks] = *(const LAS bf16x8*)(kb + koff[ks]);
#pragma unroll 1
    for (int j = jbeg; j < jend; ++j) {
        const int kt0 = kp0 + 32 * j;
        const int jn = (j + 1 < NTILE) ? j + 1 : j;
        if (!(kt0 + 31 < 0 || kt0 >= Lsub)) {
            s16x4 vlo[2][2], vhi[2][2];
#pragma unroll
            for (int st = 0; st < 2; ++st) {
                vlo[0][st] = __builtin_bit_cast(s16x4, __builtin_amdgcn_ds_read_tr16_b64_v4i16((LAS s16x4*)(vb0 + 4096 * j + 2048 * st)));
                vhi[0][st] = __builtin_bit_cast(s16x4, __builtin_amdgcn_ds_read_tr16_b64_v4i16((LAS s16x4*)(vb0 + 4096 * j + 2048 * st + 1024)));
                vlo[1][st] = __builtin_bit_cast(s16x4, __builtin_amdgcn_ds_read_tr16_b64_v4i16((LAS s16x4*)(vb1 + 4096 * j + 2048 * st)));
                vhi[1][st] = __builtin_bit_cast(s16x4, __builtin_amdgcn_ds_read_tr16_b64_v4i16((LAS s16x4*)(vb1 + 4096 * j + 2048 * st + 1024))); }
            f32x16 s; float cj;
            const float cl = slope2 * (float)(32 * j - HALFW - ql);
            if (j < JM) { s = __builtin_amdgcn_mfma_f32_32x32x16_bf16(kf[0], qf[0], CL, 0, 0, 0); cj = cl; }
            else if (j == JM) { s = __builtin_amdgcn_mfma_f32_32x32x16_bf16(kf[0], qf[0], CM, 0, 0, 0); cj = 0.f; }
            else { s = __builtin_amdgcn_mfma_f32_32x32x16_bf16(kf[0], qf[0], CR, 0, 0, 0); cj = -cl; }
#pragma unroll
            for (int ks = 1; ks < 4; ++ks) s = __builtin_amdgcn_mfma_f32_32x32x16_bf16(kf[ks], qf[ks], s, 0, 0, 0);
#pragma unroll
            for (int ks = 0; ks < 4; ++ks) kf[ks] = *(const LAS bf16x8*)(kb + 4096 * jn + koff[ks]);
            if (j == 0) {
#pragma unroll
                for (int reg = 0; reg < 16; ++reg) s[reg] = ((reg & 3) + 8 * (reg >> 2) >= ql4) ? s[reg] : -INFINITY;
            } else if (j == NTILE - 1) {
#pragma unroll
                for (int reg = 0; reg < 16; ++reg) s[reg] = ((reg & 3) + 8 * (reg >> 2) <= ql4) ? s[reg] : -INFINITY;
            }
            if (kt0 < 0 || kt0 + 31 >= Lsub) {
                const int kq = kt0 + 4 * hh;
#pragma unroll
                for (int reg = 0; reg < 16; ++reg) { const int kpos = kq + (reg & 3) + 8 * (reg >> 2); s[reg] = ((unsigned)kpos < (unsigned)Lsub) ? s[reg] : -INFINITY; }
            }
            float tmax = fmaxf(fmaxf(s[0], s[1]), s[2]);
#pragma unroll
            for (int reg = 3; reg < 15; reg += 2) tmax = fmaxf(fmaxf(tmax, s[reg]), s[reg + 1]);
            tmax = fmaxf(tmax, s[15]) + cj;
            tmax = fmaxf(tmax, __shfl_xor(tmax, 32));
            if (__any(tmax > m + 8.0f)) { const float mnew = fmaxf(m, tmax); const float alpha = __builtin_amdgcn_exp2f(m - mnew); lsum *= alpha; m = mnew;
#pragma unroll
                for (int reg = 0; reg < 16; ++reg) { o0[reg] *= alpha; o1[reg] *= alpha; } }
            const float dd = cj - m;
            f32x2 ps2 = {0.f, 0.f}; const f32x2 dd2 = {dd, dd};
#pragma unroll
            for (int rp = 0; rp < 8; ++rp) { f32x2 t; { const f32x2 in_ = {s[2 * rp], s[2 * rp + 1]}; asm("v_pk_add_f32 %0, %1, %2" : "=v"(t) : "v"(in_), "v"(dd2)); } t[0] = __builtin_amdgcn_exp2f(t[0]); t[1] = __builtin_amdgcn_exp2f(t[1]); s[2 * rp] = t[0]; s[2 * rp + 1] = t[1]; asm("v_pk_add_f32 %0, %1, %2" : "=v"(ps2) : "v"(ps2), "v"(t)); }
            lsum += ps2[0] + ps2[1];
            bf16x8 pf[2];
#pragma unroll
            for (int st = 0; st < 2; ++st) { v4u t; t.x = pk2(s[8 * st + 0], s[8 * st + 1]); t.y = pk2(s[8 * st + 2], s[8 * st + 3]); t.z = pk2(s[8 * st + 4], s[8 * st + 5]); t.w = pk2(s[8 * st + 6], s[8 * st + 7]); pf[st] = __builtin_bit_cast(bf16x8, t); }
#pragma unroll
            for (int st = 0; st < 2; ++st) {
                const bf16x8 v0 = (bf16x8){vlo[0][st][0], vlo[0][st][1], vlo[0][st][2], vlo[0][st][3], vhi[0][st][0], vhi[0][st][1], vhi[0][st][2], vhi[0][st][3]};
                const bf16x8 v1 = (bf16x8){vlo[1][st][0], vlo[1][st][1], vlo[1][st][2], vlo[1][st][3], vhi[1][st][0], vhi[1][st][1], vhi[1][st][2], vhi[1][st][3]};
                o0 = __builtin_amdgcn_mfma_f32_32x32x16_bf16(v0, pf[st], o0, 0, 0, 0);
                o1 = __builtin_amdgcn_mfma_f32_32x32x16_bf16(v1, pf[st], o1, 0, 0, 0); }
        } else {
#pragma unroll
            for (int ks = 0; ks < 4; ++ks) kf[ks] = *(const LAS bf16x8*)(kb + 4096 * jn + koff[ks]);
        }
    }
    lsum += __shfl_xor(lsum, 32);
    m_out = m; l_out = lsum;
}
__device__ __forceinline__ void att_store(bf16* orow, const f32x16& o0, const f32x16& o1, float scale, int hh) {
#pragma unroll
    for (int dt = 0; dt < 2; ++dt)
#pragma unroll
        for (int k = 0; k < 4; k += 2) {
            const f32x16& o = dt ? o1 : o0;
            const unsigned ax = pk2(o[4 * k] * scale, o[4 * k + 1] * scale), ay = pk2(o[4 * k + 2] * scale, o[4 * k + 3] * scale);
            const unsigned bx = pk2(o[4 * k + 4] * scale, o[4 * k + 5] * scale), by = pk2(o[4 * k + 6] * scale, o[4 * k + 7] * scale);
            const auto sx = __builtin_amdgcn_permlane32_swap(ax, bx, false, false), sy = __builtin_amdgcn_permlane32_swap(ay, by, false, false);
            v4u w; w.x = sx[0]; w.y = sy[0]; w.z = sx[1]; w.w = sy[1];
            *(v4u*)(orow + 32 * dt + 8 * (k + hh)) = w; }
}
template <int MODE  >
__device__ __forceinline__ void p2_attention(Frame& F) {
    const bf16* proj = (const bf16*)(F.ws + WS_PROJ);
    bf16* OB = (bf16*)(F.ws + WS_XN + (MODE >= 2 ? 48 * MiB : 0));
    unsigned char* outb = (unsigned char*)F.out;
    const int w = F.wave;
#define ATT_LOADKV(U) do { const int nk_ = (U).isB ? 512 : 384, iv0_ = (U).q0 - ((U).isB ? 128 : 64); \
        _Pragma("unroll") for (int it_ = 0; it_ < 8; ++it_) { const int idx_ = tid + it_ * NTHREADS, row_ = idx_ >> 3, ch_ = idx_ & 7, i_ = iv0_ + row_; const bool ok_ = (row_ < nk_) && (i_ >= 0) && (i_ < (U).Lsub); \
            const bf16* src_ = proj + (size_t)((U).rowbase + (U).r + (U).d * (ok_ ? i_ : 0)) * INW + ch_ * 8; \
            kk[it_] = ok_ ? *(const v4u*)(src_ + (U).kcol) : (v4u){0u, 0u, 0u, 0u}; vv[it_] = ok_ ? *(const v4u*)(src_ + (U).vcol) : (v4u){0u, 0u, 0u, 0u}; } } while (0)
#define ATT_WRITEKV(U) do { const int nk_ = (U).isB ? 512 : 384; const int row0_ = tid >> 3, ch_ = tid & 7;     \
        LAS unsigned char* kb_ = F.lds + ATT_KOFF + row0_ * 128 + ((ch_ ^ ((row0_ >> 1) & 7)) << 4); LAS unsigned char* vb_ = F.lds + ATT_VOFF + row0_ * 128 + ((ch_ ^ (((row0_ >> 1) & 1) << 2)) << 4); \
        _Pragma("unroll") for (int it_ = 0; it_ < 8; ++it_) { if (row0_ + 64 * it_ < nk_) { *(LAS v4u*)(kb_ + 8192 * it_) = kk[it_]; *(LAS v4u*)(vb_ + 8192 * it_) = vv[it_]; } } } while (0)
#define ATT_QLOAD(dst, U, h) do { const int tok_ = (U).rowbase + (U).r + (U).d * ((U).q0 + 32 * w + ql); const bf16* qp_ = proj + (size_t)tok_ * INW + (U).qcol + 64 * (h) + 8 * hh; \
        _Pragma("unroll") for (int ks_ = 0; ks_ < 4; ++ks_) dst[ks_] = *(const bf16x8*)(qp_ + 16 * ks_); } while (0)
    v4u kk[8], vv[8];
    const LAS unsigned char* Ks = F.lds + ATT_KOFF; const LAS unsigned char* Vs = F.lds + ATT_VOFF;
#pragma unroll 1
    for (int k = 0;; ++k) {
        const AttU cur = att_unit(F.vcu, F.G, k);
        if (!cur.valid) break;
        const int lane = fresh_lane();
        const int ql = lane & 31, hh = lane >> 5, tid = w * 64 + lane;
        bf16x8 qc[4];
        if (MODE == 0) ATT_QLOAD(qc, cur, 0);
        __syncthreads();
        if (MODE < 2) { ATT_LOADKV(cur); ATT_WRITEKV(cur); }
        __syncthreads();
        if (MODE == 1) continue;
#pragma unroll 1
        for (int h = 0; h < cur.nh; ++h) {
            if (MODE == 4) { const bf16* qp_ = proj + (size_t)ql * INW + 8 * hh;
#pragma unroll
                for (int ks_ = 0; ks_ < 4; ++ks_) qc[ks_] = *(const bf16x8*)(qp_ + 16 * ks_); }
            else if (MODE != 0 || h > 0) ATT_QLOAD(qc, cur, h);
            const int ln = lane;
            f32x16 o0, o1; float m, l;
            if (cur.isB) {
                const int hq = cur.head + h;
                const float slope = exp2f(-0.5f * (float)(hq + 1));
                att_wave<128, MODE == 6>(ln, w, Ks, Vs, cur.q0 - 128 + 32 * w, cur.Lsub, qc, slope * LOG2E, o0, o1, m, l, MODE == 5 ? 4 : 0, MODE == 5 ? 5 : 9);
                const int l2 = fresh_lane(), hh2 = l2 >> 5; const int tok0_ = cur.rowbase + cur.r + cur.d * (cur.q0 + 32 * w + (l2 & 31)); const int tok = (MODE >= 2) ? (tok0_ & 255) : tok0_;
                const float sk2 = F.sink[hq] * LOG2E; const float mf = fmaxf(m, sk2);
                const float sc = __builtin_amdgcn_exp2f(m - mf); const float den = l * sc + __builtin_amdgcn_exp2f(sk2 - mf);
                if (MODE >= 3) { const float z_ = sc / den; asm volatile("" :: "v"(o0), "v"(o1), "v"(z_)); }
                else att_store(OB + (size_t)tok * 1024 + hq * 64, o0, o1, sc / den, hh2);
            } else {
                const float slope = exp2f(-0.25f * (float)(2 * cur.head + 1));
                att_wave<64, MODE == 6>(ln, w, Ks, Vs, cur.q0 - 64 + 32 * w, cur.Lsub, qc, slope * (float)cur.d * LOG2E, o0, o1, m, l, MODE == 5 ? 2 : 0, MODE == 5 ? 3 : 5);
                const int l2 = fresh_lane(), hh2 = l2 >> 5; const int tok0_ = cur.rowbase + cur.r + cur.d * (cur.q0 + 32 * w + (l2 & 31)); const int tok = (MODE >= 2) ? (tok0_ & 255) : tok0_;
                bf16* OA = (MODE >= 2) ? (bf16*)(outb + 150 * MiB) : (bf16*)(outb + OUT_OA + (size_t)cur.p * OUT_OA_STRIDE);
                float* LSE = (MODE >= 2) ? (float*)(outb + 152 * MiB) : (float*)(outb + OUT_LSE + (size_t)cur.p * OUT_LSE_STRIDE);
                if (MODE >= 3) { const float z_ = m + l; asm volatile("" :: "v"(o0), "v"(o1), "v"(z_)); }
                else { att_store(OA + (size_t)tok * 1024 + cur.head * 64, o0, o1, 1.0f / l, hh2);
                    if (hh2 == 0) LSE[(size_t)tok * 16 + cur.head] = m + __builtin_amdgcn_logf(l); }
            }
        }
    }
#undef ATT_LOADKV
#undef ATT_WRITEKV
#undef ATT_QLOAD
    __syncthreads();
}

__device__ __forceinline__ void p3_finalize(Frame& F) {
    const int gw = F.vcu * NWAVES + F.wave, NGW = F.G * NWAVES, lane = fresh_lane();
    const unsigned char* outb = (const unsigned char*)F.out;
    const bf16* OB = (const bf16*)(F.ws + WS_XN);
    unsigned char* MIXQ = F.ws + WS_MIXED; float* SA = (float*)(F.ws + WS_SA); bf16* MIXED = (bf16*)(F.ws + WS_MIXED); (void)MIXQ; (void)SA; (void)MIXED;
    const int head = lane >> 2;
    f32x4 gaq[4], gbq[4];
#pragma unroll
    for (int q = 0; q < 4; ++q) { gaq[q] = *(const f32x4*)(F.a_out_g + 16 * lane + 4 * q); gbq[q] = *(const f32x4*)(F.b_out_g + 16 * lane + 4 * q); }
    for (int t = gw; t < NT_TOK; t += NGW) {
        float ls[3]; v4u oa[3][2];
#pragma unroll
        for (int p = 0; p < 3; ++p) { ls[p] = ((const float*)(outb + OUT_LSE + (size_t)p * OUT_LSE_STRIDE))[(size_t)t * 16 + head];
            const v4u* src = (const v4u*)((const bf16*)(outb + OUT_OA + (size_t)p * OUT_OA_STRIDE) + (size_t)t * 1024 + 16 * lane); oa[p][0] = src[0]; oa[p][1] = src[1]; }
        const v4u* sb = (const v4u*)(OB + (size_t)t * 1024 + 16 * lane); const v4u ob0 = sb[0], ob1 = sb[1];
        const float mx = fmaxf(fmaxf(ls[0], ls[1]), ls[2]);
        float w0 = __builtin_amdgcn_exp2f(ls[0] - mx), w1 = __builtin_amdgcn_exp2f(ls[1] - mx), w2 = __builtin_amdgcn_exp2f(ls[2] - mx);
        const float inv = 1.0f / (w0 + w1 + w2); w0 *= inv; w1 *= inv; w2 *= inv;
        float a[16], b[16]; float sa = 0.f, sbq = 0.f;
#pragma unroll
        for (int q = 0; q < 2; ++q)
#pragma unroll
            for (int e = 0; e < 4; ++e) {
                const unsigned x0 = oa[0][q][e], x1 = oa[1][q][e], x2 = oa[2][q][e], y = (q == 0 ? ob0 : ob1)[e];
                const float lo = w0 * bflo(x0) + w1 * bflo(x1) + w2 * bflo(x2), hi = w0 * bfhi(x0) + w1 * bfhi(x1) + w2 * bfhi(x2);
                a[q * 8 + e * 2] = lo; a[q * 8 + e * 2 + 1] = hi; sa += lo * lo + hi * hi;
                const float bl = bflo(y), bh = bfhi(y); b[q * 8 + e * 2] = bl; b[q * 8 + e * 2 + 1] = bh; sbq += bl * bl + bh * bh; }
        const float ra = 1.0f / sqrtf(wave_sum(sa) * (1.0f / 1024.0f) + RMS_EPS), rb = 1.0f / sqrtf(wave_sum(sbq) * (1.0f / 1024.0f) + RMS_EPS);
#if P4_I8
        float am = 0.f;
#pragma unroll
        for (int q = 0; q < 2; ++q) {
            const f32x4 ga0 = *(const f32x4*)(F.a_out_g + 16 * lane + 8 * q), ga1 = *(const f32x4*)(F.a_out_g + 16 * lane + 8 * q + 4);
            const f32x4 gb0 = *(const f32x4*)(F.b_out_g + 16 * lane + 8 * q), gb1 = *(const f32x4*)(F.b_out_g + 16 * lane + 8 * q + 4);
#pragma unroll
            for (int e = 0; e < 4; ++e) { a[8 * q + e] *= ra * ga0[e]; a[8 * q + 4 + e] *= ra * ga1[e]; b[8 * q + e] *= rb * gb0[e]; b[8 * q + 4 + e] *= rb * gb1[e];
                am = fmaxf(am, fmaxf(fmaxf(fabsf(a[8 * q + e]), fabsf(a[8 * q + 4 + e])), fmaxf(fabsf(b[8 * q + e]), fabsf(b[8 * q + 4 + e])))); } }
#pragma unroll
        for (int o = 1; o < 64; o <<= 1) am = fmaxf(am, __shfl_xor(am, o));
        const float qinv = am > 0.f ? 127.0f / am : 0.f;
        v4u oa8, ob8;
#pragma unroll
        for (int q = 0; q < 4; ++q) { unsigned wa = 0, wb = 0;
#pragma unroll
            for (int e = 0; e < 4; ++e) { wa |= ((unsigned)(int)__builtin_rintf(a[4 * q + e] * qinv) & 0xffu) << (8 * e); wb |= ((unsigned)(int)__builtin_rintf(b[4 * q + e] * qinv) & 0xffu) << (8 * e); }
            oa8[q] = wa; ob8[q] = wb; }
        *(v4u*)(MIXQ + (size_t)t * DM + 16 * lane) = oa8; *(v4u*)(MIXQ + (size_t)t * DM + 1024 + 16 * lane) = ob8;
        if (lane == 0) SA[t] = am > 0.f ? am * (1.0f / 127.0f) : 1.0f;
#else
        v4u o[2], o2[2];
#pragma unroll
        for (int q = 0; q < 2; ++q) {
            const f32x4 ga0 = gaq[2 * q], ga1 = gaq[2 * q + 1];
            const f32x4 gb0 = gbq[2 * q], gb1 = gbq[2 * q + 1];
            o[q].x = pk2(a[8 * q + 0] * ra * ga0[0], a[8 * q + 1] * ra * ga0[1]); o[q].y = pk2(a[8 * q + 2] * ra * ga0[2], a[8 * q + 3] * ra * ga0[3]);
            o[q].z = pk2(a[8 * q + 4] * ra * ga1[0], a[8 * q + 5] * ra * ga1[1]); o[q].w = pk2(a[8 * q + 6] * ra * ga1[2], a[8 * q + 7] * ra * ga1[3]);
            o2[q].x = pk2(b[8 * q + 0] * rb * gb0[0], b[8 * q + 1] * rb * gb0[1]); o2[q].y = pk2(b[8 * q + 2] * rb * gb0[2], b[8 * q + 3] * rb * gb0[3]);
            o2[q].z = pk2(b[8 * q + 4] * rb * gb1[0], b[8 * q + 5] * rb * gb1[1]); o2[q].w = pk2(b[8 * q + 6] * rb * gb1[2], b[8 * q + 7] * rb * gb1[3]); }
        v4u* dst = (v4u*)(MIXED + (size_t)t * DM + 16 * lane); dst[0] = o[0]; dst[1] = o[1];
        v4u* dst2 = (v4u*)(MIXED + (size_t)t * DM + 1024 + 16 * lane); dst2[0] = o2[0]; dst2[1] = o2[1];
#endif
    }
}

__device__ __forceinline__ int f2key(float v) { const int b = __builtin_bit_cast(int, v); return b ^ ((b >> 31) & 0x7fffffff); }
__device__ __forceinline__ float key2f(int k) { return __builtin_bit_cast(float, k ^ ((k >> 31) & 0x7fffffff)); }
#define P6_CE(x, y) do { const int hi_ = max(x, y), lo_ = min(x, y); x = hi_; y = lo_; } while (0)
__device__ __forceinline__ void p6_sort16(int (&a)[16]) {
    P6_CE(a[0], a[1]); P6_CE(a[3], a[2]); P6_CE(a[4], a[5]); P6_CE(a[7], a[6]); P6_CE(a[8], a[9]); P6_CE(a[11], a[10]); P6_CE(a[12], a[13]); P6_CE(a[15], a[14]); P6_CE(a[0], a[2]); P6_CE(a[1], a[3]); P6_CE(a[6], a[4]); P6_CE(a[7], a[5]); P6_CE(a[8], a[10]); P6_CE(a[9], a[11]); P6_CE(a[14], a[12]); P6_CE(a[15], a[13]); P6_CE(a[0], a[1]); P6_CE(a[2], a[3]); P6_CE(a[5], a[4]); P6_CE(a[7], a[6]); P6_CE(a[8], a[9]); P6_CE(a[10], a[11]); P6_CE(a[13], a[12]); P6_CE(a[15], a[14]); P6_CE(a[0], a[4]); P6_CE(a[1], a[5]); P6_CE(a[2], a[6]); P6_CE(a[3], a[7]); P6_CE(a[12], a[8]); P6_CE(a[13], a[9]); P6_CE(a[14], a[10]); P6_CE(a[15], a[11]); P6_CE(a[0], a[2]); P6_CE(a[1], a[3]); P6_CE(a[4], a[6]); P6_CE(a[5], a[7]); P6_CE(a[10], a[8]); P6_CE(a[11], a[9]); P6_CE(a[14], a[12]); P6_CE(a[15], a[13]); P6_CE(a[0], a[1]); P6_CE(a[2], a[3]); P6_CE(a[4], a[5]); P6_CE(a[6], a[7]); P6_CE(a[9], a[8]); P6_CE(a[11], a[10]); P6_CE(a[13], a[12]); P6_CE(a[15], a[14]); P6_CE(a[0], a[8]); P6_CE(a[1], a[9]); P6_CE(a[2], a[10]); P6_CE(a[3], a[11]); P6_CE(a[4], a[12]); P6_CE(a[5], a[13]); P6_CE(a[6], a[14]); P6_CE(a[7], a[15]); P6_CE(a[0], a[4]); P6_CE(a[1], a[5]); P6_CE(a[2], a[6]); P6_CE(a[3], a[7]); P6_CE(a[8], a[12]); P6_CE(a[9], a[13]); P6_CE(a[10], a[14]); P6_CE(a[11], a[15]); P6_CE(a[0], a[2]); P6_CE(a[1], a[3]); P6_CE(a[4], a[6]); P6_CE(a[5], a[7]); P6_CE(a[8], a[10]); P6_CE(a[9], a[11]); P6_CE(a[12], a[14]); P6_CE(a[13], a[15]); P6_CE(a[0], a[1]); P6_CE(a[2], a[3]); P6_CE(a[4], a[5]); P6_CE(a[6], a[7]); P6_CE(a[8], a[9]); P6_CE(a[10], a[11]); P6_CE(a[12], a[13]); P6_CE(a[14], a[15]);
}
__device__ __forceinline__ void p6_merge16(int (&a)[16]) {
    P6_CE(a[0], a[8]); P6_CE(a[1], a[9]); P6_CE(a[2], a[10]); P6_CE(a[3], a[11]); P6_CE(a[4], a[12]); P6_CE(a[5], a[13]); P6_CE(a[6], a[14]); P6_CE(a[7], a[15]); P6_CE(a[0], a[4]); P6_CE(a[1], a[5]); P6_CE(a[2], a[6]); P6_CE(a[3], a[7]); P6_CE(a[8], a[12]); P6_CE(a[9], a[13]); P6_CE(a[10], a[14]); P6_CE(a[11], a[15]); P6_CE(a[0], a[2]); P6_CE(a[1], a[3]); P6_CE(a[4], a[6]); P6_CE(a[5], a[7]); P6_CE(a[8], a[10]); P6_CE(a[9], a[11]); P6_CE(a[12], a[14]); P6_CE(a[13], a[15]); P6_CE(a[0], a[1]); P6_CE(a[2], a[3]); P6_CE(a[4], a[5]); P6_CE(a[6], a[7]); P6_CE(a[8], a[9]); P6_CE(a[10], a[11]); P6_CE(a[12], a[13]); P6_CE(a[14], a[15]);
}
#undef P6_CE
__device__ __forceinline__ void p6_top16(int (&a)[16], const int (&b)[16]) {
#pragma unroll
    for (int i = 0; i < 16; ++i) a[i] = max(a[i], b[15 - i]);
    p6_merge16(a);
}
__device__ __forceinline__ void p6_top16_partner(int (&a)[16]) {
    int t[16];
#pragma unroll
    for (int i = 0; i < 16; ++i) t[i] = __shfl_xor(a[15 - i], 32);
#pragma unroll
    for (int i = 0; i < 16; ++i) a[i] = max(a[i], t[i]);
    p6_merge16(a);
}
template <bool FROM_LDS>
__device__ __forceinline__ void p6_task(unsigned char* ws, int lane, int h, int tok, const bf16* qrow_g, const LAS unsigned char* qrow_l, int rsw, LAS unsigned char* scr) {
    const int ql = lane & 31, hh = lane >> 5;
    const bf16* SK = (const bf16*)(ws + WS_SK);
    unsigned char* RE16b = ws + WS_RE16; float* RG = (float*)(ws + WS_RG);
    constexpr int INT_MINV = -2147483647 - 1;
    {
        int k1[2][16];
        bf16x8 kfa[1][8];
#define P6_LOADKF(BUF, STEP) do { const bf16* skb_ = SK + (size_t)(h * 2 + ((STEP) >> 2)) * 128 * 128 + (size_t)ql * 128 + 8 * hh + (size_t)((STEP) & 3) * 32 * 128; \
            _Pragma("unroll") for (int ks_ = 0; ks_ < 8; ++ks_) kfa[BUF][ks_] = *(const bf16x8*)(skb_ + 16 * ks_); } while (0)
        P6_LOADKF(0, 0);
#pragma unroll
        for (int p = 0; p < 2; ++p) {
            bf16x8 qf[8];
#pragma unroll
            for (int ks = 0; ks < 8; ++ks) qf[ks] = FROM_LDS ? *(const LAS bf16x8*)(qrow_l + (((16 * p + 2 * ks + hh) ^ rsw) << 4)) : *(const bf16x8*)(qrow_g + p * 128 + 8 * hh + 16 * ks);
            int g0[16], g1[16];
#pragma unroll
            for (int kt = 0; kt < 4; ++kt) { f32x16 s = (f32x16){};
                const int step = 4 * p + kt;
#pragma unroll
                for (int ks = 0; ks < 8; ++ks) s = __builtin_amdgcn_mfma_f32_32x32x16_bf16(kfa[0][ks], qf[ks], s, 0, 0, 0);
                __builtin_amdgcn_sched_barrier(0);
                if (step + 1 < 8) { P6_LOADKF(0, step + 1); }
                __builtin_amdgcn_sched_barrier(0);
                int g[16];
#pragma unroll
                for (int reg = 0; reg < 16; ++reg) { const int n = 32 * kt + (reg & 3) + 8 * (reg >> 2) + 4 * hh; g[reg] = (f2key(s[reg]) & ~127) | n; }
                p6_sort16(g);
                if (kt == 0) {
#pragma unroll
                    for (int i = 0; i < 16; ++i) g0[i] = g[i];
                } else if (kt == 1) p6_top16(g0, g);
                else if (kt == 2) {
#pragma unroll
                    for (int i = 0; i < 16; ++i) g1[i] = g[i];
                } else p6_top16(g1, g);
            }
            p6_top16(g0, g1);
            p6_top16_partner(g0);
#pragma unroll
            for (int i = 0; i < 16; ++i) k1[p][i] = g0[i];
        }
        float v1[16], v2[16];
#pragma unroll
        for (int i = 0; i < 16; ++i) { v1[i] = key2f(k1[0][i] & ~127); v2[i] = key2f(k1[1][i] & ~127); }
        { v4u w;
#pragma unroll
          for (int q = 0; q < 4; ++q) { unsigned x = 0;
#pragma unroll
              for (int c = 0; c < 4; ++c) x |= (unsigned)((hh ? k1[1][4 * q + c] : k1[0][4 * q + c]) & 127) << (8 * c);
              w[q] = x; }
          *(LAS v4u*)(scr + 16 * hh) = w; }
        int ca[16], cb[16];
#define P6_SLOT(k) ((k) < 16 ? ca[(k)] : cb[(k) - 16])
#define P6_CAND(k, Ia, Ja, Ib, Jb) do { const float sa_ = v1[Ia] + v2[Ja], sb_ = v1[Ib] + v2[Jb]; \
            const int key_ = (f2key(hh ? sb_ : sa_) & ~255) | (hh ? ((Ib) << 4 | (Jb)) : ((Ia) << 4 | (Ja))); if ((k) < 16) ca[(k) & 15] = key_; else cb[(k) & 15] = key_; } while (0)
        P6_CAND(0, 0, 0, 0, 1);
        P6_CAND(1, 0, 2, 0, 3);
        P6_CAND(2, 0, 4, 0, 5);
        P6_CAND(3, 0, 6, 0, 7);
        P6_CAND(4, 0, 8, 0, 9);
        P6_CAND(5, 0, 10, 0, 11);
        P6_CAND(6, 0, 12, 0, 13);
        P6_CAND(7, 0, 14, 0, 15);
        P6_CAND(8, 1, 0, 1, 1);
        P6_CAND(9, 1, 2, 1, 3);
        P6_CAND(10, 1, 4, 1, 5);
        P6_CAND(11, 1, 6, 1, 7);
        P6_CAND(12, 2, 0, 2, 1);
        P6_CAND(13, 2, 2, 2, 3);
        P6_CAND(14, 2, 4, 3, 0);
        P6_CAND(15, 3, 1, 3, 2);
        P6_CAND(16, 3, 3, 4, 0);
        P6_CAND(17, 4, 1, 4, 2);
        P6_CAND(18, 5, 0, 5, 1);
        P6_CAND(19, 6, 0, 6, 1);
        P6_CAND(20, 7, 0, 7, 1);
        P6_CAND(21, 8, 0, 9, 0);
        P6_CAND(22, 10, 0, 11, 0);
        P6_CAND(23, 12, 0, 13, 0);
        P6_CAND(24, 14, 0, 15, 0);
#undef P6_CAND
#undef P6_LOADKF
#undef P6_SLOT
#pragma unroll
        for (int i = 9; i < 16; ++i) cb[i] = INT_MINV;
        p6_sort16(ca); p6_sort16(cb); p6_top16(ca, cb); p6_top16_partner(ca);
        asm volatile("s_waitcnt lgkmcnt(0)" ::: "memory");
        float top[16], gs = 0.f;
        const float smax = key2f(ca[0] & ~255);
#pragma unroll
        for (int i = 0; i < 16; ++i) ca[i] = ((ca[i] & 255) << 24) | (int)((unsigned)ca[i] >> 8);
        p6_sort16(ca);
#pragma unroll
        for (int i = 0; i < 16; ++i) ca[i] = (ca[i] << 8) | ((ca[i] >> 24) & 255);
#pragma unroll
        for (int i = 0; i < 16; ++i) { top[i] = key2f(ca[i] & ~255); }
#pragma unroll
        for (int i = 0; i < 16; ++i) { top[i] = __expf(top[i] - smax); gs += top[i]; }
        const float ginv = 1.0f / gs;
        unsigned short* re = (unsigned short*)(RE16b + (size_t)tok * 256) + 2 * h + hh;
        float gq[8];
#pragma unroll
        for (int r = 0; r < 8; ++r) { const int key = hh ? ca[r + 8] : ca[r]; const int ci = (key >> 4) & 15, cj = key & 15;
            const int e = (int)scr[ci] * 128 + (int)scr[16 + cj];
            re[r * 16] = (unsigned short)e; gq[r] = (hh ? top[r + 8] : top[r]) * ginv; }
        float* rg = RG + ((size_t)tok * 8 + h) * 16 + 8 * hh;
        *(f32x4*)rg = (f32x4){gq[0], gq[1], gq[2], gq[3]}; *(f32x4*)(rg + 4) = (f32x4){gq[4], gq[5], gq[6], gq[7]};
        asm volatile("s_waitcnt lgkmcnt(0)" ::: "memory");
    }
}
__device__ __forceinline__ void p6_route(Frame& F) {
    const int gw = F.vcu * NWAVES + F.wave, NGW = F.G * NWAVES, lane = fresh_lane(), ql = lane & 31;
    const bf16* Q = (const bf16*)(F.ws + WS_MIXED);
    LAS unsigned char* scr = F.lds + F.wave * 1024 + ql * 32;
#pragma unroll 1
    for (int task = gw; task < 768 * 8; task += NGW) {
        const int h = task / 768, tile = task % 768, tok = tile * 32 + ql;
        p6_task<false>(F.ws, lane, h, tok, Q + (size_t)tok * DM + h * 256, nullptr, 0, scr);
    }
}
template <bool I8_>
struct EpiRouteT {
    static constexpr bool PERM = true, AFTER_DRAIN = true, I8 = I8_;
    const float* ss; unsigned char* ws; const float* sx; const float* sw;
    __device__ __forceinline__ void fused(typename pg8::AccT<I8_>::type (&acc)[2][2][4][2], const pg8::Unit& u, int wr, int wc, int fr, int fq, LAS unsigned char* lds, int wid, int lane) const {
        LAS float* rsl = (LAS float*)(lds + 131072 + 10240);
        if (lane < 32) { const int r = 32 * wid + lane;
            const f32x4* p = (const f32x4*)(ss + (size_t)(u.pm * 256 + r) * 32); f32x4 v[8];
#pragma unroll
            for (int i = 0; i < 8; ++i) v[i] = p[i];
            float s = 0.f;
#pragma unroll
            for (int i = 0; i < 8; ++i) s += (v[i][0] + v[i][1]) + (v[i][2] + v[i][3]);
            float sc = 1.0f / sqrtf(s * (1.0f / 2048.0f) + 1e-6f);
            if (I8_) sc *= sx[u.pm * 256 + r];
            rsl[r] = sc; }
        asm volatile("s_waitcnt lgkmcnt(0)" ::: "memory"); __builtin_amdgcn_s_barrier(); asm volatile("" ::: "memory");
#pragma unroll
        for (int ai = 0; ai < 2; ++ai)
#pragma unroll
            for (int m = 0; m < 4; ++m) {
                const int r = 128 * ai + 64 * wr + 16 * m + fr;
                const float sc = rsl[r];
#pragma unroll
                for (int bj = 0; bj < 2; ++bj) { f32x4 v0, v1;
                    if constexpr (I8_) { const int cb = u.pn * 256 + 128 * bj + 32 * wc + 8 * fq; const f32x4 w0 = *(const f32x4*)(sw + cb), w1 = *(const f32x4*)(sw + cb + 4);
                        const pg8::i32x4 a0 = acc[ai][bj][m][0], a1 = acc[ai][bj][m][1];
                        v0 = (f32x4){(float)a0[0], (float)a0[1], (float)a0[2], (float)a0[3]} * w0 * sc; v1 = (f32x4){(float)a1[0], (float)a1[1], (float)a1[2], (float)a1[3]} * w1 * sc; }
                    else { v0 = acc[ai][bj][m][0] * sc; v1 = acc[ai][bj][m][1] * sc; }
                    v4u w; w.x = pk2(v0[0], v0[1]); w.y = pk2(v0[2], v0[3]); w.z = pk2(v1[0], v1[1]); w.w = pk2(v1[2], v1[3]);
                    const int c = 16 * bj + 4 * wc + fq;
                    *(LAS v4u*)(lds + r * 512 + ((c ^ (r & 15)) << 4)) = w; } }
        asm volatile("s_waitcnt lgkmcnt(0)" ::: "memory"); __builtin_amdgcn_s_barrier(); asm volatile("" ::: "memory");
        const int ql = lane & 31, rowl = 32 * wid + ql;
        p6_task<true>(ws, lane, u.pn, u.pm * 256 + rowl, nullptr, lds + rowl * 512, rowl & 15, lds + 131072 + 1024 + wid * 1024 + ql * 32);
        asm volatile("s_waitcnt lgkmcnt(0)" ::: "memory"); __builtin_amdgcn_s_barrier(); asm volatile("" ::: "memory");
    }
};


template <int CTRL> __device__ __forceinline__ int dpp_i(int x) { return __builtin_amdgcn_update_dpp(0, x, CTRL, 0xf, 0xf, true); }
__device__ __forceinline__ int red8_add(int v) { v += dpp_i<0xB1>(v); v += dpp_i<0x4E>(v); v += dpp_i<0x141>(v); return v; }
__device__ __forceinline__ float red8_max(float v) {
    v = fmaxf(v, __builtin_bit_cast(float, dpp_i<0xB1>(__builtin_bit_cast(int, v)))); v = fmaxf(v, __builtin_bit_cast(float, dpp_i<0x4E>(__builtin_bit_cast(int, v))));
    v = fmaxf(v, __builtin_bit_cast(float, dpp_i<0x141>(__builtin_bit_cast(int, v)))); return v; }
struct SliceOwn { unsigned n_mine, vx, npop; };
__device__ __forceinline__ SliceOwn slice_census(unsigned* bar, unsigned x) {
    SliceOwn s; s.n_mine = 1u; s.vx = 0u; s.npop = 0u;
#pragma unroll
    for (unsigned j = 0; j < 16; ++j) { const unsigned c = (unsigned)__builtin_amdgcn_readfirstlane((int)xb_ld(&bar[XB_XCNT(j)])); if (c > 0u) { if (j < x) ++s.vx; ++s.npop; } if (j == x) s.n_mine = c > 0u ? c : 1u; }
    if (s.npop == 0u) s.npop = 1u;
    return s;
}
#define P7_EID(R0, R1, i) ((((i) & 1) ? (((i) < 8 ? R0 : R1)[((i) >> 1) & 3] >> 16) : (((i) < 8 ? R0 : R1)[((i) >> 1) & 3] & 0xffffu)))

__device__ __forceinline__ void p7a_udots(Frame& F, unsigned* bar, unsigned x, unsigned rank) {
    const int lane = fresh_lane(), r = lane >> 3, seg = lane & 7;
    const SliceOwn so = slice_census(bar, x);
    const int gwl = (int)rank * NWAVES + F.wave, stride = (int)so.n_mine * NWAVES;
    const bf16* X2B = (const bf16*)(F.ws + WS_X2B); const unsigned char* RE16b = F.ws + WS_RE16;
#pragma unroll 1
    for (int pass = 0; pass < 16; ++pass) {
        const int hs = (2 * (int)so.vx + pass) & 15; if ((unsigned)(hs >> 1) % so.npop != so.vx) continue;
        float* PD = (float*)(F.ws + (hs < 8 ? WS_PD0 : WS_PD1)) + (size_t)(hs & 7) * NT_TOK * 128;
        const unsigned char* Ub = F.ws + WS_U + (size_t)hs * (16384 * 128) + 16 * seg;
        const unsigned char* rp0 = RE16b + r * 32; const bf16* xp0 = X2B + 128 * hs + 16 * seg;
#define P7A_LOADA(R0, R1, X0, X1, t) do { const int tt_ = (t) < NT_TOK ? (t) : NT_TOK - 1; const unsigned char* rp_ = rp0 + (size_t)tt_ * 256; R0 = *(const v4u*)rp_; R1 = *(const v4u*)(rp_ + 16); \
            const bf16* xp_ = xp0 + (size_t)tt_ * DM; X0 = *(const v4u*)xp_; X1 = *(const v4u*)(xp_ + 8); } while (0)
#define P7A_ISSUE(G, R0, R1) do { __builtin_amdgcn_s_setprio(3); _Pragma("unroll") for (int i_ = 0; i_ < 16; ++i_) { const unsigned e_ = P7_EID(R0, R1, i_); G[i_] = *(const v4u*)(Ub + (size_t)e_ * 128); } __builtin_amdgcn_s_setprio(0); } while (0)
#define P7A_COMP(G, X0, X1, t) do { float xf_[16]; float am_ = 0.f; \
            _Pragma("unroll") for (int c_ = 0; c_ < 4; ++c_) { xf_[2 * c_] = bflo(X0[c_]); xf_[2 * c_ + 1] = bfhi(X0[c_]); xf_[8 + 2 * c_] = bflo(X1[c_]); xf_[8 + 2 * c_ + 1] = bfhi(X1[c_]); } \
            _Pragma("unroll") for (int c_ = 0; c_ < 16; ++c_) am_ = fmaxf(am_, fabsf(xf_[c_])); \
            am_ = red8_max(am_); const float inv_ = am_ > 0.f ? 127.0f / am_ : 0.f, hsc_ = am_ * (1.0f / 127.0f); \
            int hq_[4]; _Pragma("unroll") for (int w_ = 0; w_ < 4; ++w_) { unsigned p_ = 0; _Pragma("unroll") for (int c_ = 0; c_ < 4; ++c_) p_ |= ((unsigned)(int)__builtin_rintf(xf_[4 * w_ + c_] * inv_) & 0xffu) << (8 * c_); hq_[w_] = (int)p_; } \
            int res0_ = 0, res1_ = 0; \
            _Pragma("unroll") for (int i_ = 0; i_ < 16; ++i_) { int d_ = 0; _Pragma("unroll") for (int w_ = 0; w_ < 4; ++w_) d_ = __builtin_amdgcn_sdot4((int)G[i_][w_], hq_[w_], d_, false); \
                d_ = red8_add(d_); if ((i_ & 7) == seg) { if (i_ < 8) res0_ = d_; else res1_ = d_; } } \
            if ((t) < NT_TOK) { float* pd_ = PD + (size_t)(t) * 128 + 8 * seg + r; pd_[0] = (float)res0_ * hsc_; pd_[64] = (float)res1_ * hsc_; } } while (0)
        v4u GA[16], GB[16], ra0, ra1, xa0, xa1, rb0, rb1, xb0, xb1, xA0, xA1, xB0, xB1;
        P7A_LOADA(ra0, ra1, xa0, xa1, gwl);
        P7A_LOADA(rb0, rb1, xb0, xb1, gwl + stride);
        P7A_ISSUE(GA, ra0, ra1); xA0 = xa0; xA1 = xa1;
#pragma unroll 1
        for (int t = gwl; t < NT_TOK; t += 2 * stride) {
            P7A_LOADA(ra0, ra1, xa0, xa1, t + 2 * stride); P7A_ISSUE(GB, rb0, rb1); xB0 = xb0; xB1 = xb1; P7A_COMP(GA, xA0, xA1, t);
            P7A_LOADA(rb0, rb1, xb0, xb1, t + 3 * stride); P7A_ISSUE(GA, ra0, ra1); xA0 = xa0; xA1 = xa1; P7A_COMP(GB, xB0, xB1, t + stride);
        }
#undef P7A_LOADA
#undef P7A_ISSUE
#undef P7A_COMP
    }
}
__device__ __forceinline__ void p7b_coef(Frame& F) {
    const int gw = F.vcu * NWAVES + F.wave, NGW = F.G * NWAVES, lane = fresh_lane();
    const float* PD0 = (const float*)(F.ws + WS_PD0); const float* PD1 = (const float*)(F.ws + WS_PD1);
    const unsigned char* RE16b = F.ws + WS_RE16; const float* RG = (const float*)(F.ws + WS_RG); const float* SS = (const float*)(F.ws + WS_SS);
    const float* US = (const float*)(F.ws + WS_US); const float* VS = (const float*)(F.ws + WS_VS);
    unsigned* CQ = (unsigned*)(F.ws + WS_CQ); float* SCQ = (float*)(F.ws + WS_SCQ);
#pragma unroll 1
    for (int t = gw; t < NT_TOK; t += NGW) {
        float da = 0.f, db = 0.f;
#pragma unroll
        for (int hs = 0; hs < 8; ++hs) { const size_t o = ((size_t)hs * NT_TOK + t) * 128 + lane; da += PD0[o] + PD1[o]; db += PD0[o + 64] + PD1[o + 64]; }
        float rstd; { const float sp = (lane < 32) ? SS[(size_t)t * 32 + lane] : 0.f; rstd = 1.0f / sqrtf(wave_sum(sp) * (1.0f / DM) + RMS_EPS); }
        const unsigned short* rp = (const unsigned short*)(RE16b + (size_t)t * 256 + (lane & 7) * 32) + (lane >> 3);
        const int ea = rp[0], eb = rp[8];
        const float ga = RG[(size_t)t * 128 + lane], gb = RG[(size_t)t * 128 + 64 + lane];
        const float za = da * US[ea] * rstd, zb = db * US[eb] * rstd;
        const float ca = ga * 0.5f * za * (1.0f + erff(za * 0.70710678118654752f)) * VS[ea], cb = gb * 0.5f * zb * (1.0f + erff(zb * 0.70710678118654752f)) * VS[eb];
        float am = fmaxf(fabsf(ca), fabsf(cb));
#pragma unroll
        for (int o = 1; o < 64; o <<= 1) am = fmaxf(am, __shfl_xor(am, o));
        const float inv = am > 0.f ? 127.0f / am : 0.f;
        const int qa = (int)__builtin_rintf(ca * inv) & 0xff, qb = (int)__builtin_rintf(cb * inv) & 0xff;
        const int wa = qa | (__shfl_down(qa, 8) << 8) | (__shfl_down(qa, 16) << 16) | (__shfl_down(qa, 24) << 24);
        const int wb = qb | (__shfl_down(qb, 8) << 8) | (__shfl_down(qb, 16) << 16) | (__shfl_down(qb, 24) << 24);
        if (((lane >> 3) & 3) == 0) { unsigned* cq = CQ + (size_t)t * 32 + (lane & 7) * 4 + (lane >> 5); cq[0] = (unsigned)wa; cq[2] = (unsigned)wb; }
        if (lane == 0) SCQ[t] = am * (1.0f / 127.0f);
    }
}

#if P7A_INV
__device__ __forceinline__ void lds_inc(LAS unsigned* p) { (void)__hip_atomic_fetch_add(p, 1u, __ATOMIC_RELAXED, __HIP_MEMORY_SCOPE_WORKGROUP); }
__device__ __forceinline__ unsigned lds_inc_rtn(LAS unsigned* p) { return __hip_atomic_fetch_add(p, 1u, __ATOMIC_RELAXED, __HIP_MEMORY_SCOPE_WORKGROUP); }
__device__ __forceinline__ void p6a_hist(Frame& F) {
    const int lane = fresh_lane(), tid = F.wave * 64 + lane;
    LAS unsigned* cnt = (LAS unsigned*)F.lds;
    unsigned* H = (unsigned*)(F.ws + WS_H); const float* SS = (const float*)(F.ws + WS_SS); float* RSTD2 = (float*)(F.ws + WS_RSTD2);
#pragma unroll 1
    for (int j = F.vcu; j < IG_NSUB; j += F.G) {
        cnt[tid] = 0u; cnt[tid + 512] = 0u;
        __syncthreads();
        const v4u* re = (const v4u*)(F.ws + WS_RE16 + (size_t)j * IG_SUBT * 256);
        v4u rv[3];
#pragma unroll
        for (int k = 0; k < 3; ++k) rv[k] = re[tid + 512 * k];
#pragma unroll
        for (int k = 0; k < 3; ++k) { const v4u v = rv[k];
#pragma unroll
            for (int c = 0; c < 4; ++c) { lds_inc(&cnt[(v[c] & 0xffffu) >> 4]); lds_inc(&cnt[v[c] >> 20]); } }
        if (tid < IG_SUBT) { const int t = j * IG_SUBT + tid; const f32x4* p = (const f32x4*)(SS + (size_t)t * 32); float s = 0.f;
#pragma unroll
            for (int i = 0; i < 8; ++i) { const f32x4 v = p[i]; s += (v[0] + v[1]) + (v[2] + v[3]); }
            float rs_ = 1.0f / sqrtf(s * (1.0f / DM) + RMS_EPS);
#if P7A_X2Q
            rs_ *= ((const float*)(F.ws + WS_SX2))[t];
#endif
            RSTD2[t] = rs_; }
        __syncthreads();
        H[j * 1024 + tid] = cnt[tid]; H[j * 1024 + tid + 512] = cnt[tid + 512];
        __syncthreads();
    }
}
__device__ __forceinline__ void p6b_scatter(Frame& F) {
    const int lane = fresh_lane(), tid = F.wave * 64 + lane;
    LAS unsigned* cnt = (LAS unsigned*)F.lds; LAS unsigned* wsum = cnt + 1024;
    const unsigned* H = (const unsigned*)(F.ws + WS_H); unsigned* L = (unsigned*)(F.ws + WS_L); unsigned* TL = (unsigned*)(F.ws + WS_TL);
#pragma unroll 1
    for (int j = F.vcu; j < IG_NSUB; j += F.G) {
        const int g = j / IG_SPG, c = j % IG_SPG;
        unsigned t0 = 0, t1 = 0, p0 = 0, p1 = 0;
#pragma unroll
        for (int cc = 0; cc < IG_SPG; ++cc) { const v2u h = *(const v2u*)(H + (size_t)(IG_SPG * g + cc) * 1024 + 2 * tid); t0 += h.x; t1 += h.y; if (cc < c) { p0 += h.x; p1 += h.y; } }
        const unsigned k0 = t0 | (((t0 + 15u) >> 4) << 18), k1 = t1 | (((t1 + 15u) >> 4) << 18), s = k0 + k1;
        unsigned inc = s;
#pragma unroll
        for (int o = 1; o < 64; o <<= 1) { const unsigned v = (unsigned)__shfl_up((int)inc, o); if (lane >= o) inc += v; }
        if (lane == 63) wsum[F.wave] = inc;
        __syncthreads();
        unsigned wo = 0;
#pragma unroll
        for (int w = 0; w < 8; ++w) { const unsigned v = wsum[w]; if (w < F.wave) wo += v; }
        const unsigned e0 = wo + inc - s, e1 = e0 + k0;
        cnt[2 * tid] = (e0 & 0x3ffffu) + p0; cnt[2 * tid + 1] = (e1 & 0x3ffffu) + p1;
        if (c == 0) { unsigned* of = TL + (size_t)g * 1040; of[2 * tid] = e0 & 0x3ffffu; of[2 * tid + 1] = e1 & 0x3ffffu; if (tid == 511) of[1024] = (e1 & 0x3ffffu) + t1; }
        __syncthreads();
        const v4u* re = (const v4u*)(F.ws + WS_RE16 + (size_t)j * IG_SUBT * 256);
        unsigned* Lg = L + (size_t)g * IG_PICKS;
        v4u rv[3];
#pragma unroll
        for (int k = 0; k < 3; ++k) rv[k] = re[tid + 512 * k];
#pragma unroll
        for (int k = 0; k < 3; ++k) { const v4u v = rv[k]; const unsigned ix0 = (unsigned)(tid + 512 * k) * 8u;
            const unsigned tl7 = ((unsigned)c * IG_SUBT + (ix0 >> 7)) << 7, ri0 = ix0 & 127u;
#pragma unroll
            for (int cc = 0; cc < 8; ++cc) { const unsigned e = (cc & 1) ? (v[cc >> 1] >> 16) : (v[cc >> 1] & 0xffffu); const unsigned ri = ri0 + cc, pair = 8u * (ri & 15u) + (ri >> 4);
                const unsigned pos = lds_inc_rtn(&cnt[e >> 4]); Lg[pos] = (e << 17) | tl7 | pair; } }
        __syncthreads();
    }
}
typedef int v4i __attribute__((ext_vector_type(4)));
__device__ __forceinline__ float red16_max(float v) { v = red8_max(v); return fmaxf(v, __builtin_bit_cast(float, dpp_i<0x140>(__builtin_bit_cast(int, v)))); }
template <int MODE  >
__device__ __forceinline__ void p7a_inv(Frame& F, unsigned* bar, unsigned x, unsigned rank) {
    const int lane = fresh_lane();
    const SliceOwn so = slice_census(bar, x);
    const bf16* X2B = (const bf16*)(F.ws + WS_X2B);
    const unsigned* L = (const unsigned*)(F.ws + WS_L); const unsigned* OFF = (const unsigned*)(F.ws + WS_TL);
    LAS unsigned* OFl = (LAS unsigned*)(F.lds + 2048);
    LAS unsigned char* XS = F.lds + 8192;
#pragma unroll 1
    for (int sp = 0; sp < 8; ++sp) {
        if ((unsigned)sp % so.npop != so.vx) continue;
#pragma unroll 1
        for (int g = (int)rank; g < IG_NGRP; g += (int)so.n_mine) {
            {
                const int r4 = lane >> 4, seg = lane & 15;
                const bf16* xp0 = X2B + (size_t)(g * IG_TOK + r4) * DM + 256 * sp + 16 * seg;
#if P7A_X2Q
                {
                    const unsigned char* qp0 = (const unsigned char*)F.out + OUT_X2Q + (size_t)(g * IG_TOK + r4) * DM + 256 * sp + 16 * seg;
                    v4u XQv[12];
#pragma unroll
                    for (int k = 0; k < 12; ++k) XQv[k] = *(const v4u*)(qp0 + (size_t)(F.wave + k * NWAVES) * 4 * DM);
#pragma unroll
                    for (int k = 0; k < 12; ++k) { const int tl = (F.wave + k * NWAVES) * 4 + r4; *(LAS v4u*)(XS + tl * IG_PITCH + seg * 16) = XQv[k]; }
                }
#else
#pragma unroll 1
                for (int it0 = F.wave; it0 < IG_TOK / 4; it0 += 4 * NWAVES) {
                    v4u XA[4], XB[4];
#pragma unroll
                    for (int k = 0; k < 4; ++k) { const int it = it0 + k * NWAVES < IG_TOK / 4 ? it0 + k * NWAVES : it0; const bf16* xp = xp0 + (size_t)it * 4 * DM; XA[k] = *(const v4u*)xp; XB[k] = *(const v4u*)(xp + 8); }
#pragma unroll
                    for (int k = 0; k < 4; ++k) { const int it = it0 + k * NWAVES; if (it < IG_TOK / 4) { const v4u X0 = XA[k], X1 = XB[k];
                    float xf[16]; float am = 0.f;
#pragma unroll
                    for (int c = 0; c < 4; ++c) { xf[2 * c] = bflo(X0[c]); xf[2 * c + 1] = bfhi(X0[c]); xf[8 + 2 * c] = bflo(X1[c]); xf[8 + 2 * c + 1] = bfhi(X1[c]); }
#pragma unroll
                    for (int c = 0; c < 16; ++c) am = fmaxf(am, fabsf(xf[c]));
                    am = red16_max(am); const float inv = am > 0.f ? 127.0f / am : 0.f;
                    v4u hq;
#pragma unroll
                    for (int w = 0; w < 4; ++w) { unsigned p = 0;
#pragma unroll
                        for (int c = 0; c < 4; ++c) p |= ((unsigned)(int)__builtin_rintf(xf[4 * w + c] * inv) & 0xffu) << (8 * c);
                        hq[w] = p; }
                    const int tl = it * 4 + r4;
                    *(LAS v4u*)(XS + tl * IG_PITCH + seg * 16) = hq;
                    if (seg == 0) *(LAS float*)(XS + tl * IG_PITCH + 256) = am * (1.0f / 127.0f); } }
                }
#endif
                const int tid = F.wave * 64 + lane;
                OFl[tid] = OFF[(size_t)g * 1040 + tid]; OFl[tid + 512] = OFF[(size_t)g * 1040 + tid + 512]; if (tid < 8) OFl[1024 + tid] = OFF[(size_t)g * 1040 + 1024];
            }
            __syncthreads();
            {
                const int lane2 = fresh_lane(), i16 = lane2 & 15; const unsigned q = (unsigned)lane2 >> 4, qsh = q << 4;
                const unsigned* Lgu = L + (size_t)g * IG_PICKS;
                float* PDu = (float*)(F.ws + ((MODE & 4) ? WS_PD1 : WS_PD0)) + (size_t)sp * NT_TOK * 128 + (size_t)g * IG_PICKS;
                const unsigned char* Ub = F.ws + WS_U + (size_t)sp * (1024 * 4096) + lane2 * 16;
                const unsigned stg_ = 112640u + (unsigned)F.wave * 768u + (unsigned)lane2 * 4u, own_ = 112640u + (unsigned)F.wave * 768u + (unsigned)i16 * 4u, dmy_ = stg_ + 256u;
                float* DMG = (float*)(F.ws + WS_NTL);
#define IG_OFF(b) ((unsigned)__builtin_amdgcn_readfirstlane((int)OFl[b]))
#define IG_LD(j, R) do { const unsigned rec_ = R[j]; const unsigned t_ = ((MODE & 16) ? (unsigned)i16 : __builtin_amdgcn_ubfe(rec_, 7, 10)) * (unsigned)IG_PITCH + qsh; \
                    B0[j] = *(const LAS v4i*)(XS + t_); B1[j] = *(const LAS v4i*)(XS + t_ + 64); B2[j] = *(const LAS v4i*)(XS + t_ + 128); B3[j] = *(const LAS v4i*)(XS + t_ + 192); \
                    if (!P7A_X2Q) hv[j] = *(const LAS float*)(XS + (t_ - qsh) + 256); } while (0)
#define IG_MM(j, A) do { if (MODE & 8) { B0[j] = B0[j] | B1[j] | B2[j] | B3[j]; break; } const v4i z_ = {0, 0, 0, 0}; B0[j] = __builtin_amdgcn_mfma_i32_16x16x64_i8(A[0], B0[j], z_, 0, 0, 0); B0[j] = __builtin_amdgcn_mfma_i32_16x16x64_i8(A[1], B1[j], B0[j], 0, 0, 0); \
                    B0[j] = __builtin_amdgcn_mfma_i32_16x16x64_i8(A[2], B2[j], B0[j], 0, 0, 0); B0[j] = __builtin_amdgcn_mfma_i32_16x16x64_i8(A[3], B3[j], B0[j], 0, 0, 0); } while (0)
#define IG_ST(j, R) do { const unsigned rec_ = R[j]; const int lo_ = (rec_ & 0x20000u) ? B0[j][1] : B0[j][0], hi_ = (rec_ & 0x20000u) ? B0[j][3] : B0[j][2], val_ = (rec_ & 0x40000u) ? hi_ : lo_; \
                    const float o_ = P7A_X2Q ? (float)val_ : (float)val_ * hv[j]; \
                    *(LAS float*)(F.lds + (__builtin_amdgcn_ubfe(rec_, 19, 2) == q ? own_ : dmy_) + 64 * (j)) = o_; } while (0)
#define IG_STG(R, P0, NREM) do { const unsigned rec_ = R[0]; const int lo_ = (rec_ & 0x20000u) ? B0[0][1] : B0[0][0], hi_ = (rec_ & 0x20000u) ? B0[0][3] : B0[0][2], val_ = (rec_ & 0x40000u) ? hi_ : lo_; \
                    const float o_ = P7A_X2Q ? (float)val_ : (float)val_ * hv[0]; \
                    if (__builtin_amdgcn_ubfe(rec_, 19, 2) == q && (unsigned)i16 < (NREM)) (PDu + (P0))[i16] = o_; } while (0)
#define IG_BIDX(BI) (F.wave + NWAVES * (BI))
#define IG_BLOCK(AC, RC, AN, RN, BI) do { \
                    const unsigned s4_ = (unsigned)__builtin_amdgcn_readfirstlane((int)vS), e4_ = (unsigned)__builtin_amdgcn_readfirstlane((int)vE);     \
                    { const int b5_ = IG_BIDX((BI) + 4) < 1023 ? IG_BIDX((BI) + 4) : 1023; vS = OFl[b5_]; vE = OFl[b5_ + 1]; } \
                    const int bp_ = IG_BIDX((BI) + 3), bpc_ = (MODE & 1) ? 0 : (bp_ < 1023 ? bp_ : 1023); \
                    v4i B0[4], B1[4], B2[4], B3[4]; float hv[4]; \
                    const unsigned nrem_ = e0 - s0; const bool h3_ = nrem_ > 48u; \
                    IG_LD(0, RC); IG_LD(1, RC); IG_LD(2, RC); \
                    if (h3_) IG_LD(3, RC); \
                    __builtin_amdgcn_sched_barrier(0); \
                    AN[0] = *(const v4i*)(Ub + (size_t)bpc_ * 4096); AN[1] = *(const v4i*)(Ub + (size_t)bpc_ * 4096 + 1024); \
                    __builtin_amdgcn_sched_barrier(0); \
                    IG_MM(0, AC); IG_MM(1, AC); \
                    __builtin_amdgcn_sched_barrier(0); \
                    AN[2] = *(const v4i*)(Ub + (size_t)bpc_ * 4096 + 2048); AN[3] = *(const v4i*)(Ub + (size_t)bpc_ * 4096 + 3072); \
                    __builtin_amdgcn_sched_barrier(0); \
                    IG_MM(2, AC); \
                    IG_ST(0, RC); IG_ST(1, RC); \
                    __builtin_amdgcn_sched_barrier(0); \
                    RN[0] = (Lgu + (((MODE & 2) ? 0u : s4_)))[i16]; RN[1] = (Lgu + (((MODE & 2) ? 0u : s4_) + 16))[i16]; \
                    __builtin_amdgcn_sched_barrier(0); \
                    IG_ST(2, RC); \
                    if (h3_) { IG_MM(3, AC); IG_ST(3, RC); } \
                    __builtin_amdgcn_sched_barrier(0); \
                    RN[2] = (Lgu + (((MODE & 2) ? 0u : s4_) + 32))[i16]; RN[3] = (Lgu + (((MODE & 2) ? 0u : s4_) + 48))[i16]; \
                    __builtin_amdgcn_sched_barrier(0); \
                    { const float v_ = *(const LAS float*)(F.lds + stg_); float* dst_ = (unsigned)lane2 < nrem_ ? PDu + s0 + lane2 : DMG + lane2; *dst_ = v_; }     \
                    _Pragma("unroll 1") for (unsigned tb_ = s0 + 64u; tb_ < e0; tb_ += 16u) {     \
                        unsigned rr_[1]; rr_[0] = (Lgu + tb_)[i16]; IG_LD(0, rr_); IG_MM(0, AC); IG_STG(rr_, tb_, e0 - tb_); } \
                    s0 = s1; e0 = e1; s1 = s2; e1 = e2; s2 = s4_; e2 = e4_; } while (0)
#define IG_LOADSET(A, R, B, S) do { A[0] = *(const v4i*)(Ub + (size_t)(B) * 4096); A[1] = *(const v4i*)(Ub + (size_t)(B) * 4096 + 1024); A[2] = *(const v4i*)(Ub + (size_t)(B) * 4096 + 2048); A[3] = *(const v4i*)(Ub + (size_t)(B) * 4096 + 3072); \
                    _Pragma("unroll") for (int j_ = 0; j_ < 4; ++j_) R[j_] = (Lgu + ((S) + 16 * j_))[i16]; } while (0)
                unsigned s0 = IG_OFF(IG_BIDX(0)), e0 = IG_OFF(IG_BIDX(0) + 1), s1 = IG_OFF(IG_BIDX(1)), e1 = IG_OFF(IG_BIDX(1) + 1), s2 = IG_OFF(IG_BIDX(2)), e2 = IG_OFF(IG_BIDX(2) + 1);
                unsigned vS = OFl[IG_BIDX(3)], vE = OFl[IG_BIDX(3) + 1];
                v4i A0s[4], A1s[4], A2s[4], A3s[4]; unsigned R0s[4], R1s[4], R2s[4], R3s[4];
                IG_LOADSET(A0s, R0s, IG_BIDX(0), s0); IG_LOADSET(A1s, R1s, IG_BIDX(1), s1); IG_LOADSET(A2s, R2s, IG_BIDX(2), s2);
#pragma unroll 1
                for (int bi = 0; bi < 128; bi += 4) { IG_BLOCK(A0s, R0s, A3s, R3s, bi); IG_BLOCK(A1s, R1s, A0s, R0s, bi + 1); IG_BLOCK(A2s, R2s, A1s, R1s, bi + 2); IG_BLOCK(A3s, R3s, A2s, R2s, bi + 3); }
#undef IG_BIDX
#undef IG_LOADSET
#undef IG_BLOCK
#undef IG_ST
#undef IG_STG
#undef IG_MM
#undef IG_LD
#undef IG_OFF
            }
            __syncthreads();
        }
    }
}
__device__ __forceinline__ void p7b_sorted(Frame& F) {
    const int lane = fresh_lane(), tid = F.wave * 64 + lane;
    const float* PD = (const float*)(F.ws + WS_PD0);
    const unsigned* L = (const unsigned*)(F.ws + WS_L); float* RG = (float*)(F.ws + WS_RG); const float* RSTD2 = (const float*)(F.ws + WS_RSTD2);
    const float* US = (const float*)(F.ws + WS_US); const float* VS = (const float*)(F.ws + WS_VS);
    constexpr int NQ = IG_NGRP * IG_PICKS / 4, QPG = IG_PICKS / 4, QB = 3;
    const int q_lo = (int)((long long)F.vcu * NQ / F.G), q_hi = (int)((long long)(F.vcu + 1) * NQ / F.G);
#pragma unroll 1
    for (int q0 = q_lo + tid; q0 < q_hi; q0 += QB * NTHREADS) {
        v4u rec[QB]; f32x4 d[QB];
#pragma unroll
        for (int k = 0; k < QB; ++k) { const int qq = q0 + k * NTHREADS; const size_t pos = (size_t)(qq < q_hi ? qq : q_lo) * 4; rec[k] = *(const v4u*)(L + pos); f32x4 s = {0.f, 0.f, 0.f, 0.f};
#pragma unroll
            for (int sp = 0; sp < 8; ++sp) s += *(const f32x4*)(PD + (size_t)sp * NT_TOK * 128 + pos);
            d[k] = s; }
        float us[QB][4], vs[QB][4], rs[QB][4], gg[QB][4];
#pragma unroll
        for (int k = 0; k < QB; ++k) { const int qq = q0 + k * NTHREADS < q_hi ? q0 + k * NTHREADS : q_lo; const int g = qq / QPG;
#pragma unroll
            for (int c = 0; c < 4; ++c) { const unsigned r = rec[k][c]; const unsigned e = r >> 17; const int t = g * IG_TOK + (int)((r >> 7) & 1023u), pair = (int)(r & 127u);
                us[k][c] = US[e]; vs[k][c] = VS[e]; rs[k][c] = RSTD2[t]; gg[k][c] = RG[(size_t)t * 128 + pair]; } }
        asm volatile("s_waitcnt vmcnt(0)" ::: "memory");
#pragma unroll
        for (int k = 0; k < QB; ++k) { const int qq = q0 + k * NTHREADS; if (qq < q_hi) { const int g = qq / QPG;
#pragma unroll
            for (int c = 0; c < 4; ++c) { const unsigned r = rec[k][c]; const int t = g * IG_TOK + (int)((r >> 7) & 1023u), pair = (int)(r & 127u);
                const float z = d[k][c] * us[k][c] * rs[k][c];
                RG[(size_t)t * 128 + pair] = gg[k][c] * 0.5f * z * (1.0f + erff(z * 0.70710678118654752f)) * vs[k][c]; } } }
    }
}
__device__ __forceinline__ void p7b_quant(Frame& F) {
    const int gw = F.vcu * NWAVES + F.wave, NGW = F.G * NWAVES, lane = fresh_lane();
    const float* RG = (const float*)(F.ws + WS_RG); unsigned* CQ = (unsigned*)(F.ws + WS_CQ); float* SCQ = (float*)(F.ws + WS_SCQ);
#pragma unroll 1
    for (int t0 = gw; t0 < NT_TOK; t0 += 4 * NGW) {
        float ca[4], cb[4];
#pragma unroll
        for (int k = 0; k < 4; ++k) { const int t = t0 + k * NGW < NT_TOK ? t0 + k * NGW : t0; ca[k] = RG[(size_t)t * 128 + lane]; cb[k] = RG[(size_t)t * 128 + 64 + lane]; }
#pragma unroll
        for (int k = 0; k < 4; ++k) { const int t = t0 + k * NGW; if (t < NT_TOK) {
            float am = fmaxf(fabsf(ca[k]), fabsf(cb[k]));
#pragma unroll
            for (int o = 1; o < 64; o <<= 1) am = fmaxf(am, __shfl_xor(am, o));
            const float inv = am > 0.f ? 127.0f / am : 0.f;
            const int qa = (int)__builtin_rintf(ca[k] * inv) & 0xff, qb = (int)__builtin_rintf(cb[k] * inv) & 0xff;
            const int wa = qa | (__shfl_down(qa, 8) << 8) | (__shfl_down(qa, 16) << 16) | (__shfl_down(qa, 24) << 24);
            const int wb = qb | (__shfl_down(qb, 8) << 8) | (__shfl_down(qb, 16) << 16) | (__shfl_down(qb, 24) << 24);
            if (((lane >> 3) & 3) == 0) { unsigned* cq = CQ + (size_t)t * 32 + (lane & 7) * 4 + (lane >> 5); cq[0] = (unsigned)wa; cq[2] = (unsigned)wb; }
            if (lane == 0) SCQ[t] = am * (1.0f / 127.0f); } }
    }
}
#endif
__device__ __forceinline__ void p7c_vaxpy(Frame& F, unsigned* bar, unsigned x, unsigned rank) {
    const int lane = fresh_lane(), r = lane >> 3, seg = lane & 7;
    const SliceOwn so = slice_census(bar, x);
    const int gwl = (int)rank * NWAVES + F.wave, stride = (int)so.n_mine * NWAVES;
    const unsigned char* RE16b = F.ws + WS_RE16; const unsigned char* CQb = F.ws + WS_CQ; const float* SCQ = (const float*)(F.ws + WS_SCQ);
    float* SS3 = (float*)(F.ws + WS_SS3); bf16* X2Bw = (bf16*)(F.ws + WS_X2B);
#pragma unroll 1
    for (int pass = 0; pass < 16; ++pass) {
        const int hs = (2 * (int)so.vx + pass) & 15; if ((unsigned)(hs >> 1) % so.npop != so.vx) continue;
        const unsigned char* Vb = F.ws + WS_V + (size_t)hs * (16384 * 128) + 16 * seg;
        const unsigned char* rp0 = RE16b + r * 32; const unsigned char* cp0 = CQb + r * 16;
#define P7C_LOADA(R0, R1, C, S, X, t) do { const int tt_ = (t) < NT_TOK ? (t) : NT_TOK - 1; const unsigned char* rp_ = rp0 + (size_t)tt_ * 256; R0 = *(const v4u*)rp_; R1 = *(const v4u*)(rp_ + 16); \
            C = *(const v4u*)(cp0 + (size_t)tt_ * 128); S = SCQ[tt_]; X = *(const unsigned*)(X2Bw + (size_t)tt_ * DM + 128 * hs + 16 * seg + 2 * r); } while (0)
#define P7C_ISSUE(G, R0, R1) do { __builtin_amdgcn_s_setprio(3); _Pragma("unroll") for (int i_ = 0; i_ < 16; ++i_) { const unsigned e_ = P7_EID(R0, R1, i_); G[i_] = *(const v4u*)(Vb + (size_t)e_ * 128); } __builtin_amdgcn_s_setprio(0); } while (0)
#define P7C_COMP(G, C, S, X, t) do { int acc_[16]; _Pragma("unroll") for (int c_ = 0; c_ < 16; ++c_) acc_[c_] = 0; \
            _Pragma("unroll") for (int gi_ = 0; gi_ < 4; ++gi_) { const int cq_ = (int)C[gi_]; \
                _Pragma("unroll") for (int w_ = 0; w_ < 4; ++w_) { const unsigned A0 = G[4 * gi_][w_], A1 = G[4 * gi_ + 1][w_], A2 = G[4 * gi_ + 2][w_], A3 = G[4 * gi_ + 3][w_]; \
                    const unsigned lo01 = __builtin_amdgcn_perm(A1, A0, 0x05010400u), hi01 = __builtin_amdgcn_perm(A1, A0, 0x07030602u), lo23 = __builtin_amdgcn_perm(A3, A2, 0x05010400u), hi23 = __builtin_amdgcn_perm(A3, A2, 0x07030602u); \
                    acc_[4 * w_ + 0] = __builtin_amdgcn_sdot4((int)__builtin_amdgcn_perm(lo23, lo01, 0x05040100u), cq_, acc_[4 * w_ + 0], false); \
                    acc_[4 * w_ + 1] = __builtin_amdgcn_sdot4((int)__builtin_amdgcn_perm(lo23, lo01, 0x07060302u), cq_, acc_[4 * w_ + 1], false); \
                    acc_[4 * w_ + 2] = __builtin_amdgcn_sdot4((int)__builtin_amdgcn_perm(hi23, hi01, 0x05040100u), cq_, acc_[4 * w_ + 2], false); \
                    acc_[4 * w_ + 3] = __builtin_amdgcn_sdot4((int)__builtin_amdgcn_perm(hi23, hi01, 0x07060302u), cq_, acc_[4 * w_ + 3], false); } } \
            int a8_[8], a4_[4], a2_[2]; \
            { const bool up_ = (lane & 32) != 0; _Pragma("unroll") for (int c_ = 0; c_ < 8; ++c_) { const int keep_ = up_ ? acc_[c_ + 8] : acc_[c_], send_ = up_ ? acc_[c_] : acc_[c_ + 8]; a8_[c_] = keep_ + __shfl_xor(send_, 32); } } \
            { const bool up_ = (lane & 16) != 0; _Pragma("unroll") for (int c_ = 0; c_ < 4; ++c_) { const int keep_ = up_ ? a8_[c_ + 4] : a8_[c_], send_ = up_ ? a8_[c_] : a8_[c_ + 4]; a4_[c_] = keep_ + __shfl_xor(send_, 16); } } \
            { const bool up_ = (lane & 8) != 0; _Pragma("unroll") for (int c_ = 0; c_ < 2; ++c_) { const int keep_ = up_ ? a4_[c_ + 2] : a4_[c_], send_ = up_ ? a4_[c_] : a4_[c_ + 2]; a2_[c_] = keep_ + __shfl_xor(send_, 8); } } \
            const int tt_ = (t) < NT_TOK ? (t) : NT_TOK - 1; bf16* op_ = X2Bw + (size_t)tt_ * DM + 128 * hs + 16 * seg + 2 * r; \
            const float o0_ = bflo(X) + (float)a2_[0] * S, o1_ = bfhi(X) + (float)a2_[1] * S; \
            const float s3_ = wave_sum(o0_ * o0_ + o1_ * o1_); \
            if ((t) < NT_TOK) { *(unsigned*)op_ = pk2(o0_, o1_); if (lane == 0) SS3[(size_t)(t) * 16 + hs] = s3_; } } while (0)
        v4u GA[16], GB[16], ra0, ra1, ca, rb0, rb1, cb, cA, cB; float sa, sb, sA, sB; unsigned xa, xb2, xA, xB;
        P7C_LOADA(ra0, ra1, ca, sa, xa, gwl);
        P7C_LOADA(rb0, rb1, cb, sb, xb2, gwl + stride);
        P7C_ISSUE(GA, ra0, ra1); cA = ca; sA = sa; xA = xa;
#pragma unroll 1
        for (int t = gwl; t < NT_TOK; t += 2 * stride) {
            P7C_LOADA(ra0, ra1, ca, sa, xa, t + 2 * stride); P7C_ISSUE(GB, rb0, rb1); cB = cb; sB = sb; xB = xb2; P7C_COMP(GA, cA, sA, xA, t);
            P7C_LOADA(rb0, rb1, cb, sb, xb2, t + 3 * stride); P7C_ISSUE(GA, ra0, ra1); cA = ca; sA = sa; xA = xa; P7C_COMP(GB, cB, sB, xB, t + stride);
        }
#undef P7C_LOADA
#undef P7C_ISSUE
#undef P7C_COMP
    }
}
__device__ __forceinline__ void p7d_final(Frame& F) {
    const int gw = F.vcu * NWAVES + F.wave, NGW = F.G * NWAVES, lane = fresh_lane();
    const float* SS3 = (const float*)(F.ws + WS_SS3);
    f32x4 gf[8];
#pragma unroll
    for (int j = 0; j < 8; ++j) gf[j] = *(const f32x4*)(F.normf_g + 512 * (j >> 1) + 8 * lane + 4 * (j & 1));
#pragma unroll 1
    for (int t = gw; t < NT_TOK; t += NGW) {
        const float sp = (lane < 16) ? SS3[(size_t)t * 16 + lane] : 0.f; const float r3 = 1.0f / sqrtf(wave_sum(sp) * (1.0f / DM) + RMS_EPS);
        const v4u* xin = (const v4u*)((const bf16*)(F.ws + WS_X2B) + (size_t)t * DM) + lane;
        f32x4* row = (f32x4*)(F.out + (size_t)t * DM);
        v4u v[4];
#pragma unroll
        for (int j = 0; j < 4; ++j) v[j] = xin[64 * j];
#pragma unroll
        for (int j = 0; j < 4; ++j) {
            const f32x4 a = (f32x4){bflo(v[j].x), bfhi(v[j].x), bflo(v[j].y), bfhi(v[j].y)} * r3 * gf[2 * j], b = (f32x4){bflo(v[j].z), bfhi(v[j].z), bflo(v[j].w), bfhi(v[j].w)} * r3 * gf[2 * j + 1];
            row[128 * j + 2 * lane] = a; row[128 * j + 2 * lane + 1] = b; }
    }
}

__device__ __forceinline__ void p4b_quant_x2(Frame& F) {
    const int gw = F.vcu * NWAVES + F.wave, NGW = F.G * NWAVES, lane = fresh_lane();
    const bf16* X2B = (const bf16*)(F.ws + WS_X2B); unsigned char* X2Q = (unsigned char*)F.out + OUT_X2Q; float* SX = (float*)(F.ws + WS_SX);
    v4u cur[4], nxt[4];
    if (gw < NT_TOK) {
#pragma unroll
        for (int j = 0; j < 4; ++j) cur[j] = *(const v4u*)(X2B + (size_t)gw * DM + 512 * j + 8 * lane); }
#pragma unroll 1
    for (int t = gw; t < NT_TOK; t += NGW) {
        { const int tn = (t + NGW < NT_TOK) ? t + NGW : t;
#pragma unroll
          for (int j = 0; j < 4; ++j) nxt[j] = *(const v4u*)(X2B + (size_t)tn * DM + 512 * j + 8 * lane); }
        float v[32]; float am = 0.f;
#pragma unroll
        for (int j = 0; j < 4; ++j)
#pragma unroll
            for (int c = 0; c < 4; ++c) { v[8 * j + 2 * c] = bflo(cur[j][c]); v[8 * j + 2 * c + 1] = bfhi(cur[j][c]); am = fmaxf(am, fmaxf(fabsf(v[8 * j + 2 * c]), fabsf(v[8 * j + 2 * c + 1]))); }
#pragma unroll
        for (int o = 1; o < 64; o <<= 1) am = fmaxf(am, __shfl_xor(am, o));
        const float inv = am > 0.f ? 127.0f / am : 0.f;
#pragma unroll
        for (int j = 0; j < 4; ++j) { v2u o;
#pragma unroll
            for (int q = 0; q < 2; ++q) { unsigned w = 0;
#pragma unroll
                for (int e = 0; e < 4; ++e) w |= ((unsigned)(int)__builtin_rintf(v[8 * j + 4 * q + e] * inv) & 0xffu) << (8 * e);
                o[q] = w; }
            *(v2u*)(X2Q + (size_t)t * DM + 512 * j + 8 * lane) = o; }
        if (lane == 0) SX[t] = am > 0.f ? am * (1.0f / 127.0f) : 1.0f;
#pragma unroll
        for (int j = 0; j < 4; ++j) cur[j] = nxt[j];
    }
}
__global__ void __launch_bounds__(NTHREADS, 2) hymba_fwd(Args args) {
    extern __shared__ __attribute__((aligned(16))) unsigned char lds[];
    Frame F;
    F.lds = (LAS unsigned char*)lds; F.lds_g = lds;
    F.tid = threadIdx.x; F.lane = F.tid & 63; F.wave = __builtin_amdgcn_readfirstlane(F.tid >> 6);
    F.G = gridDim.x; { const int bx = blockIdx.x; F.vcu = (F.G % 8 == 0) ? (bx % 8) * (F.G / 8) + bx / 8 : bx; }
    F.xp = args.in[0]; F.xs = args.in[1]; F.norm1_g = args.in[2]; F.w_in = args.in[3]; F.a_out_g = args.in[4]; F.b_out_g = args.in[5]; F.sink = args.in[6];
    F.w_out = args.in[7]; F.norm2_g = args.in[8]; F.w_pq = args.in[9]; F.sub_keys = args.in[10]; F.expert_u = args.in[11]; F.expert_v = args.in[12]; F.normf_g = args.in[13];
    F.out = args.out; F.ws = args.ws;
    volatile LAS unsigned* MISC = (volatile LAS unsigned*)(F.lds + MISC_OFF);
    if (F.tid < 32) MISC[F.tid] = 0u;
    __syncthreads();
    unsigned* bar = (unsigned*)(F.ws + WS_CTL);
    XcdBarrier xb = xcd_barrier_post(bar, MISC + 8);
#define GRID_BAR() xcd_barrier(xb)
#ifndef PROBE_REP
#define PROBE_REP -1
#endif
#define REPS(k) ((PROBE_REP == (k)) ? 3 : 1)
    for (int rep = 0; rep < REPS(0); ++rep) p0_prep(F);
    GRID_BAR();
    {
#if P1_I8
        pg8::Gemm g{(const bf16*)(F.ws + WS_XN), (const bf16*)(F.ws + WS_WIN), NT_TOK, INW, DM / 2}; pg8::StaticOrder S; S.init(NT_TOK, INW, F.G, (int)blockIdx.x);
        pg8::EpiBf16I8 E{(bf16*)(F.ws + WS_PROJ), INW, (const float*)(F.ws + WS_SXN), (const float*)(F.ws + WS_SWI), 0.125f * LOG2E};
        p1_quant_w<INW, false>(F, F.w_in, nullptr, (const float*)(F.ws + WS_CMAX_IN), F.ws + WS_WIN, (float*)(F.ws + WS_SWI));
        typedef pg8::EpiBf16I8 EpiP1;
#else
        pg8::Gemm g{(const bf16*)(F.ws + WS_XN), (const bf16*)(F.ws + WS_WIN), NT_TOK, INW, DM}; pg8::StaticOrder S; S.init(NT_TOK, INW, F.G, (int)blockIdx.x);
        pg8::EpiBf16 E{(bf16*)(F.ws + WS_PROJ), INW, nullptr, 0.125f * LOG2E};
        typedef pg8::EpiBf16 EpiP1;
#endif
#if P4_I8
        p1_quant_w<DM, false>(F, F.w_out, nullptr, (const float*)(F.ws + WS_CMAX), F.ws + WS_WOUT, (float*)(F.ws + WS_SWO));
#endif
#if P1_I8
        GRID_BAR();
#else
        __syncthreads();
#endif
        for (int rep = 0; rep < REPS(1); ++rep) pg8::gemm_phase<EpiP1, pg8::StaticOrder, true, true>(F.lds, g, S, E, F.wave);
    }
    GRID_BAR();
    p2_attention<0>(F);
#if PROBE_REP == 21
    p2_attention<1>(F); p2_attention<1>(F);
#elif PROBE_REP == 22
    p2_attention<2>(F); p2_attention<2>(F);
#elif PROBE_REP == 23
    p2_attention<3>(F); p2_attention<3>(F);
#elif PROBE_REP == 24
    p2_attention<4>(F); p2_attention<4>(F);
#elif PROBE_REP == 25
    p2_attention<5>(F); p2_attention<5>(F);
#elif PROBE_REP == 26
    p2_attention<6>(F); p2_attention<6>(F);
#elif PROBE_REP == 2
    p2_attention<0>(F); p2_attention<0>(F);
#endif
    GRID_BAR();
    for (int rep = 0; rep < REPS(3); ++rep) p3_finalize(F);
#if P5_I8
    __syncthreads();
    p1_quant_w<DM, true>(F, F.w_pq, F.norm2_g, (const float*)(F.ws + WS_CMAX2), F.ws + WS_WPQ, (float*)(F.ws + WS_SWQ));
#endif
    GRID_BAR();
    {
#if P4_I8
        pg8::Gemm g{(const bf16*)(F.ws + WS_MIXED), (const bf16*)(F.ws + WS_WOUT), NT_TOK, DM, DM / 2}; pg8::StaticOrder S; S.init(NT_TOK, DM, F.G, (int)blockIdx.x);
        pg8::EpiResidI8 E{F.xp, F.xs, (bf16*)(F.ws + WS_X2B), (float*)(F.ws + WS_SS), (const float*)(F.ws + WS_SA), (const float*)(F.ws + WS_SWO)};
        for (int rep = 0; rep < REPS(4); ++rep) pg8::gemm_phase<pg8::EpiResidI8, pg8::StaticOrder, true, true>(F.lds, g, S, E, F.wave);
#else
        pg8::Gemm g{(const bf16*)(F.ws + WS_MIXED), (const bf16*)(F.ws + WS_WOUT), NT_TOK, DM, DM}; pg8::StaticOrder S; S.init(NT_TOK, DM, F.G, (int)blockIdx.x);
        pg8::EpiResid E{F.xp, F.xs, F.out, (bf16*)(F.ws + WS_X2B), (float*)(F.ws + WS_SS), (unsigned char*)F.out + OUT_X2Q, (const float*)(F.ws + WS_SX2)};
        for (int rep = 0; rep < REPS(4); ++rep) pg8::gemm_phase<pg8::EpiResid, pg8::StaticOrder, true, true>(F.lds, g, S, E, F.wave);
#endif
    }
    GRID_BAR();
#if P5_I8 == 1
    p4b_quant_x2(F);
    GRID_BAR();
#endif
    {
#if P5_I8
        pg8::Gemm g{(const bf16*)((const unsigned char*)F.out + OUT_X2Q), (const bf16*)(F.ws + WS_WPQ), NT_TOK, DM, DM / 2}; pg8::StaticOrder S; S.init(NT_TOK, DM, F.G, (int)blockIdx.x);
        typedef EpiRouteT<true> EpiRoute;
        EpiRoute E{(const float*)(F.ws + WS_SS), F.ws, (const float*)(F.ws + WS_SX2), (const float*)(F.ws + WS_SWQ)};
#else
        pg8::Gemm g{(const bf16*)(F.ws + WS_X2B), (const bf16*)(F.ws + WS_WPQ), NT_TOK, DM, DM}; pg8::StaticOrder S; S.init(NT_TOK, DM, F.G, (int)blockIdx.x);
        typedef EpiRouteT<false> EpiRoute;
        EpiRoute E{(const float*)(F.ws + WS_SS), F.ws, nullptr, nullptr};
#endif
#pragma unroll 1
        for (int rep = 0; rep < REPS(5); ++rep)
#pragma unroll 1
        for (int i = 0;; ++i) { pg8::OneUnit O; if (!S.next(i, O.u)) break; pg8::gemm_phase<EpiRoute, pg8::OneUnit, false, true>(F.lds, g, O, E, F.wave); }
    }
    GRID_BAR();
    const unsigned rank = MISC[10];
#if P7A_INV
    for (int rep = 0; rep < REPS(9); ++rep) p6a_hist(F);
    GRID_BAR();
    for (int rep = 0; rep < REPS(10); ++rep) p6b_scatter(F);
    GRID_BAR();
    p7a_inv<0>(F, bar, xb.x, rank);
#if PROBE_REP == 7
    p7a_inv<4>(F, bar, xb.x, rank); p7a_inv<4>(F, bar, xb.x, rank);
#elif PROBE_REP == 71
    p7a_inv<5>(F, bar, xb.x, rank); p7a_inv<5>(F, bar, xb.x, rank);
#elif PROBE_REP == 72
    p7a_inv<6>(F, bar, xb.x, rank); p7a_inv<6>(F, bar, xb.x, rank);
#elif PROBE_REP == 73
    p7a_inv<7>(F, bar, xb.x, rank); p7a_inv<7>(F, bar, xb.x, rank);
#elif PROBE_REP == 74
    p7a_inv<12>(F, bar, xb.x, rank); p7a_inv<12>(F, bar, xb.x, rank);
#elif PROBE_REP == 75
    p7a_inv<20>(F, bar, xb.x, rank); p7a_inv<20>(F, bar, xb.x, rank);
#endif
    GRID_BAR();
    p7b_sorted(F);
    GRID_BAR();
    for (int rep = 0; rep < REPS(11); ++rep) p7b_quant(F);
    GRID_BAR();
#else
    for (int rep = 0; rep < REPS(7); ++rep) p7a_udots(F, bar, xb.x, rank);
    GRID_BAR();
    for (int rep = 0; rep < REPS(8); ++rep) p7b_coef(F);
    GRID_BAR();
#endif
    p7c_vaxpy(F, bar, xb.x, rank);
    GRID_BAR();
    p7d_final(F);
#undef GRID_BAR
}

extern "C" void kernel_launch(void* const* d_in, const int* in_sizes, int n_in, void* d_out, int out_size, void* d_ws, size_t ws_size, hipStream_t stream) {
    static int grid = 0;
    if (grid == 0) {
        if (n_in != 14 || out_size != NT_TOK * DM || ws_size < WS_END) { fprintf(stderr, "kernel_launch: unexpected shapes (n_in %d out %d ws %zu)\n", n_in, out_size, ws_size); grid = -1; return; }
        int dev = 0, cus = 0, per_cu = 0;
        (void)hipGetDevice(&dev); (void)hipDeviceGetAttribute(&cus, hipDeviceAttributeMultiprocessorCount, dev);
        (void)hipFuncSetAttribute((const void*)hymba_fwd, hipFuncAttributeMaxDynamicSharedMemorySize, LDS_BYTES);
        (void)hipOccupancyMaxActiveBlocksPerMultiprocessor(&per_cu, (const void*)hymba_fwd, NTHREADS, LDS_BYTES);
        if (per_cu < 1) { fprintf(stderr, "kernel_launch: occupancy query says %d blocks per CU\n", per_cu); per_cu = 1; }
        (void)hipGetLastError();
        grid = cus;
    }
    if (grid < 0) return;
    Args a{};
    for (int i = 0; i < 14; ++i) a.in[i] = (const float*)d_in[i];
    a.out = (float*)d_out; a.ws = (unsigned char*)d_ws; a.ph_lo = 0; a.ph_hi = 0;
    if (hipMemsetAsync((char*)d_ws + WS_CTL, 0, CTL_ZERO_BYTES, stream) != hipSuccess) { fprintf(stderr, "kernel_launch: memset failed\n"); return; }
    void* kargs[] = {&a};
    hipError_t e = hipLaunchCooperativeKernel((const void*)hymba_fwd, dim3(grid), dim3(NTHREADS), kargs, LDS_BYTES, stream);
    if (e != hipSuccess) fprintf(stderr, "cooperative launch failed: %s (grid %d)\n", hipGetErrorString(e), grid);
}
```

```cpp
#include <hip/hip_runtime.h>
#include <hip/hip_cooperative_groups.h>
#include <cstdio>
#include <cstdint>
namespace cg = cooperative_groups;

#ifndef PROBE_REP
#define PROBE_REP -1
#endif
#ifndef P4_I8
#define P4_I8 0
#endif
#ifndef P1_I8
#define P1_I8 1
#endif
#ifndef P5_I8
#define P5_I8 2
#endif
#ifndef P7A_INV
#define P7A_INV 1
#endif
#ifndef P7A_X2Q
#define TAB_P2 1
#define P7A_X2Q 1
#endif
#ifndef MK_N_LAUNCHES
#define MK_N_LAUNCHES 1
#endif

__device__ __forceinline__ int fresh_lane() { int l; asm volatile("v_mbcnt_lo_u32_b32 %0, -1, 0\n\tv_mbcnt_hi_u32_b32 %0, -1, %0" : "=v"(l)); return l; }
namespace pg8 {
#define PG8_LAS __attribute__((address_space(3)))
typedef unsigned short bf16_t;
typedef short bf16x8 __attribute__((ext_vector_type(8)));
typedef float f32x4 __attribute__((ext_vector_type(4)));
typedef unsigned u32x4 __attribute__((ext_vector_type(4)));
typedef unsigned u32x2 __attribute__((ext_vector_type(2)));
typedef int i32x4 __attribute__((ext_vector_type(4)));
template <bool I8> struct AccT { typedef f32x4 type; };
template <> struct AccT<true> { typedef i32x4 type; };
template <bool I8> __device__ __forceinline__ typename AccT<I8>::type mma16(bf16x8 b, bf16x8 a, typename AccT<I8>::type c) {
    if constexpr (I8) return __builtin_amdgcn_mfma_i32_16x16x64_i8(__builtin_bit_cast(i32x4, b), __builtin_bit_cast(i32x4, a), c, 0, 0, 0);
    else return __builtin_amdgcn_mfma_f32_16x16x32_bf16(b, a, c, 0, 0, 0);
}
constexpr int BM = 256, BK = 64, HALF = 128, HTB = HALF * BK * 2, STAGE_BYTES = 8 * HTB, NXCD = 8, WGM = 8;

__host__ __device__ __forceinline__ int lds_byte(int r, int c) { const int st = (r >> 4) * 2 + (c >> 5), rr = r & 15, cc = c & 31, ob = rr * 64 + cc * 2; return st * 1024 + (ob ^ (((ob >> 9) & 1) << 5)); }
__host__ __device__ __forceinline__ void stage_rc(int b, int& R, int& C) { const int st = b / 1024, sb = b % 1024, swz = sb ^ (((sb >> 9) & 1) << 5); R = (st >> 1) * 16 + swz / 64; C = (st & 1) * 32 + (swz % 64) / 2; }
__host__ __device__ __forceinline__ int perm32(int rho) { const int n = rho >> 4, i = rho & 15; return 8 * (i >> 2) + 4 * n + (i & 3); }

struct Unit { int pm, pn; };
struct Gemm { const bf16_t* A; const bf16_t* Bt; int M, N, K; };

struct StaticOrder {
    int nM, nN, nwg, G, c;
    __host__ __device__ void init(int M, int N, int G_, int c_) { nM = M / BM; nN = N / BM; nwg = nM * nN; G = G_; c = c_; }
    __host__ __device__ bool next(int i, Unit& u) const {
        const long L = (long)i * G + c; if (L >= nwg) return false;
        int wgid = (int)L; { const int q = nwg / NXCD, r = nwg % NXCD, xcd = wgid % NXCD, off = wgid / NXCD; wgid = (xcd < r ? xcd * (q + 1) : r * (q + 1) + (xcd - r) * q) + off; }
        const int nig = WGM * nN, gid = wgid / nig, fm = gid * WGM, gsz = (nM - fm) < WGM ? (nM - fm) : WGM;
        u.pm = fm + ((wgid % nig) % gsz); u.pn = (wgid % nig) / gsz; return true;
    }
    __device__ __forceinline__ void a_ready(const Unit&) const {}
    __device__ __forceinline__ void done(const Unit&) const {}
};

struct OneUnit { Unit u;
    __device__ __forceinline__ bool next(int i, Unit& o) const { if (i != 0) return false; o = u; return true; }
    __device__ __forceinline__ void a_ready(const Unit&) const {}
    __device__ __forceinline__ void done(const Unit&) const {}
};

__device__ __forceinline__ unsigned cvt_pk_bf16(float lo, float hi) { unsigned r; asm volatile("v_cvt_pk_bf16_f32 %0, %1, %2" : "=v"(r) : "v"(lo), "v"(hi)); return r; }

struct EpiBf16 {
    static constexpr bool PERM = true, AFTER_DRAIN = false, I8 = false;
    bf16_t* O; int ldc; const float* ss;
    float qscale;
    __device__ __forceinline__ void operator()(const f32x4 (&acc)[2][2][4][2], const Unit& u, int wr, int wc, int fr, int fq) const {
        const int row0 = u.pm * BM + wr * 64 + fr; const int col0 = u.pn * BM + wc * 32 + 8 * fq;
#pragma unroll
        for (int ai = 0; ai < 2; ++ai)
#pragma unroll
            for (int m = 0; m < 4; ++m) {
                const int r = row0 + ai * HALF + m * 16;
                float sc = (qscale != 0.f && (u.pn < 4 || (u.pn >= 12 && u.pn < 16))) ? qscale : 1.f;
                if (ss) { const f32x4* p = (const f32x4*)(ss + (size_t)r * 32); float s = 0.f;
#pragma unroll
                    for (int i = 0; i < 8; ++i) { const f32x4 v = p[i]; s += (v[0] + v[1]) + (v[2] + v[3]); }
                    sc *= 1.0f / sqrtf(s * (1.0f / 2048.0f) + 1e-6f); }
                bf16_t* rowp = O + (size_t)r * ldc + col0;
#pragma unroll
                for (int bj = 0; bj < 2; ++bj) { const f32x4 v0 = acc[ai][bj][m][0] * sc, v1 = acc[ai][bj][m][1] * sc;
                    u32x4 w; w.x = cvt_pk_bf16(v0[0], v0[1]); w.y = cvt_pk_bf16(v0[2], v0[3]); w.z = cvt_pk_bf16(v1[0], v1[1]); w.w = cvt_pk_bf16(v1[2], v1[3]);
                    *(u32x4*)(rowp + bj * HALF) = w; } }
    }
};
struct EpiBf16I8 {
    static constexpr bool PERM = true, AFTER_DRAIN = false, I8 = true;
    bf16_t* O; int ldc; const float* sa; const float* sw; float qscale; int hm_rows;
    __device__ __forceinline__ void operator()(const i32x4 (&acc)[2][2][4][2], const Unit& u, int wr, int wc, int fr, int fq) const {
        const int row0 = u.pm * BM + wr * 64 + fr; const int col0 = u.pn * BM + wc * 32 + 8 * fq;
        f32x4 w0[2], w1[2]; float sav[8];
#pragma unroll
        for (int bj = 0; bj < 2; ++bj) { w0[bj] = *(const f32x4*)(sw + col0 + bj * HALF); w1[bj] = *(const f32x4*)(sw + col0 + bj * HALF + 4); }
#pragma unroll
        for (int i = 0; i < 8; ++i) sav[i] = sa[row0 + (i >> 2) * HALF + (i & 3) * 16];
#pragma unroll
        for (int ai = 0; ai < 2; ++ai)
#pragma unroll
            for (int m = 0; m < 4; ++m) {
                const int r = row0 + ai * HALF + m * 16;
                float sc = sav[4 * ai + m]; if (qscale != 0.f && (u.pn < 4 || (u.pn >= 12 && u.pn < 16))) sc *= qscale;
                bf16_t* rowp = O + (size_t)r * ldc + col0;
#pragma unroll
                for (int bj = 0; bj < 2; ++bj) { const i32x4 a0 = acc[ai][bj][m][0], a1 = acc[ai][bj][m][1];
                    const f32x4 v0 = (f32x4){(float)a0[0], (float)a0[1], (float)a0[2], (float)a0[3]} * w0[bj] * sc, v1 = (f32x4){(float)a1[0], (float)a1[1], (float)a1[2], (float)a1[3]} * w1[bj] * sc;
                    u32x4 w; w.x = cvt_pk_bf16(v0[0], v0[1]); w.y = cvt_pk_bf16(v0[2], v0[3]); w.z = cvt_pk_bf16(v1[0], v1[1]); w.w = cvt_pk_bf16(v1[2], v1[3]);
                    if (hm_rows) { const int c = col0 + bj * HALF; *(u32x4*)(O + ((size_t)(c >> 6) * hm_rows + r) * 64 + (c & 63)) = w; }
                    else *(u32x4*)(rowp + bj * HALF) = w; } }
    }
};
struct EpiResid {
    static constexpr bool PERM = true, AFTER_DRAIN = false, I8 = false, XQ = (P5_I8 == 2);
    const float* xp; const float* xs; float* out; bf16_t* xb; float* ss; unsigned char* xq; const float* sx;
    __device__ __forceinline__ void operator()(const f32x4 (&acc)[2][2][4][2], const Unit& u, int wr, int wc, int fr, int fq) const {
        const int row0 = u.pm * BM + wr * 64 + fr; const int col0 = u.pn * BM + wc * 32 + 8 * fq;
        f32x4 xv[3][4];
#define EPR_ROW(it) (row0 + ((it) >> 2) * HALF + ((it) & 3) * 16)
#define EPR_LOAD(buf, it) do { const int r_ = EPR_ROW(it); const float* xrow_ = (r_ < 16384) ? (xp + (size_t)r_ * 2048) : (xs + (size_t)(r_ - 16384) * 2048); \
            _Pragma("unroll") for (int q_ = 0; q_ < 4; ++q_) xv[buf][q_] = *(const f32x4*)(xrow_ + col0 + (q_ >> 1) * HALF + (q_ & 1) * 4); } while (0)
        float sxv[8];
#pragma unroll
        for (int i = 0; i < 8; ++i) sxv[i] = XQ ? sx[EPR_ROW(i)] : 1.0f;
        EPR_LOAD(0, 0); EPR_LOAD(1, 1);
#pragma unroll
        for (int it = 0; it < 8; ++it) {
            const int ai = it >> 2, m = it & 3, r = EPR_ROW(it);
            if (it + 2 < 8) EPR_LOAD((it + 2) % 3, it + 2);
            float s = 0.f; const float qi = XQ ? 1.0f / sxv[it] : 0.f;
#pragma unroll
            for (int bj = 0; bj < 2; ++bj) { const int c = col0 + bj * HALF;
                const f32x4 v0 = acc[ai][bj][m][0] + xv[it % 3][bj * 2], v1 = acc[ai][bj][m][1] + xv[it % 3][bj * 2 + 1];
                u32x4 w; w.x = cvt_pk_bf16(v0[0], v0[1]); w.y = cvt_pk_bf16(v0[2], v0[3]); w.z = cvt_pk_bf16(v1[0], v1[1]); w.w = cvt_pk_bf16(v1[2], v1[3]);
                *(u32x4*)(xb + (size_t)r * 2048 + c) = w;
                if (XQ) { u32x2 p; p.x = 0; p.y = 0;
#pragma unroll
                    for (int e = 0; e < 4; ++e) { p.x |= ((unsigned)(int)__builtin_rintf(fminf(fmaxf(v0[e] * qi, -127.0f), 127.0f)) & 0xffu) << (8 * e); p.y |= ((unsigned)(int)__builtin_rintf(fminf(fmaxf(v1[e] * qi, -127.0f), 127.0f)) & 0xffu) << (8 * e); }
                    *(u32x2*)(xq + (size_t)r * 2048 + c) = p; }
                s += ((v0[0] * v0[0] + v0[1] * v0[1]) + (v0[2] * v0[2] + v0[3] * v0[3])) + ((v1[0] * v1[0] + v1[1] * v1[1]) + (v1[2] * v1[2] + v1[3] * v1[3])); }
            s += __shfl_xor(s, 16); s += __shfl_xor(s, 32);
            if (fq == 0) ss[(size_t)r * 32 + u.pn * 4 + wc] = s;
            asm volatile("" ::: "memory"); }
#undef EPR_LOAD
#undef EPR_ROW
    }
};

struct EpiResidI8 {
    static constexpr bool PERM = false, AFTER_DRAIN = false, I8 = true;
    const float* xp; const float* xs; bf16_t* xb; float* ss; const float* sa; const float* sw;
    __device__ __forceinline__ void operator()(const i32x4 (&acc)[2][2][4][2], const Unit& u, int wr, int wc, int fr, int fq) const {
        const int row0 = u.pm * BM + wr * 64 + fr; const int col0 = u.pn * BM + wc * 32 + 4 * fq;
        f32x4 swv[2][2];
#pragma unroll
        for (int bj = 0; bj < 2; ++bj)
#pragma unroll
            for (int n = 0; n < 2; ++n) swv[bj][n] = *(const f32x4*)(sw + col0 + bj * HALF + n * 16);
#pragma unroll
        for (int ai = 0; ai < 2; ++ai)
#pragma unroll
            for (int m = 0; m < 4; ++m) {
                const int r = row0 + ai * HALF + m * 16;
                const float* xrow = (r < 16384) ? (xp + (size_t)r * 2048) : (xs + (size_t)(r - 16384) * 2048);
                const float sar = sa[r];
                float s = 0.f;
#pragma unroll
                for (int bj = 0; bj < 2; ++bj)
#pragma unroll
                    for (int n = 0; n < 2; ++n) { const int c = col0 + bj * HALF + n * 16;
                        const i32x4 a = acc[ai][bj][m][n];
                        const f32x4 v = (f32x4){(float)a[0], (float)a[1], (float)a[2], (float)a[3]} * sar * swv[bj][n] + *(const f32x4*)(xrow + c);
                        u32x2 w; w.x = cvt_pk_bf16(v[0], v[1]); w.y = cvt_pk_bf16(v[2], v[3]);
                        *(u32x2*)(xb + (size_t)r * 2048 + c) = w;
                        s += (v[0] * v[0] + v[1] * v[1]) + (v[2] * v[2] + v[3] * v[3]); }
                s += __shfl_xor(s, 16); s += __shfl_xor(s, 32);
                if (fq == 0) ss[(size_t)r * 32 + u.pn * 4 + wc] = s;
                asm volatile("" ::: "memory"); }
    }
};

template <class Epi, class Sched, bool ALIGN_EPI = false, bool SP2 = false>
__device__ __forceinline__ void gemm_phase(PG8_LAS unsigned char* lds, const Gemm g, const Sched& S, const Epi& E, int wid  ) {
    const int lane = fresh_lane(), tid = wid * 64 + lane, wr = wid >> 2, wc = wid & 3, fr = lane & 15, fq = lane >> 4;
    const int K = g.K, nt = K / BK;
    unsigned voffA[2], voffB[2];
#pragma unroll
    for (int i = 0; i < 2; ++i) { int R, C; stage_rc(tid * 16 + i * 8192, R, C); const int Rb = Epi::PERM ? ((R & ~31) + perm32(R & 31)) : R;
        voffA[i] = (unsigned)(R * K + C) * 2u; voffB[i] = (unsigned)(Rb * K + C) * 2u; }
    const size_t kstep = (size_t)(BK * 2);
    const size_t hstep = (size_t)HALF * K * 2;
    const size_t tstep = 2 * hstep;
    const unsigned ldsw = (unsigned)wid * 1024u;
    const int aoff = lds_byte(wr * 64 + fr, fq * 8), boff = lds_byte(wc * 32 + fr, fq * 8);
#define PG8_SA(b, h) (((b) * 2 + (h)) * HTB)
#define PG8_SB(b, h) ((4 + (b) * 2 + (h)) * HTB)
#define PG8_STAGE(bufoff, gbase, voff) do { _Pragma("unroll") for (int _i = 0; _i < 2; ++_i) \
        __builtin_amdgcn_global_load_lds((const unsigned*)((const char*)(gbase) + (voff)[_i]), (PG8_LAS unsigned*)(lds + (bufoff) + ldsw + _i * 8192), 16, 0, 0); } while (0)
#define PG8_LDA(dst, b, h) do { _Pragma("unroll") for (int m = 0; m < 4; ++m) _Pragma("unroll") for (int k = 0; k < 2; ++k) dst[m][k] = *(const PG8_LAS bf16x8*)(lds + PG8_SA(b, h) + aoff + m * 2048 + k * 1024); } while (0)
#define PG8_LDB(dst, b, h) do { _Pragma("unroll") for (int n = 0; n < 2; ++n) _Pragma("unroll") for (int k = 0; k < 2; ++k) dst[n][k] = *(const PG8_LAS bf16x8*)(lds + PG8_SB(b, h) + boff + n * 2048 + k * 1024); } while (0)
#define PG8_MMA(ai, bj, At, Bt) do { __builtin_amdgcn_s_setprio(1); _Pragma("unroll") for (int m = 0; m < 4; ++m) _Pragma("unroll") for (int n = 0; n < 2; ++n) _Pragma("unroll") for (int k = 0; k < 2; ++k) \
        acc[ai][bj][m][n] = mma16<Epi::I8>(Bt[n][k], At[m][k], acc[ai][bj][m][n]); __builtin_amdgcn_s_setprio(0); } while (0)
#define PG8_WAIT_V(n) asm volatile("s_waitcnt vmcnt(" #n ")" ::: "memory")
#define PG8_WAIT_L(n) asm volatile("s_waitcnt lgkmcnt(" #n ")" ::: "memory")
#define PG8_BAR __builtin_amdgcn_s_barrier()
#define PG8_SCHED __builtin_amdgcn_sched_barrier(0)
    Unit cur, nxt; int ui = 0;
    if (!S.next(0, cur)) return;
    typedef typename AccT<Epi::I8>::type acc_t;
    acc_t acc[2][2][4][2];
#pragma unroll
    for (int a = 0; a < 2; ++a)
#pragma unroll
        for (int b = 0; b < 2; ++b)
#pragma unroll
            for (int m = 0; m < 4; ++m)
#pragma unroll
                for (int n = 0; n < 2; ++n) acc[a][b][m][n] = (acc_t){0, 0, 0, 0};
    bf16x8 At[4][2], B0[2][2], B1[2][2];
    const char* cA = (const char*)g.A + (size_t)cur.pm * tstep; const char* cB = (const char*)g.Bt + (size_t)cur.pn * tstep;
    S.a_ready(cur);
    if constexpr (SP2) {
        PG8_STAGE(PG8_SB(0, 0), cB, voffB); PG8_STAGE(PG8_SB(0, 1), cB + hstep, voffB); PG8_STAGE(PG8_SA(0, 0), cA, voffA); PG8_STAGE(PG8_SA(0, 1), cA + hstep, voffA);
        if (wr == 1) PG8_BAR;
        PG8_WAIT_V(2); PG8_BAR;
        PG8_STAGE(PG8_SB(1, 0), cB + kstep, voffB); PG8_STAGE(PG8_SA(1, 0), cA + kstep, voffA); PG8_STAGE(PG8_SB(1, 1), cB + hstep + kstep, voffB);
        PG8_WAIT_V(6); PG8_BAR;
    } else {
        PG8_STAGE(PG8_SB(0, 0), cB, voffB); PG8_STAGE(PG8_SA(0, 0), cA, voffA); PG8_STAGE(PG8_SB(0, 1), cB + hstep, voffB); PG8_STAGE(PG8_SA(0, 1), cA + hstep, voffA);
        if (wr == 1) PG8_BAR;
        PG8_WAIT_V(4); PG8_BAR;
        PG8_STAGE(PG8_SB(1, 0), cB + kstep, voffB); PG8_STAGE(PG8_SA(1, 0), cA + kstep, voffA); PG8_STAGE(PG8_SB(1, 1), cB + hstep + kstep, voffB);
        PG8_WAIT_V(6); PG8_BAR;
    }
    for (;;) {
        const bool has_next = S.next(ui + 1, nxt);
        const char* nA = has_next ? (const char*)g.A + (size_t)nxt.pm * tstep : cA; const char* nB = has_next ? (const char*)g.Bt + (size_t)nxt.pn * tstep : cB;
        for (int t = 0; t < nt; t += 2) {
            const bool last = (t == nt - 2);
            const char* a1 = cA + (size_t)(t + 1) * kstep;
            const char* a2 = last ? nA : cA + (size_t)(t + 2) * kstep; const char* b2 = last ? nB : cB + (size_t)(t + 2) * kstep;
            const char* a3 = a2 + kstep; const char* b3 = b2 + kstep;
            if (last && has_next) S.a_ready(nxt);
            if constexpr (SP2) {
            PG8_LDB(B0, 0, 0); PG8_LDB(B1, 0, 1); PG8_SCHED; PG8_LDA(At, 0, 0); PG8_STAGE(PG8_SA(1, 1), a1 + hstep, voffA);
            PG8_WAIT_V(8); PG8_WAIT_L(0); PG8_BAR; PG8_MMA(0, 0, At, B0); PG8_MMA(0, 1, At, B1); PG8_BAR; PG8_SCHED;
            PG8_LDA(At, 0, 1); PG8_STAGE(PG8_SB(0, 0), b2, voffB); PG8_STAGE(PG8_SB(0, 1), b2 + hstep, voffB); PG8_STAGE(PG8_SA(0, 0), a2, voffA);
            PG8_WAIT_V(8); PG8_WAIT_L(0); PG8_BAR; PG8_MMA(1, 0, At, B0); PG8_MMA(1, 1, At, B1); PG8_BAR; PG8_SCHED;
            PG8_LDB(B0, 1, 0); PG8_LDB(B1, 1, 1); PG8_SCHED; PG8_LDA(At, 1, 0); PG8_STAGE(PG8_SA(0, 1), a2 + hstep, voffA);
            PG8_WAIT_V(8); PG8_WAIT_L(0); PG8_BAR; PG8_MMA(0, 0, At, B0); PG8_MMA(0, 1, At, B1); PG8_BAR; PG8_SCHED;
            PG8_LDA(At, 1, 1); PG8_STAGE(PG8_SB(1, 0), b3, voffB); PG8_STAGE(PG8_SB(1, 1), b3 + hstep, voffB); PG8_STAGE(PG8_SA(1, 0), a3, voffA);
            PG8_WAIT_V(8); PG8_WAIT_L(0); PG8_BAR; PG8_MMA(1, 0, At, B0); PG8_MMA(1, 1, At, B1); PG8_BAR; PG8_SCHED;
            } else {
            PG8_LDB(B0, 0, 0); PG8_SCHED; PG8_LDA(At, 0, 0); PG8_STAGE(PG8_SA(1, 1), a1 + hstep, voffA);
            PG8_WAIT_L(8); PG8_BAR; PG8_WAIT_L(0); PG8_MMA(0, 0, At, B0); PG8_BAR; PG8_SCHED;
            PG8_LDB(B1, 0, 1); PG8_STAGE(PG8_SB(0, 0), b2, voffB);
            PG8_BAR; PG8_WAIT_L(0); PG8_MMA(0, 1, At, B1); PG8_BAR;
            PG8_LDA(At, 0, 1); PG8_STAGE(PG8_SA(0, 0), a2, voffA);
            PG8_BAR; PG8_WAIT_L(0); PG8_MMA(1, 0, At, B0); PG8_BAR; PG8_SCHED;
            PG8_STAGE(PG8_SB(0, 1), b2 + hstep, voffB);
            PG8_WAIT_V(6); PG8_BAR; PG8_MMA(1, 1, At, B1); PG8_BAR;
            PG8_LDB(B0, 1, 0); PG8_SCHED; PG8_LDA(At, 1, 0); PG8_STAGE(PG8_SA(0, 1), a2 + hstep, voffA);
            PG8_WAIT_L(8); PG8_BAR; PG8_WAIT_L(0); PG8_MMA(0, 0, At, B0); PG8_BAR; PG8_SCHED;
            PG8_LDB(B1, 1, 1); PG8_STAGE(PG8_SB(1, 0), b3, voffB);
            PG8_BAR; PG8_WAIT_L(0); PG8_MMA(0, 1, At, B1); PG8_BAR;
            PG8_LDA(At, 1, 1); PG8_STAGE(PG8_SA(1, 0), a3, voffA);
            PG8_BAR; PG8_WAIT_L(0); PG8_MMA(1, 0, At, B0); PG8_BAR; PG8_SCHED;
            PG8_STAGE(PG8_SB(1, 1), b3 + hstep, voffB);
            PG8_WAIT_V(6); PG8_BAR; PG8_MMA(1, 1, At, B1); PG8_BAR;
            }
        }
        if constexpr (ALIGN_EPI) { if (wr == 0) PG8_BAR; }
        if constexpr (!Epi::AFTER_DRAIN) { E(acc, cur, wr, wc, fr, fq); S.done(cur); }
        if (!has_next) break;
#pragma unroll
        for (int a = 0; a < 2; ++a)
#pragma unroll
            for (int b = 0; b < 2; ++b)
#pragma unroll
                for (int m = 0; m < 4; ++m)
#pragma unroll
                    for (int n = 0; n < 2; ++n) acc[a][b][m][n] = (acc_t){0, 0, 0, 0};
        cur = nxt; cA = nA; cB = nB; ++ui;
        if constexpr (ALIGN_EPI) { if (wr == 1) PG8_BAR; }
    }
    PG8_WAIT_V(0);
    if constexpr (!ALIGN_EPI) { if (wr == 0) PG8_BAR; }
    PG8_BAR;
    if constexpr (Epi::AFTER_DRAIN) { E.fused(acc, cur, wr, wc, fr, fq, lds, wid, lane); }
#undef PG8_SA
#undef PG8_SB
#undef PG8_STAGE
#undef PG8_LDA
#undef PG8_LDB
#undef PG8_MMA
#undef PG8_WAIT_V
#undef PG8_WAIT_L
#undef PG8_BAR
#undef PG8_SCHED
}
}

constexpr int NT_TOK = 24576, DM = 2048, INW = 4608, NPROMPT = 16384;
constexpr int NWAVES = 8, NTHREADS = 512;
constexpr float RMS_EPS = 1e-6f;
constexpr float LOG2E = 1.4426950408889634f;

constexpr size_t MiB = 1u << 20;
constexpr size_t WS_CTL = 0, CTL_ZERO_BYTES = 128 * 1024;
constexpr size_t WS_CMAX_IN = 64 * 1024;
constexpr size_t WS_SWI = 35 * MiB + 640 * 1024;
constexpr size_t WS_SXN = 39 * MiB + 262144;
constexpr size_t WS_SX2 = 39 * MiB + 393216;
constexpr size_t WS_WIN = 1 * MiB;
constexpr size_t WS_WOUT = 19 * MiB;
constexpr size_t WS_SWO = 23 * MiB;
constexpr size_t WS_CMAX = 32 * 1024;
constexpr size_t WS_SA = 39 * MiB + 131072;
constexpr size_t WS_SX = 39 * MiB + 262144;
constexpr size_t WS_SWQ = 31 * MiB;
constexpr size_t WS_CMAX2 = 48 * 1024;
constexpr size_t OUT_X2Q = 0;
constexpr size_t WS_WPQ = 27 * MiB;
constexpr size_t WS_SK = 35 * MiB;
constexpr size_t WS_SS = 36 * MiB;
constexpr size_t WS_US = 39 * MiB;
constexpr size_t WS_VS = 39 * MiB + 65536;
constexpr size_t WS_U = 40 * MiB;
constexpr size_t WS_V = 72 * MiB;
constexpr size_t WS_XN = 168 * MiB;
constexpr size_t WS_PROJ = 264 * MiB;
constexpr size_t WS_MIXED = WS_PROJ;
constexpr size_t WS_X2B = WS_PROJ + 96 * MiB;
constexpr size_t WS_RE16 = WS_PROJ + 192 * MiB;
constexpr size_t WS_RG = WS_PROJ + 198 * MiB;
constexpr size_t WS_CQ = WS_PROJ + 210 * MiB;
constexpr size_t WS_SCQ = WS_PROJ + 213 * MiB;
constexpr size_t WS_SS3 = WS_PROJ + 214 * MiB;
constexpr size_t WS_PD0 = WS_XN;
constexpr size_t WS_PD1 = WS_MIXED;
constexpr size_t WS_END = 480 * MiB;
constexpr int IG_NGRP = 64, IG_TOK = 384, IG_NSUB = 256, IG_SUBT = 96, IG_SPG = IG_TOK / IG_SUBT, IG_PICKS = IG_TOK * 128, IG_PITCH = 272;
constexpr size_t WS_L = 104 * MiB;
constexpr size_t WS_TL = 117 * MiB;
constexpr size_t WS_H = 118 * MiB;
constexpr size_t WS_RSTD2 = 119 * MiB;
constexpr size_t WS_NTL = 119 * MiB + 131072;
constexpr size_t OUT_OA = 0, OUT_OA_STRIDE = 48 * MiB, OUT_LSE = 144 * MiB, OUT_LSE_STRIDE = (size_t)NT_TOK * 16 * 4;

constexpr int LDS_BYTES = 147456;

#define LAS __attribute__((address_space(3)))
typedef unsigned short bf16;
typedef unsigned v4u __attribute__((ext_vector_type(4)));
typedef unsigned v2u __attribute__((ext_vector_type(2)));
typedef float f32x4 __attribute__((ext_vector_type(4)));
typedef float f32x16 __attribute__((ext_vector_type(16)));
typedef short bf16x8 __attribute__((ext_vector_type(8)));
typedef short s16x4 __attribute__((ext_vector_type(4)));
typedef float f32x2 __attribute__((ext_vector_type(2)));

typedef __bf16 bf16x2_t __attribute__((ext_vector_type(2)));
__device__ __forceinline__ unsigned pk2(float lo, float hi) { const f32x2 v = {lo, hi}; return __builtin_bit_cast(unsigned, __builtin_convertvector(v, bf16x2_t)); }
__device__ __forceinline__ float bflo(unsigned w) { return __builtin_bit_cast(float, w << 16); }
__device__ __forceinline__ float bfhi(unsigned w) { return __builtin_bit_cast(float, w & 0xffff0000u); }
__device__ __forceinline__ float wave_sum(float v) {
#pragma unroll
    for (int o = 1; o < 64; o <<= 1) v += __shfl_xor(v, o);
    return v;
}

struct Args { const float* in[14]; float* out; unsigned char* ws; int ph_lo, ph_hi; };

struct Frame {
    LAS unsigned char* lds; unsigned char* lds_g;
    int tid, lane, wave, vcu, G;
    const float *xp, *xs, *norm1_g, *w_in, *a_out_g, *b_out_g, *sink, *w_out, *norm2_g, *w_pq, *sub_keys, *expert_u, *expert_v, *normf_g;
    float* out; unsigned char* ws;
};


#define XB_TMO      128
#define XB_XCNT(j)  (256  + 64 * (j))
#define XB_XSUB(j)  (1280 + 64 * (j))
#define XB_XGEN(j)  (2304 + 64 * (j))
#define XB_TOP      3328
#define XB_TOPGEN   3392
#define XCD_BAR_WORDS 3456
#define XB_SPIN_CAP (1u << 22)
__device__ __forceinline__ unsigned xb_ld(unsigned* p)              { return __hip_atomic_load(p, __ATOMIC_RELAXED, __HIP_MEMORY_SCOPE_AGENT); }
__device__ __forceinline__ unsigned xb_add(unsigned* p, unsigned v) { return __hip_atomic_fetch_add(p, v, __ATOMIC_RELAXED, __HIP_MEMORY_SCOPE_AGENT); }
__device__ __forceinline__ unsigned xb_xcc_id() { return (unsigned)__builtin_amdgcn_s_getreg((3 << 11) | 20) & 0xFu; }
#define XB_SPIN(cond, bar) do { unsigned _sp = 0; while (cond) { __builtin_amdgcn_s_sleep(8); \
    if ((++_sp & 255u) == 0u) { if (xb_ld(&(bar)[XB_TMO])) break; if (_sp > XB_SPIN_CAP) { atomicAdd(&(bar)[XB_TMO], 1u); break; } } } } while (0)
struct XcdBarrier { unsigned* bar; unsigned x; volatile LAS unsigned* st; };
__device__ __forceinline__ XcdBarrier xcd_barrier_post(unsigned* bar, volatile LAS unsigned* st) {
    XcdBarrier b; b.bar = bar; b.x = xb_xcc_id(); b.st = st;
    if (threadIdx.x == 0) st[2] = xb_add(&bar[XB_XCNT(b.x)], 1u);
    return b;
}
__device__ __forceinline__ void xcd_barrier_complete(unsigned* bar, unsigned x, unsigned& nloc, unsigned& nx) {
    const unsigned G = gridDim.x * gridDim.y * gridDim.z;
    unsigned sum, cnt, mine, sp = 0u;
    for (;;) {
        sum = 0u; cnt = 0u; mine = 0u;
#pragma unroll
        for (unsigned j = 0; j < 16; ++j) { const unsigned c = xb_ld(&bar[XB_XCNT(j)]); sum += c; cnt += (c > 0u) ? 1u : 0u; mine = (j == x) ? c : mine; }
        if (sum == G) break;
        __builtin_amdgcn_s_sleep(1);
        if ((++sp & 255u) == 0u) { if (xb_ld(&bar[XB_TMO])) break; if (sp > XB_SPIN_CAP) { atomicAdd(&bar[XB_TMO], 1u); break; } }
    }
    nloc = mine > 0u ? mine : 1u; nx = cnt > 0u ? cnt : 1u;
}
__device__ __forceinline__ void xcd_barrier(const XcdBarrier& b) {
    asm volatile("s_waitcnt vmcnt(0)" ::: "memory");
    __syncthreads();
    if (threadIdx.x == 0) {
        unsigned* bar = b.bar;
        __builtin_amdgcn_s_waitcnt(0);
        unsigned nloc = b.st[0], nx = b.st[1];
        if (nloc == 0u) { xcd_barrier_complete(bar, b.x, nloc, nx); b.st[0] = nloc; b.st[1] = nx; }
        const unsigned old = xb_add(&bar[XB_XSUB(b.x)], 1u);
        const unsigned gen = old / nloc;
        if (old + 1u == (gen + 1u) * nloc) {
            __builtin_amdgcn_fence(__ATOMIC_RELEASE, "agent");
            asm volatile("s_waitcnt vmcnt(0)" ::: "memory");
            const unsigned og = xb_add(&bar[XB_TOP], 1u);
            const unsigned tg = og / nx;
            if (og + 1u == (tg + 1u) * nx) xb_add(&bar[XB_TOPGEN], 1u);
            else XB_SPIN(xb_ld(&bar[XB_TOPGEN]) == tg, bar);
            __builtin_amdgcn_fence(__ATOMIC_ACQUIRE, "agent");
            xb_add(&bar[XB_XGEN(b.x)], 1u);
            asm volatile("s_waitcnt vmcnt(0)" ::: "memory");
        } else {
            XB_SPIN(xb_ld(&bar[XB_XGEN(b.x)]) == gen, bar);
            __builtin_amdgcn_fence(__ATOMIC_ACQUIRE, "agent");
            asm volatile("s_waitcnt vmcnt(0)" ::: "memory");
        }
    }
    __syncthreads();
}
constexpr int MISC_OFF = 131072 + 320;

template <bool HASKS>
__device__ __forceinline__ void p0_transpose_item(const float* W, int K, int N, bf16* WT, const float* kscale, LAS float* scr, int item, int lane) {
    const int nblk = N / 32, kb = item / nblk, nb = item % nblk, k0 = 64 * kb, n0 = 32 * nb;
#pragma unroll 32
    for (int i = 0; i < 32; ++i) { const int kk = 2 * i + (lane >> 5); float v = W[(size_t)(k0 + kk) * N + n0 + (lane & 31)]; if (HASKS) v *= kscale[k0 + kk]; scr[kk * 33 + (lane & 31)] = v; }
    asm volatile("s_waitcnt lgkmcnt(0)" ::: "memory");
    const int c = lane & 7;
#pragma unroll
    for (int j = 0; j < 4; ++j) { const int n = (lane >> 3) + 8 * j; const LAS float* s = scr + (8 * c) * 33 + n;
        v4u o; o.x = pk2(s[0 * 33], s[1 * 33]); o.y = pk2(s[2 * 33], s[3 * 33]); o.z = pk2(s[4 * 33], s[5 * 33]); o.w = pk2(s[6 * 33], s[7 * 33]);
        *(v4u*)(WT + (size_t)(n0 + n) * K + k0 + 8 * c) = o; }
    asm volatile("s_waitcnt lgkmcnt(0)" ::: "memory");
}
template <int NN, bool HASKS>
__device__ __forceinline__ void p1_quant_w(Frame& F, const float* W, const float* kscale, const float* cmax, unsigned char* WQ, float* SW) {
    LAS float* scr = (LAS float*)(F.lds + F.wave * 16384);
    const int gw = F.vcu * NWAVES + F.wave, NGW = F.G * NWAVES, lane = fresh_lane();
    constexpr int NITEM = (DM / 64) * (NN / 32);
    for (int item = gw; item < NITEM; item += NGW) {
        const int nblk = NN / 32, kb = item / nblk, nb = item % nblk, k0 = 64 * kb, n0 = 32 * nb;
        const float cm = cmax[n0 + (lane & 31)]; const float inv = cm > 0.f ? 127.0f / cm : 0.f;
#pragma unroll 32
        for (int i = 0; i < 32; ++i) { const int kk = 2 * i + (lane >> 5); float v = W[(size_t)(k0 + kk) * NN + n0 + (lane & 31)] * inv; if (HASKS) v *= kscale[k0 + kk]; scr[kk * 33 + (lane & 31)] = v; }
        asm volatile("s_waitcnt lgkmcnt(0)" ::: "memory");
        const int c = lane & 3;
#pragma unroll
        for (int j = 0; j < 2; ++j) { const int n = (lane >> 2) + 16 * j; const LAS float* s = scr + (16 * c) * 33 + n; v4u o;
#pragma unroll
            for (int q = 0; q < 4; ++q) { unsigned w = 0;
#pragma unroll
                for (int e = 0; e < 4; ++e) w |= ((unsigned)(int)__builtin_rintf(s[(4 * q + e) * 33]) & 0xffu) << (8 * e);
                o[q] = w; }
            *(v4u*)(WQ + (size_t)(n0 + n) * DM + k0 + 16 * c) = o; }
        if (kb == 0 && lane < 32) SW[n0 + lane] = cm > 0.f ? cm * (1.0f / 127.0f) : 1.0f;
        asm volatile("s_waitcnt lgkmcnt(0)" ::: "memory");
    }
}
__device__ __forceinline__ void p0_prep(Frame& F) {
    LAS float* scr = (LAS float*)(F.lds + F.wave * 16384);
    const int gw = F.vcu * NWAVES + F.wave, NGW = F.G * NWAVES, lane = fresh_lane();
    bf16* WinT = (bf16*)(F.ws + WS_WIN); bf16* WpqT = (bf16*)(F.ws + WS_WPQ);
    constexpr int I_IN = (DM / 64) * (INW / 32), I_OUT = (DM / 64) * (DM / 32), I_PQ = I_OUT;
    for (int it = gw; it < I_IN + I_OUT + I_PQ; it += NGW) {
        int r = it;
#define P0_CMAX_ITEM(W, KS, CM, HASKS) P0_CMAX_ITEM_N(W, KS, CM, DM, HASKS)
#define P0_CMAX_ITEM_N(W, KS, CM, NN, HASKS) do { const int nblk_ = (NN) / 32, kb_ = r / nblk_, nb_ = r % nblk_; float mx_ = 0.f; \
            _Pragma("unroll 32") for (int i_ = 0; i_ < 32; ++i_) { const int k_ = 64 * kb_ + 2 * i_ + (lane >> 5); float v_ = (W)[(size_t)k_ * (NN) + 32 * nb_ + (lane & 31)]; if (HASKS) v_ *= ((const float*)(KS))[k_]; mx_ = fmaxf(mx_, fabsf(v_)); } \
            mx_ = fmaxf(mx_, __shfl_xor(mx_, 32)); \
            if (lane < 32) atomicMax((unsigned*)(F.ws + (CM)) + 32 * nb_ + lane, __builtin_bit_cast(unsigned, mx_)); } while (0)
#if P1_I8
        if (r < I_IN) { P0_CMAX_ITEM_N(F.w_in, (const float*)nullptr, WS_CMAX_IN, INW, 0); continue; } r -= I_IN;
#else
        if (r < I_IN) { p0_transpose_item<false>(F.w_in, DM, INW, WinT, nullptr, scr, r, lane); continue; } r -= I_IN;
#endif
#if P4_I8
        if (r < I_OUT) { P0_CMAX_ITEM(F.w_out, (const float*)nullptr, WS_CMAX, 0); continue; } r -= I_OUT;
#else
        if (r < I_OUT) { p0_transpose_item<false>(F.w_out, DM, DM, (bf16*)(F.ws + WS_WOUT), nullptr, scr, r, lane); continue; } r -= I_OUT;
#endif
#if P5_I8
        P0_CMAX_ITEM(F.w_pq, F.norm2_g, WS_CMAX2, 1); continue;
#endif
#if !P5_I8
        p0_transpose_item<true>(F.w_pq, DM, DM, WpqT, F.norm2_g, scr, r, lane);
#endif
    }
    { bf16* SK = (bf16*)(F.ws + WS_SK);
      for (int i = gw * 64 + lane; i < 65536; i += NGW * 64) { const f32x4 v = ((const f32x4*)F.sub_keys)[i]; v2u o; o.x = pk2(v[0], v[1]); o.y = pk2(v[2], v[3]); ((v2u*)SK)[i] = o; } }
    { unsigned char* U = F.ws + WS_U; unsigned char* V = F.ws + WS_V; float* US = (float*)(F.ws + WS_US); float* VS = (float*)(F.ws + WS_VS);
      float g2[32];
#pragma unroll
      for (int j = 0; j < 2; ++j)
#pragma unroll
          for (int q = 0; q < 4; ++q) { const f32x4 t = *(const f32x4*)(F.norm2_g + 1024 * j + 16 * lane + 4 * q); g2[16 * j + 4 * q] = t[0]; g2[16 * j + 4 * q + 1] = t[1]; g2[16 * j + 4 * q + 2] = t[2]; g2[16 * j + 4 * q + 3] = t[3]; }
#define P0_ROWSRC(row) (((row) < 16384 ? F.expert_u + (size_t)(row) * DM : F.expert_v + (size_t)((row) - 16384) * DM) + 16 * lane)
      f32x4 cur[8], nxt[8];
#define P0_ROWOF(n) ((((n) >> 4) * NGW + gw) * 16 + ((n) & 15))
      if (!TAB_P2 && gw < 2048) { const float* s0 = P0_ROWSRC(P0_ROWOF(0));
#pragma unroll
          for (int q = 0; q < 8; ++q) cur[q] = *(const f32x4*)(s0 + 1024 * (q >> 2) + 4 * (q & 3)); }
#pragma unroll 1
      for (int n = 0; !TAB_P2 && P0_ROWOF(n) < 32768; ++n) {
          const int row = P0_ROWOF(n);
          const bool isu = row < 16384; const int e = isu ? row : row - 16384;
          unsigned char* dst = (isu ? U : V) + (size_t)e * 128;
          { const int rn = (P0_ROWOF(n + 1) < 32768) ? P0_ROWOF(n + 1) : row; const float* sn = P0_ROWSRC(rn);
#pragma unroll
            for (int q = 0; q < 8; ++q) nxt[q] = *(const f32x4*)(sn + 1024 * (q >> 2) + 4 * (q & 3)); }
          float v[32]; float am = 0.f;
#pragma unroll
          for (int q = 0; q < 8; ++q)
#pragma unroll
              for (int c = 0; c < 4; ++c) { float x = cur[q][c]; if (isu) x *= g2[4 * q + c]; v[4 * q + c] = x; am = fmaxf(am, fabsf(x)); }
#pragma unroll
          for (int o = 1; o < 64; o <<= 1) am = fmaxf(am, __shfl_xor(am, o));
          const float inv = am > 0.f ? 127.0f / am : 0.f;
#pragma unroll
          for (int j = 0; j < 2; ++j) { v4u o;
#pragma unroll
              for (int q = 0; q < 4; ++q) { unsigned w = 0;
#pragma unroll
                  for (int c = 0; c < 4; ++c) { const int qi = (int)__builtin_rintf(v[16 * j + 4 * q + c] * inv); w |= ((unsigned)qi & 0xffu) << (8 * c); }
                  o[q] = w; }
#if P7A_INV
              if (isu) { const int cidx = lane + 64 * j;
                  *(v4u*)(U + (size_t)(cidx >> 4) * (1024 * 4096) + (size_t)(e >> 4) * 4096 + ((cidx & 15) >> 2) * 1024 + (((cidx & 3) << 4) + (e & 15)) * 16) = o; }
              else
#endif
              *(v4u*)(dst + (size_t)((lane >> 3) + 8 * j) * (16384 * 128) + 16 * (lane & 7)) = o; }
          if (lane == 0) (isu ? US : VS)[e] = am > 0.f ? am * (1.0f / 127.0f) : 1.0f;
#pragma unroll
          for (int q = 0; q < 8; ++q) cur[q] = nxt[q]; }
#undef P0_ROWSRC
#undef P0_ROWOF
    }
    { bf16* XN = (bf16*)(F.ws + WS_XN);
#define P0_XROW(t) (((t) < NPROMPT ? F.xp + (size_t)(t) * DM : F.xs + (size_t)((t) - NPROMPT) * DM) + 8 * lane)
      f32x4 cur[4][2], nxt[4][2], g1a[4], g1b[4];
#pragma unroll
      for (int j = 0; j < 4; ++j) { g1a[j] = *(const f32x4*)(F.norm1_g + 512 * j + 8 * lane); g1b[j] = *(const f32x4*)(F.norm1_g + 512 * j + 8 * lane + 4); }
      if (gw < NT_TOK) { const float* x0 = P0_XROW(gw);
#pragma unroll
          for (int j = 0; j < 4; ++j) { cur[j][0] = *(const f32x4*)(x0 + 512 * j); cur[j][1] = *(const f32x4*)(x0 + 512 * j + 4); } }
#pragma unroll 1
      for (int t = gw; t < NT_TOK; t += NGW) {
          { const int tn = (t + NGW < NT_TOK) ? t + NGW : t; const float* xn_ = P0_XROW(tn);
#pragma unroll
            for (int j = 0; j < 4; ++j) { nxt[j][0] = *(const f32x4*)(xn_ + 512 * j); nxt[j][1] = *(const f32x4*)(xn_ + 512 * j + 4); } }
          float s = 0.f;
#pragma unroll
          for (int j = 0; j < 4; ++j)
#pragma unroll
              for (int q = 0; q < 2; ++q) s += (cur[j][q][0] * cur[j][q][0] + cur[j][q][1] * cur[j][q][1]) + (cur[j][q][2] * cur[j][q][2] + cur[j][q][3] * cur[j][q][3]);
          const float rstd = 1.0f / sqrtf(wave_sum(s) * (1.0f / DM) + RMS_EPS);
#if P5_I8 == 2
          if (lane == 0) ((float*)(F.ws + WS_SX2))[t] = 6.0f / (127.0f * rstd);
#endif
#if P1_I8
          f32x4 xa[4], xb4[4]; float am = 0.f;
#pragma unroll
          for (int j = 0; j < 4; ++j) { const f32x4 ga = g1a[j], gb = g1b[j];
              xa[j] = cur[j][0] * rstd * ga; xb4[j] = cur[j][1] * rstd * gb;
#pragma unroll
              for (int c = 0; c < 4; ++c) am = fmaxf(am, fmaxf(fabsf(xa[j][c]), fabsf(xb4[j][c]))); }
#pragma unroll
          for (int o = 1; o < 64; o <<= 1) am = fmaxf(am, __shfl_xor(am, o));
          const float inv = am > 0.f ? 127.0f / am : 0.f;
#pragma unroll
          for (int j = 0; j < 4; ++j) { v2u o; unsigned w0 = 0, w1 = 0;
#pragma unroll
              for (int c = 0; c < 4; ++c) { w0 |= ((unsigned)(int)__builtin_rintf(xa[j][c] * inv) & 0xffu) << (8 * c); w1 |= ((unsigned)(int)__builtin_rintf(xb4[j][c] * inv) & 0xffu) << (8 * c); }
              o.x = w0; o.y = w1; *(v2u*)((unsigned char*)XN + (size_t)t * DM + 512 * j + 8 * lane) = o; }
          if (lane == 0) ((float*)(F.ws + WS_SXN))[t] = am > 0.f ? am * (1.0f / 127.0f) : 1.0f;
#else
#pragma unroll
          for (int j = 0; j < 4; ++j) { const f32x4 ga = g1a[j], gb = g1b[j];
              const f32x4 a = cur[j][0] * rstd * ga, b = cur[j][1] * rstd * gb;
              v4u o; o.x = pk2(a[0], a[1]); o.y = pk2(a[2], a[3]); o.z = pk2(b[0], b[1]); o.w = pk2(b[2], b[3]);
              *(v4u*)(XN + (size_t)t * DM + 512 * j + 8 * lane) = o; }
#endif
#pragma unroll
          for (int j = 0; j < 4; ++j) { cur[j][0] = nxt[j][0]; cur[j][1] = nxt[j][1]; } }
#undef P0_XROW
    }
}

constexpr int ATT_KOFF = 0, ATT_VOFF = 65536;
struct AttU { int valid, isB, p, rowbase, Lsub, r, d, q0, kcol, vcol, qcol, head, nh; };
__device__ __forceinline__ AttU att_decode_b(int gb, int kvh, int qp) {
    AttU u; u.valid = 1; u.isB = 1; u.p = 0; u.rowbase = gb < 64 ? (gb >> 4) * 4096 : NPROMPT; u.Lsub = gb < 64 ? 4096 : 8192; u.r = 0; u.d = 1; u.q0 = 256 * (gb < 64 ? (gb & 15) : (gb - 64));
    u.kcol = 4096 + kvh * 64; u.vcol = 4352 + kvh * 64; u.head = kvh * 4 + qp * 2; u.qcol = 3072 + u.head * 64; u.nh = 2; return u;
}
__device__ __forceinline__ AttU att_decode_a(int p, int head, int gb) {
    AttU u; const int d = p == 0 ? 1 : (p == 1 ? 4 : 16); const int L = gb < 64 ? 4096 : 8192; const int idx = gb < 64 ? (gb & 15) : (gb - 64);
    u.valid = 1; u.isB = 0; u.p = p; u.rowbase = gb < 64 ? (gb >> 4) * 4096 : NPROMPT; u.Lsub = L / d; u.r = idx % d; u.d = d; u.q0 = 256 * (idx / d);
    u.kcol = 1024 + head * 64; u.vcol = 2048 + head * 64; u.head = head; u.qcol = head * 64; u.nh = 1; return u;
}
__device__ __forceinline__ AttU att_unit(int vcu, int G, int k) {
    AttU u; u.valid = 0;
    if (G == 256) {
        if (k >= 21) return u;
        const int x = vcu >> 5, lc = vcu & 31;
        if (k < 3) { const int gB = x * 3 + k, rg = gB % 6, kvh = gB / 6; return att_decode_b(16 * rg + (lc >> 1), kvh, lc & 1); }
        const int t = (k - 3) / 3, j = (k - 3) % 3, gp = x * 6 + t, uu0 = lc + 32 * j, group = 2 * gp + uu0 / 48, uu = uu0 % 48;
        return att_decode_a(uu / 16, group / 6, 16 * (group % 6) + (uu % 16));
    }
    const int uidx = vcu + k * G;
    if (uidx >= 768 + 4608) return u;
    if (uidx < 768) return att_decode_b(uidx >> 3, (uidx >> 1) & 3, uidx & 1);
    const int a = uidx - 768; return att_decode_a(a / 1536, (a % 1536) / 96, a % 96);
}
template <int HALFW, bool LDSFLAT = false>
__device__ __forceinline__ void att_wave(int lane, int w, const LAS unsigned char* Ks, const LAS unsigned char* Vs, int kp0  , int Lsub,
                                         const bf16x8 (&qf)[4], float slope2, f32x16& o0, f32x16& o1, float& m_out, float& l_out, int jbeg = 0, int jend = 1 + 2 * HALFW / 32) {
    constexpr int NTILE = 1 + 2 * HALFW / 32, JM = HALFW / 32;
    const int ql = lane & 31, hh = lane >> 5;
    o0 = (f32x16){}; o1 = (f32x16){};
    float m = -1e30f, lsum = 0.f;
    const int i15 = lane & 15, G = (lane >> 4) & 1, ql4 = ql - 4 * hh;
    f32x16 CL, CM, CR;
    { const float sq = slope2 * (float)ql;
#pragma unroll
      for (int reg = 0; reg < 16; ++reg) { const float kb_ = slope2 * (float)((reg & 3) + 8 * (reg >> 2) + 4 * hh); CL[reg] = kb_; CR[reg] = -kb_; CM[reg] = -fabsf(kb_ - sq); } }
    const LAS unsigned char* kb = Ks + (LDSFLAT ? 0 : (32 * w + ql) * 128); const int sw = LDSFLAT ? 0 : ((ql >> 1) & 7);
    int koff[4];
#pragma unroll
    for (int ks = 0; ks < 4; ++ks) koff[ks] = LDSFLAT ? 0 : (((2 * ks + hh) ^ sw) << 4);
    const int c0 = (2 * G + ((i15 & 3) >> 1)) ^ (((i15 >> 3) & 1) << 2);
    const LAS unsigned char* vb0 = LDSFLAT ? Vs : Vs + (32 * w + 4 * hh + (i15 >> 2)) * 128 + (i15 & 1) * 8 + (c0 << 4);
    const LAS unsigned char* vb1 = LDSFLAT ? Vs + 64 : Vs + (32 * w + 4 * hh + (i15 >> 2)) * 128 + (i15 & 1) * 8 + ((c0 ^ 4) << 4);
    bf16x8 kf[4];
#pragma unroll
    for (int ks = 0; ks < 4; ++ks) kf[ks] = *(const LAS bf16x8*)(kb + koff[ks]);
#pragma unroll 1
    for (int j = jbeg; j < jend; ++j) {
        const int kt0 = kp0 + 32 * j;
        const int jn = (j + 1 < NTILE) ? j + 1 : j;
        if (!(kt0 + 31 < 0 || kt0 >= Lsub)) {
            s16x4 vlo[2][2], vhi[2][2];
#pragma unroll
            for (int st = 0; st < 2; ++st) {
                vlo[0][st] = __builtin_bit_cast(s16x4, __builtin_amdgcn_ds_read_tr16_b64_v4i16((LAS s16x4*)(vb0 + 4096 * j + 2048 * st)));
                vhi[0][st] = __builtin_bit_cast(s16x4, __builtin_amdgcn_ds_read_tr16_b64_v4i16((LAS s16x4*)(vb0 + 4096 * j + 2048 * st + 1024)));
                vlo[1][st] = __builtin_bit_cast(s16x4, __builtin_amdgcn_ds_read_tr16_b64_v4i16((LAS s16x4*)(vb1 + 4096 * j + 2048 * st)));
                vhi[1][st] = __builtin_bit_cast(s16x4, __builtin_amdgcn_ds_read_tr16_b64_v4i16((LAS s16x4*)(vb1 + 4096 * j + 2048 * st + 1024))); }
            f32x16 s; float cj;
            const float cl = slope2 * (float)(32 * j - HALFW - ql);
            if (j < JM) { s = __builtin_amdgcn_mfma_f32_32x32x16_bf16(kf[0], qf[0], CL, 0, 0, 0); cj = cl; }
            else if (j == JM) { s = __builtin_amdgcn_mfma_f32_32x32x16_bf16(kf[0], qf[0], CM, 0, 0, 0); cj = 0.f; }
            else { s = __builtin_amdgcn_mfma_f32_32x32x16_bf16(kf[0], qf[0], CR, 0, 0, 0); cj = -cl; }
#pragma unroll
            for (int ks = 1; ks < 4; ++ks) s = __builtin_amdgcn_mfma_f32_32x32x16_bf16(kf[ks], qf[ks], s, 0, 0, 0);
#pragma unroll
            for (int ks = 0; ks < 4; ++ks) kf[ks] = *(const LAS bf16x8*)(kb + 4096 * jn + koff[ks]);
            if (j == 0) {
#pragma unroll
                for (int reg = 0; reg < 16; ++reg) s[reg] = ((reg & 3) + 8 * (reg >> 2) >= ql4) ? s[reg] : -INFINITY;
            } else if (j == NTILE - 1) {
#pragma unroll
                for (int reg = 0; reg < 16; ++reg) s[reg] = ((reg & 3) + 8 * (reg >> 2) <= ql4) ? s[reg] : -INFINITY;
            }
            if (kt0 < 0 || kt0 + 31 >= Lsub) {
                const int kq = kt0 + 4 * hh;
#pragma unroll
                for (int reg = 0; reg < 16; ++reg) { const int kpos = kq + (reg & 3) + 8 * (reg >> 2); s[reg] = ((unsigned)kpos < (unsigned)Lsub) ? s[reg] : -INFINITY; }
            }
            float tmax = fmaxf(fmaxf(s[0], s[1]), s[2]);
#pragma unroll
            for (int reg = 3; reg < 15; reg += 2) tmax = fmaxf(fmaxf(tmax, s[reg]), s[reg + 1]);
            tmax = fmaxf(tmax, s[15]) + cj;
            tmax = fmaxf(tmax, __shfl_xor(tmax, 32));
            if (__any(tmax > m + 8.0f)) { const float mnew = fmaxf(m, tmax); const float alpha = __builtin_amdgcn_exp2f(m - mnew); lsum *= alpha; m = mnew;
#pragma unroll
                for (int reg = 0; reg < 16; ++reg) { o0[reg] *= alpha; o1[reg] *= alpha; } }
            const float dd = cj - m;
            f32x2 ps2 = {0.f, 0.f}; const f32x2 dd2 = {dd, dd};
#pragma unroll
            for (int rp = 0; rp < 8; ++rp) { f32x2 t; { const f32x2 in_ = {s[2 * rp], s[2 * rp + 1]}; asm("v_pk_add_f32 %0, %1, %2" : "=v"(t) : "v"(in_), "v"(dd2)); } t[0] = __builtin_amdgcn_exp2f(t[0]); t[1] = __builtin_amdgcn_exp2f(t[1]); s[2 * rp] = t[0]; s[2 * rp + 1] = t[1]; asm("v_pk_add_f32 %0, %1, %2" : "=v"(ps2) : "v"(ps2), "v"(t)); }
            lsum += ps2[0] + ps2[1];
            bf16x8 pf[2];
#pragma unroll
            for (int st = 0; st < 2; ++st) { v4u t; t.x = pk2(s[8 * st + 0], s[8 * st + 1]); t.y = pk2(s[8 * st + 2], s[8 * st + 3]); t.z = pk2(s[8 * st + 4], s[8 * st + 5]); t.w = pk2(s[8 * st + 6], s[8 * st + 7]); pf[st] = __builtin_bit_cast(bf16x8, t); }
#pragma unroll
            for (int st = 0; st < 2; ++st) {
                const bf16x8 v0 = (bf16x8){vlo[0][st][0], vlo[0][st][1], vlo[0][st][2], vlo[0][st][3], vhi[0][st][0], vhi[0][st][1], vhi[0][st][2], vhi[0][st][3]};
                const bf16x8 v1 = (bf16x8){vlo[1][st][0], vlo[1][st][1], vlo[1][st][2], vlo[1][st][3], vhi[1][st][0], vhi[1][st][1], vhi[1][st][2], vhi[1][st][3]};
                o0 = __builtin_amdgcn_mfma_f32_32x32x16_bf16(v0, pf[st], o0, 0, 0, 0);
                o1 = __builtin_amdgcn_mfma_f32_32x32x16_bf16(v1, pf[st], o1, 0, 0, 0); }
        } else {
#pragma unroll
            for (int ks = 0; ks < 4; ++ks) kf[ks] = *(const LAS bf16x8*)(kb + 4096 * jn + koff[ks]);
        }
    }
    lsum += __shfl_xor(lsum, 32);
    m_out = m; l_out = lsum;
}
__device__ __forceinline__ void att_store(bf16* orow, const f32x16& o0, const f32x16& o1, float scale, int hh) {
#pragma unroll
    for (int dt = 0; dt < 2; ++dt)
#pragma unroll
        for (int k = 0; k < 4; k += 2) {
            const f32x16& o = dt ? o1 : o0;
            const unsigned ax = pk2(o[4 * k] * scale, o[4 * k + 1] * scale), ay = pk2(o[4 * k + 2] * scale, o[4 * k + 3] * scale);
            const unsigned bx = pk2(o[4 * k + 4] * scale, o[4 * k + 5] * scale), by = pk2(o[4 * k + 6] * scale, o[4 * k + 7] * scale);
            const auto sx = __builtin_amdgcn_permlane32_swap(ax, bx, false, false), sy = __builtin_amdgcn_permlane32_swap(ay, by, false, false);
            v4u w; w.x = sx[0]; w.y = sy[0]; w.z = sx[1]; w.w = sy[1];
            *(v4u*)(orow + 32 * dt + 8 * (k + hh)) = w; }
}
__device__ __forceinline__ void tab_load(const Frame& F, int row, int lane, f32x4 (&t)[8]) {
    const float* s0 = (row < 16384 ? F.expert_u + (size_t)row * DM : F.expert_v + (size_t)(row - 16384) * DM) + 16 * lane;
#pragma unroll
    for (int q = 0; q < 8; ++q) t[q] = *(const f32x4*)(s0 + 1024 * (q >> 2) + 4 * (q & 3));
}
__device__ __forceinline__ void tab_finish(const Frame& F, int row, int lane, const f32x4 (&t)[8], const LAS float* gl  ) {
    const bool isu = row < 16384; const int e = isu ? row : row - 16384;
    float v[32]; float am = 0.f;
    if (isu) {
#pragma unroll
        for (int q = 0; q < 8; ++q) { const f32x4 g = *(const LAS f32x4*)(gl + 1024 * (q >> 2) + 16 * lane + 4 * (q & 3));
#pragma unroll
            for (int c = 0; c < 4; ++c) { const float x = t[q][c] * g[c]; v[4 * q + c] = x; am = fmaxf(am, fabsf(x)); } } }
    else {
#pragma unroll
        for (int q = 0; q < 8; ++q)
#pragma unroll
            for (int c = 0; c < 4; ++c) { const float x = t[q][c]; v[4 * q + c] = x; am = fmaxf(am, fabsf(x)); } }
#pragma unroll
    for (int o = 1; o < 64; o <<= 1) am = fmaxf(am, __shfl_xor(am, o));
    const float inv = am > 0.f ? 127.0f / am : 0.f;
    unsigned char* U = F.ws + WS_U; unsigned char* V = F.ws + WS_V;
#pragma unroll
    for (int j = 0; j < 2; ++j) { v4u o;
#pragma unroll
        for (int q = 0; q < 4; ++q) { unsigned w = 0;
#pragma unroll
            for (int c = 0; c < 4; ++c) { const int qi = (int)__builtin_rintf(v[16 * j + 4 * q + c] * inv); w |= ((unsigned)qi & 0xffu) << (8 * c); }
            o[q] = w; }
        if (isu) { const int cidx = lane + 64 * j;
            *(v4u*)(U + (size_t)(cidx >> 4) * (1024 * 4096) + (size_t)(e >> 4) * 4096 + ((cidx & 15) >> 2) * 1024 + (((cidx & 3) << 4) + (e & 15)) * 16) = o; }
        else *(v4u*)(V + (size_t)e * 128 + (size_t)((lane >> 3) + 8 * j) * (16384 * 128) + 16 * (lane & 7)) = o; }
    if (lane == 0) ((float*)(F.ws + (isu ? WS_US : WS_VS)))[e] = am > 0.f ? am * (1.0f / 127.0f) : 1.0f;
}
template <int MODE  >
__device__ __forceinline__ void p2_attention(Frame& F) {
    const bf16* proj = (const bf16*)(F.ws + WS_PROJ);
    bf16* OB = (bf16*)(F.ws + WS_XN + (MODE >= 2 ? 48 * MiB : 0));
    unsigned char* outb = (unsigned char*)F.out;
    const int w = F.wave;
    static_assert(P1_I8 == 1, "the attention phase reads the head-major projection buffer that only the int8 in-projection epilogue writes");
#define ATT_LOADKV(U) do { const int nk_ = (U).isB ? 512 : 384, iv0_ = (U).q0 - ((U).isB ? 128 : 64); \
        _Pragma("unroll") for (int it_ = 0; it_ < 8; ++it_) { const int idx_ = tid + it_ * NTHREADS, row_ = idx_ >> 3, ch_ = idx_ & 7, i_ = iv0_ + row_; const bool ok_ = (row_ < nk_) && (i_ >= 0) && (i_ < (U).Lsub); \
            const size_t to_ = (size_t)((U).rowbase + (U).r + (U).d * (ok_ ? i_ : 0)) * 64 + ch_ * 8;     \
            kk[it_] = ok_ ? *(const v4u*)(proj + (size_t)((U).kcol >> 6) * ((size_t)NT_TOK * 64) + to_) : (v4u){0u, 0u, 0u, 0u}; vv[it_] = ok_ ? *(const v4u*)(proj + (size_t)((U).vcol >> 6) * ((size_t)NT_TOK * 64) + to_) : (v4u){0u, 0u, 0u, 0u}; } } while (0)
#define ATT_WRITEKV(U) do { const int nk_ = (U).isB ? 512 : 384; const int row0_ = tid >> 3, ch_ = tid & 7;     \
        LAS unsigned char* kb_ = F.lds + ATT_KOFF + row0_ * 128 + ((ch_ ^ ((row0_ >> 1) & 7)) << 4); LAS unsigned char* vb_ = F.lds + ATT_VOFF + row0_ * 128 + ((ch_ ^ (((row0_ >> 1) & 1) << 2)) << 4); \
        _Pragma("unroll") for (int it_ = 0; it_ < 8; ++it_) { if (row0_ + 64 * it_ < nk_) { *(LAS v4u*)(kb_ + 8192 * it_) = kk[it_]; *(LAS v4u*)(vb_ + 8192 * it_) = vv[it_]; } } } while (0)
#define ATT_QLOAD(dst, U, h) do { const int tok_ = (U).rowbase + (U).r + (U).d * ((U).q0 + 32 * w + ql); const bf16* qp_ = proj + (size_t)(((U).qcol >> 6) + (h)) * ((size_t)NT_TOK * 64) + (size_t)tok_ * 64 + 8 * hh; \
        _Pragma("unroll") for (int ks_ = 0; ks_ < 4; ++ks_) dst[ks_] = *(const bf16x8*)(qp_ + 16 * ks_); } while (0)
    v4u kk[8], vv[8];
    const LAS unsigned char* Ks = F.lds + ATT_KOFF; const LAS unsigned char* Vs = F.lds + ATT_VOFF;
    const int gwt = F.vcu * NWAVES + w, NGWT = F.G * NWAVES; int kdone = 0;
    const LAS float* gl = (const LAS float*)(F.lds + 131072 + 1024);
#define TAB_VW(s) (gwt + ((s) >> 4) * NGWT)
#define TAB_ROW(s) ((((s) & 8) ? 16384 : 0) + (TAB_VW(s) >> 1) * 16 + (TAB_VW(s) & 1) * 8 + ((s) & 7))
    if (TAB_P2 && MODE == 0) { const int t_ = w * 64 + fresh_lane(); *(LAS f32x4*)(F.lds + 131072 + 1024 + t_ * 16) = *(const f32x4*)(F.norm2_g + t_ * 4); __syncthreads(); }
#pragma unroll 1
    for (int k = 0;; ++k) {
        const AttU cur = att_unit(F.vcu, F.G, k);
        if (!cur.valid) break;
        const int lane = fresh_lane();
        const int ql = lane & 31, hh = lane >> 5, tid = w * 64 + lane;
        bf16x8 qc[4];
        if (MODE == 0) ATT_QLOAD(qc, cur, 0);
        if (TAB_P2 && MODE == 0 && TAB_VW(k) < 2048) {
            f32x4 trow[8]; const int row = TAB_ROW(k);
            tab_load(F, row, lane, trow);
            __syncthreads();
            ATT_LOADKV(cur); tab_finish(F, row, lane, trow, gl); ATT_WRITEKV(cur);
        } else {
            __syncthreads();
            if (MODE < 2) { ATT_LOADKV(cur); ATT_WRITEKV(cur); }
        }
        __syncthreads();
        kdone = k + 1;
        if (MODE == 1) continue;
#pragma unroll 1
        for (int h = 0; h < cur.nh; ++h) {
            if (MODE == 4) { const bf16* qp_ = proj + (size_t)ql * INW + 8 * hh;
#pragma unroll
                for (int ks_ = 0; ks_ < 4; ++ks_) qc[ks_] = *(const bf16x8*)(qp_ + 16 * ks_); }
            else if (MODE != 0 || h > 0) ATT_QLOAD(qc, cur, h);
            const int ln = lane;
            f32x16 o0, o1; float m, l;
            if (cur.isB) {
                const int hq = cur.head + h;
                const float slope = exp2f(-0.5f * (float)(hq + 1));
                att_wave<128, MODE == 6>(ln, w, Ks, Vs, cur.q0 - 128 + 32 * w, cur.Lsub, qc, slope * LOG2E, o0, o1, m, l, MODE == 5 ? 4 : 0, MODE == 5 ? 5 : 9);
                const int l2 = fresh_lane(), hh2 = l2 >> 5; const int tok0_ = cur.rowbase + cur.r + cur.d * (cur.q0 + 32 * w + (l2 & 31)); const int tok = (MODE >= 2) ? (tok0_ & 255) : tok0_;
                const float sk2 = F.sink[hq] * LOG2E; const float mf = fmaxf(m, sk2);
                const float sc = __builtin_amdgcn_exp2f(m - mf); const float den = l * sc + __builtin_amdgcn_exp2f(sk2 - mf);
                if (MODE >= 3) { const float z_ = sc / den; asm volatile("" :: "v"(o0), "v"(o1), "v"(z_)); }
                else att_store(OB + (size_t)tok * 1024 + hq * 64, o0, o1, sc / den, hh2);
            } else {
                const float slope = exp2f(-0.25f * (float)(2 * cur.head + 1));
                att_wave<64, MODE == 6>(ln, w, Ks, Vs, cur.q0 - 64 + 32 * w, cur.Lsub, qc, slope * (float)cur.d * LOG2E, o0, o1, m, l, MODE == 5 ? 2 : 0, MODE == 5 ? 3 : 5);
                const int l2 = fresh_lane(), hh2 = l2 >> 5; const int tok0_ = cur.rowbase + cur.r + cur.d * (cur.q0 + 32 * w + (l2 & 31)); const int tok = (MODE >= 2) ? (tok0_ & 255) : tok0_;
                bf16* OA = (MODE >= 2) ? (bf16*)(outb + 150 * MiB) : (bf16*)(outb + OUT_OA + (size_t)cur.p * OUT_OA_STRIDE);
                float* LSE = (MODE >= 2) ? (float*)(outb + 152 * MiB) : (float*)(outb + OUT_LSE + (size_t)cur.p * OUT_LSE_STRIDE);
                if (MODE >= 3) { const float z_ = m + l; asm volatile("" :: "v"(o0), "v"(o1), "v"(z_)); }
                else { att_store(OA + (size_t)tok * 1024 + cur.head * 64, o0, o1, 1.0f / l, hh2);
                    if (hh2 == 0) LSE[(size_t)tok * 16 + cur.head] = m + __builtin_amdgcn_logf(l); }
            }
        }
    }
#undef ATT_LOADKV
#undef ATT_WRITEKV
#undef ATT_QLOAD
    if (TAB_P2 && MODE == 0) {
        const int lane = fresh_lane();
#pragma unroll 1
        for (int n = kdone; TAB_VW(n) < 2048; ++n) { f32x4 trow[8]; tab_load(F, TAB_ROW(n), lane, trow); tab_finish(F, TAB_ROW(n), lane, trow, gl); } }
#undef TAB_VW
#undef TAB_ROW
    __syncthreads();
}

__device__ __forceinline__ void p3_finalize(Frame& F) {
    const int gw = F.vcu * NWAVES + F.wave, NGW = F.G * NWAVES, lane = fresh_lane();
    const unsigned char* outb = (const unsigned char*)F.out;
    const bf16* OB = (const bf16*)(F.ws + WS_XN);
    unsigned char* MIXQ = F.ws + WS_MIXED; float* SA = (float*)(F.ws + WS_SA); bf16* MIXED = (bf16*)(F.ws + WS_MIXED); (void)MIXQ; (void)SA; (void)MIXED;
    const int head = lane >> 2;
    f32x4 gaq[4], gbq[4];
#pragma unroll
    for (int q = 0; q < 4; ++q) { gaq[q] = *(const f32x4*)(F.a_out_g + 16 * lane + 4 * q); gbq[q] = *(const f32x4*)(F.b_out_g + 16 * lane + 4 * q); }
    for (int t = gw; t < NT_TOK; t += NGW) {
        float ls[3]; v4u oa[3][2];
#pragma unroll
        for (int p = 0; p < 3; ++p) { ls[p] = ((const float*)(outb + OUT_LSE + (size_t)p * OUT_LSE_STRIDE))[(size_t)t * 16 + head];
            const v4u* src = (const v4u*)((const bf16*)(outb + OUT_OA + (size_t)p * OUT_OA_STRIDE) + (size_t)t * 1024 + 16 * lane); oa[p][0] = src[0]; oa[p][1] = src[1]; }
        const v4u* sb = (const v4u*)(OB + (size_t)t * 1024 + 16 * lane); const v4u ob0 = sb[0], ob1 = sb[1];
        const float mx = fmaxf(fmaxf(ls[0], ls[1]), ls[2]);
        float w0 = __builtin_amdgcn_exp2f(ls[0] - mx), w1 = __builtin_amdgcn_exp2f(ls[1] - mx), w2 = __builtin_amdgcn_exp2f(ls[2] - mx);
        const float inv = 1.0f / (w0 + w1 + w2); w0 *= inv; w1 *= inv; w2 *= inv;
        float a[16], b[16]; float sa = 0.f, sbq = 0.f;
#pragma unroll
        for (int q = 0; q < 2; ++q)
#pragma unroll
            for (int e = 0; e < 4; ++e) {
                const unsigned x0 = oa[0][q][e], x1 = oa[1][q][e], x2 = oa[2][q][e], y = (q == 0 ? ob0 : ob1)[e];
                const float lo = w0 * bflo(x0) + w1 * bflo(x1) + w2 * bflo(x2), hi = w0 * bfhi(x0) + w1 * bfhi(x1) + w2 * bfhi(x2);
                a[q * 8 + e * 2] = lo; a[q * 8 + e * 2 + 1] = hi; sa += lo * lo + hi * hi;
                const float bl = bflo(y), bh = bfhi(y); b[q * 8 + e * 2] = bl; b[q * 8 + e * 2 + 1] = bh; sbq += bl * bl + bh * bh; }
        const float ra = 1.0f / sqrtf(wave_sum(sa) * (1.0f / 1024.0f) + RMS_EPS), rb = 1.0f / sqrtf(wave_sum(sbq) * (1.0f / 1024.0f) + RMS_EPS);
#if P4_I8
        float am = 0.f;
#pragma unroll
        for (int q = 0; q < 2; ++q) {
            const f32x4 ga0 = *(const f32x4*)(F.a_out_g + 16 * lane + 8 * q), ga1 = *(const f32x4*)(F.a_out_g + 16 * lane + 8 * q + 4);
            const f32x4 gb0 = *(const f32x4*)(F.b_out_g + 16 * lane + 8 * q), gb1 = *(const f32x4*)(F.b_out_g + 16 * lane + 8 * q + 4);
#pragma unroll
            for (int e = 0; e < 4; ++e) { a[8 * q + e] *= ra * ga0[e]; a[8 * q + 4 + e] *= ra * ga1[e]; b[8 * q + e] *= rb * gb0[e]; b[8 * q + 4 + e] *= rb * gb1[e];
                am = fmaxf(am, fmaxf(fmaxf(fabsf(a[8 * q + e]), fabsf(a[8 * q + 4 + e])), fmaxf(fabsf(b[8 * q + e]), fabsf(b[8 * q + 4 + e])))); } }
#pragma unroll
        for (int o = 1; o < 64; o <<= 1) am = fmaxf(am, __shfl_xor(am, o));
        const float qinv = am > 0.f ? 127.0f / am : 0.f;
        v4u oa8, ob8;
#pragma unroll
        for (int q = 0; q < 4; ++q) { unsigned wa = 0, wb = 0;
#pragma unroll
            for (int e = 0; e < 4; ++e) { wa |= ((unsigned)(int)__builtin_rintf(a[4 * q + e] * qinv) & 0xffu) << (8 * e); wb |= ((unsigned)(int)__builtin_rintf(b[4 * q + e] * qinv) & 0xffu) << (8 * e); }
            oa8[q] = wa; ob8[q] = wb; }
        *(v4u*)(MIXQ + (size_t)t * DM + 16 * lane) = oa8; *(v4u*)(MIXQ + (size_t)t * DM + 1024 + 16 * lane) = ob8;
        if (lane == 0) SA[t] = am > 0.f ? am * (1.0f / 127.0f) : 1.0f;
#else
        v4u o[2], o2[2];
#pragma unroll
        for (int q = 0; q < 2; ++q) {
            const f32x4 ga0 = gaq[2 * q], ga1 = gaq[2 * q + 1];
            const f32x4 gb0 = gbq[2 * q], gb1 = gbq[2 * q + 1];
            o[q].x = pk2(a[8 * q + 0] * ra * ga0[0], a[8 * q + 1] * ra * ga0[1]); o[q].y = pk2(a[8 * q + 2] * ra * ga0[2], a[8 * q + 3] * ra * ga0[3]);
            o[q].z = pk2(a[8 * q + 4] * ra * ga1[0], a[8 * q + 5] * ra * ga1[1]); o[q].w = pk2(a[8 * q + 6] * ra * ga1[2], a[8 * q + 7] * ra * ga1[3]);
            o2[q].x = pk2(b[8 * q + 0] * rb * gb0[0], b[8 * q + 1] * rb * gb0[1]); o2[q].y = pk2(b[8 * q + 2] * rb * gb0[2], b[8 * q + 3] * rb * gb0[3]);
            o2[q].z = pk2(b[8 * q + 4] * rb * gb1[0], b[8 * q + 5] * rb * gb1[1]); o2[q].w = pk2(b[8 * q + 6] * rb * gb1[2], b[8 * q + 7] * rb * gb1[3]); }
        v4u* dst = (v4u*)(MIXED + (size_t)t * DM + 16 * lane); dst[0] = o[0]; dst[1] = o[1];
        v4u* dst2 = (v4u*)(MIXED + (size_t)t * DM + 1024 + 16 * lane); dst2[0] = o2[0]; dst2[1] = o2[1];
#endif
    }
}

__device__ __forceinline__ int f2key(float v) { const int b = __builtin_bit_cast(int, v); return b ^ ((b >> 31) & 0x7fffffff); }
__device__ __forceinline__ float key2f(int k) { return __builtin_bit_cast(float, k ^ ((k >> 31) & 0x7fffffff)); }
#define P6_CE(x, y) do { const int hi_ = max(x, y), lo_ = min(x, y); x = hi_; y = lo_; } while (0)
__device__ __forceinline__ void p6_sort16(int (&a)[16]) {
    P6_CE(a[0], a[1]); P6_CE(a[3], a[2]); P6_CE(a[4], a[5]); P6_CE(a[7], a[6]); P6_CE(a[8], a[9]); P6_CE(a[11], a[10]); P6_CE(a[12], a[13]); P6_CE(a[15], a[14]); P6_CE(a[0], a[2]); P6_CE(a[1], a[3]); P6_CE(a[6], a[4]); P6_CE(a[7], a[5]); P6_CE(a[8], a[10]); P6_CE(a[9], a[11]); P6_CE(a[14], a[12]); P6_CE(a[15], a[13]); P6_CE(a[0], a[1]); P6_CE(a[2], a[3]); P6_CE(a[5], a[4]); P6_CE(a[7], a[6]); P6_CE(a[8], a[9]); P6_CE(a[10], a[11]); P6_CE(a[13], a[12]); P6_CE(a[15], a[14]); P6_CE(a[0], a[4]); P6_CE(a[1], a[5]); P6_CE(a[2], a[6]); P6_CE(a[3], a[7]); P6_CE(a[12], a[8]); P6_CE(a[13], a[9]); P6_CE(a[14], a[10]); P6_CE(a[15], a[11]); P6_CE(a[0], a[2]); P6_CE(a[1], a[3]); P6_CE(a[4], a[6]); P6_CE(a[5], a[7]); P6_CE(a[10], a[8]); P6_CE(a[11], a[9]); P6_CE(a[14], a[12]); P6_CE(a[15], a[13]); P6_CE(a[0], a[1]); P6_CE(a[2], a[3]); P6_CE(a[4], a[5]); P6_CE(a[6], a[7]); P6_CE(a[9], a[8]); P6_CE(a[11], a[10]); P6_CE(a[13], a[12]); P6_CE(a[15], a[14]); P6_CE(a[0], a[8]); P6_CE(a[1], a[9]); P6_CE(a[2], a[10]); P6_CE(a[3], a[11]); P6_CE(a[4], a[12]); P6_CE(a[5], a[13]); P6_CE(a[6], a[14]); P6_CE(a[7], a[15]); P6_CE(a[0], a[4]); P6_CE(a[1], a[5]); P6_CE(a[2], a[6]); P6_CE(a[3], a[7]); P6_CE(a[8], a[12]); P6_CE(a[9], a[13]); P6_CE(a[10], a[14]); P6_CE(a[11], a[15]); P6_CE(a[0], a[2]); P6_CE(a[1], a[3]); P6_CE(a[4], a[6]); P6_CE(a[5], a[7]); P6_CE(a[8], a[10]); P6_CE(a[9], a[11]); P6_CE(a[12], a[14]); P6_CE(a[13], a[15]); P6_CE(a[0], a[1]); P6_CE(a[2], a[3]); P6_CE(a[4], a[5]); P6_CE(a[6], a[7]); P6_CE(a[8], a[9]); P6_CE(a[10], a[11]); P6_CE(a[12], a[13]); P6_CE(a[14], a[15]);
}
__device__ __forceinline__ void p6_merge16(int (&a)[16]) {
    P6_CE(a[0], a[8]); P6_CE(a[1], a[9]); P6_CE(a[2], a[10]); P6_CE(a[3], a[11]); P6_CE(a[4], a[12]); P6_CE(a[5], a[13]); P6_CE(a[6], a[14]); P6_CE(a[7], a[15]); P6_CE(a[0], a[4]); P6_CE(a[1], a[5]); P6_CE(a[2], a[6]); P6_CE(a[3], a[7]); P6_CE(a[8], a[12]); P6_CE(a[9], a[13]); P6_CE(a[10], a[14]); P6_CE(a[11], a[15]); P6_CE(a[0], a[2]); P6_CE(a[1], a[3]); P6_CE(a[4], a[6]); P6_CE(a[5], a[7]); P6_CE(a[8], a[10]); P6_CE(a[9], a[11]); P6_CE(a[12], a[14]); P6_CE(a[13], a[15]); P6_CE(a[0], a[1]); P6_CE(a[2], a[3]); P6_CE(a[4], a[5]); P6_CE(a[6], a[7]); P6_CE(a[8], a[9]); P6_CE(a[10], a[11]); P6_CE(a[12], a[13]); P6_CE(a[14], a[15]);
}
#undef P6_CE
__device__ __forceinline__ void p6_top16(int (&a)[16], const int (&b)[16]) {
#pragma unroll
    for (int i = 0; i < 16; ++i) a[i] = max(a[i], b[15 - i]);
    p6_merge16(a);
}
__device__ __forceinline__ void p6_top16_partner(int (&a)[16]) {
    int t[16];
#pragma unroll
    for (int i = 0; i < 16; ++i) t[i] = __shfl_xor(a[15 - i], 32);
#pragma unroll
    for (int i = 0; i < 16; ++i) a[i] = max(a[i], t[i]);
    p6_merge16(a);
}
template <bool FROM_LDS>
__device__ __forceinline__ void p6_task(unsigned char* ws, int lane, int h, int tok, const bf16* qrow_g, const LAS unsigned char* qrow_l, int rsw, LAS unsigned char* scr) {
    const int ql = lane & 31, hh = lane >> 5;
    const bf16* SK = (const bf16*)(ws + WS_SK);
    unsigned char* RE16b = ws + WS_RE16; float* RG = (float*)(ws + WS_RG);
    constexpr int INT_MINV = -2147483647 - 1;
    {
        int k1[2][16];
        bf16x8 kfa[1][8];
#define P6_LOADKF(BUF, STEP) do { const bf16* skb_ = SK + (size_t)(h * 2 + ((STEP) >> 2)) * 128 * 128 + (size_t)ql * 128 + 8 * hh + (size_t)((STEP) & 3) * 32 * 128; \
            _Pragma("unroll") for (int ks_ = 0; ks_ < 8; ++ks_) kfa[BUF][ks_] = *(const bf16x8*)(skb_ + 16 * ks_); } while (0)
        P6_LOADKF(0, 0);
#pragma unroll
        for (int p = 0; p < 2; ++p) {
            bf16x8 qf[8];
#pragma unroll
            for (int ks = 0; ks < 8; ++ks) qf[ks] = FROM_LDS ? *(const LAS bf16x8*)(qrow_l + (((16 * p + 2 * ks + hh) ^ rsw) << 4)) : *(const bf16x8*)(qrow_g + p * 128 + 8 * hh + 16 * ks);
            int g0[16], g1[16];
#pragma unroll
            for (int kt = 0; kt < 4; ++kt) { f32x16 s = (f32x16){};
                const int step = 4 * p + kt;
#pragma unroll
                for (int ks = 0; ks < 8; ++ks) s = __builtin_amdgcn_mfma_f32_32x32x16_bf16(kfa[0][ks], qf[ks], s, 0, 0, 0);
                __builtin_amdgcn_sched_barrier(0);
                if (step + 1 < 8) { P6_LOADKF(0, step + 1); }
                __builtin_amdgcn_sched_barrier(0);
                int g[16];
#pragma unroll
                for (int reg = 0; reg < 16; ++reg) { const int n = 32 * kt + (reg & 3) + 8 * (reg >> 2) + 4 * hh; g[reg] = (f2key(s[reg]) & ~127) | n; }
                p6_sort16(g);
                if (kt == 0) {
#pragma unroll
                    for (int i = 0; i < 16; ++i) g0[i] = g[i];
                } else if (kt == 1) p6_top16(g0, g);
                else if (kt == 2) {
#pragma unroll
                    for (int i = 0; i < 16; ++i) g1[i] = g[i];
                } else p6_top16(g1, g);
            }
            p6_top16(g0, g1);
            p6_top16_partner(g0);
#pragma unroll
            for (int i = 0; i < 16; ++i) k1[p][i] = g0[i];
        }
        float v1[16], v2[16];
#pragma unroll
        for (int i = 0; i < 16; ++i) { v1[i] = key2f(k1[0][i] & ~127); v2[i] = key2f(k1[1][i] & ~127); }
        { v4u w;
#pragma unroll
          for (int q = 0; q < 4; ++q) { unsigned x = 0;
#pragma unroll
              for (int c = 0; c < 4; ++c) x |= (unsigned)((hh ? k1[1][4 * q + c] : k1[0][4 * q + c]) & 127) << (8 * c);
              w[q] = x; }
          *(LAS v4u*)(scr + 16 * hh) = w; }
        int ca[16], cb[16];
#define P6_SLOT(k) ((k) < 16 ? ca[(k)] : cb[(k) - 16])
#define P6_CAND(k, Ia, Ja, Ib, Jb) do { const float sa_ = v1[Ia] + v2[Ja], sb_ = v1[Ib] + v2[Jb]; \
            const int key_ = (f2key(hh ? sb_ : sa_) & ~255) | (hh ? ((Ib) << 4 | (Jb)) : ((Ia) << 4 | (Ja))); if ((k) < 16) ca[(k) & 15] = key_; else cb[(k) & 15] = key_; } while (0)
        P6_CAND(0, 0, 0, 0, 1);
        P6_CAND(1, 0, 2, 0, 3);
        P6_CAND(2, 0, 4, 0, 5);
        P6_CAND(3, 0, 6, 0, 7);
        P6_CAND(4, 0, 8, 0, 9);
        P6_CAND(5, 0, 10, 0, 11);
        P6_CAND(6, 0, 12, 0, 13);
        P6_CAND(7, 0, 14, 0, 15);
        P6_CAND(8, 1, 0, 1, 1);
        P6_CAND(9, 1, 2, 1, 3);
        P6_CAND(10, 1, 4, 1, 5);
        P6_CAND(11, 1, 6, 1, 7);
        P6_CAND(12, 2, 0, 2, 1);
        P6_CAND(13, 2, 2, 2, 3);
        P6_CAND(14, 2, 4, 3, 0);
        P6_CAND(15, 3, 1, 3, 2);
        P6_CAND(16, 3, 3, 4, 0);
        P6_CAND(17, 4, 1, 4, 2);
        P6_CAND(18, 5, 0, 5, 1);
        P6_CAND(19, 6, 0, 6, 1);
        P6_CAND(20, 7, 0, 7, 1);
        P6_CAND(21, 8, 0, 9, 0);
        P6_CAND(22, 10, 0, 11, 0);
        P6_CAND(23, 12, 0, 13, 0);
        P6_CAND(24, 14, 0, 15, 0);
#undef P6_CAND
#undef P6_LOADKF
#undef P6_SLOT
#pragma unroll
        for (int i = 9; i < 16; ++i) cb[i] = INT_MINV;
        p6_sort16(ca); p6_sort16(cb); p6_top16(ca, cb); p6_top16_partner(ca);
        asm volatile("s_waitcnt lgkmcnt(0)" ::: "memory");
        float top[16], gs = 0.f;
        const float smax = key2f(ca[0] & ~255);
#pragma unroll
        for (int i = 0; i < 16; ++i) ca[i] = ((ca[i] & 255) << 24) | (int)((unsigned)ca[i] >> 8);
        p6_sort16(ca);
#pragma unroll
        for (int i = 0; i < 16; ++i) ca[i] = (ca[i] << 8) | ((ca[i] >> 24) & 255);
#pragma unroll
        for (int i = 0; i < 16; ++i) { top[i] = key2f(ca[i] & ~255); }
#pragma unroll
        for (int i = 0; i < 16; ++i) { top[i] = __expf(top[i] - smax); gs += top[i]; }
        const float ginv = 1.0f / gs;
        unsigned short* re = (unsigned short*)(RE16b + (size_t)tok * 256) + 2 * h + hh;
        float gq[8];
#pragma unroll
        for (int r = 0; r < 8; ++r) { const int key = hh ? ca[r + 8] : ca[r]; const int ci = (key >> 4) & 15, cj = key & 15;
            const int e = (int)scr[ci] * 128 + (int)scr[16 + cj];
            re[r * 16] = (unsigned short)e; gq[r] = (hh ? top[r + 8] : top[r]) * ginv; }
        float* rg = RG + ((size_t)tok * 8 + h) * 16 + 8 * hh;
        *(f32x4*)rg = (f32x4){gq[0], gq[1], gq[2], gq[3]}; *(f32x4*)(rg + 4) = (f32x4){gq[4], gq[5], gq[6], gq[7]};
        asm volatile("s_waitcnt lgkmcnt(0)" ::: "memory");
    }
}
__device__ __forceinline__ void p6_route(Frame& F) {
    const int gw = F.vcu * NWAVES + F.wave, NGW = F.G * NWAVES, lane = fresh_lane(), ql = lane & 31;
    const bf16* Q = (const bf16*)(F.ws + WS_MIXED);
    LAS unsigned char* scr = F.lds + F.wave * 1024 + ql * 32;
#pragma unroll 1
    for (int task = gw; task < 768 * 8; task += NGW) {
        const int h = task / 768, tile = task % 768, tok = tile * 32 + ql;
        p6_task<false>(F.ws, lane, h, tok, Q + (size_t)tok * DM + h * 256, nullptr, 0, scr);
    }
}
template <bool I8_>
struct EpiRouteT {
    static constexpr bool PERM = true, AFTER_DRAIN = true, I8 = I8_;
    const float* ss; unsigned char* ws; const float* sx; const float* sw;
    __device__ __forceinline__ void fused(typename pg8::AccT<I8_>::type (&acc)[2][2][4][2], const pg8::Unit& u, int wr, int wc, int fr, int fq, LAS unsigned char* lds, int wid, int lane) const {
        LAS float* rsl = (LAS float*)(lds + 131072 + 10240);
        if (lane < 32) { const int r = 32 * wid + lane;
            const f32x4* p = (const f32x4*)(ss + (size_t)(u.pm * 256 + r) * 32); f32x4 v[8];
#pragma unroll
            for (int i = 0; i < 8; ++i) v[i] = p[i];
            float s = 0.f;
#pragma unroll
            for (int i = 0; i < 8; ++i) s += (v[i][0] + v[i][1]) + (v[i][2] + v[i][3]);
            float sc = 1.0f / sqrtf(s * (1.0f / 2048.0f) + 1e-6f);
            if (I8_) sc *= sx[u.pm * 256 + r];
            rsl[r] = sc; }
        asm volatile("s_waitcnt lgkmcnt(0)" ::: "memory"); __builtin_amdgcn_s_barrier(); asm volatile("" ::: "memory");
#pragma unroll
        for (int ai = 0; ai < 2; ++ai)
#pragma unroll
            for (int m = 0; m < 4; ++m) {
                const int r = 128 * ai + 64 * wr + 16 * m + fr;
                const float sc = rsl[r];
#pragma unroll
                for (int bj = 0; bj < 2; ++bj) { f32x4 v0, v1;
                    if constexpr (I8_) { const int cb = u.pn * 256 + 128 * bj + 32 * wc + 8 * fq; const f32x4 w0 = *(const f32x4*)(sw + cb), w1 = *(const f32x4*)(sw + cb + 4);
                        const pg8::i32x4 a0 = acc[ai][bj][m][0], a1 = acc[ai][bj][m][1];
                        v0 = (f32x4){(float)a0[0], (float)a0[1], (float)a0[2], (float)a0[3]} * w0 * sc; v1 = (f32x4){(float)a1[0], (float)a1[1], (float)a1[2], (float)a1[3]} * w1 * sc; }
                    else { v0 = acc[ai][bj][m][0] * sc; v1 = acc[ai][bj][m][1] * sc; }
                    v4u w; w.x = pk2(v0[0], v0[1]); w.y = pk2(v0[2], v0[3]); w.z = pk2(v1[0], v1[1]); w.w = pk2(v1[2], v1[3]);
                    const int c = 16 * bj + 4 * wc + fq;
                    *(LAS v4u*)(lds + r * 512 + ((c ^ (r & 15)) << 4)) = w; } }
        asm volatile("s_waitcnt lgkmcnt(0)" ::: "memory"); __builtin_amdgcn_s_barrier(); asm volatile("" ::: "memory");
        const int ql = lane & 31, rowl = 32 * wid + ql;
        p6_task<true>(ws, lane, u.pn, u.pm * 256 + rowl, nullptr, lds + rowl * 512, rowl & 15, lds + 131072 + 1024 + wid * 1024 + ql * 32);
        asm volatile("s_waitcnt lgkmcnt(0)" ::: "memory"); __builtin_amdgcn_s_barrier(); asm volatile("" ::: "memory");
    }
};


template <int CTRL> __device__ __forceinline__ int dpp_i(int x) { return __builtin_amdgcn_update_dpp(0, x, CTRL, 0xf, 0xf, true); }
__device__ __forceinline__ int red8_add(int v) { v += dpp_i<0xB1>(v); v += dpp_i<0x4E>(v); v += dpp_i<0x141>(v); return v; }
__device__ __forceinline__ float red8_max(float v) {
    v = fmaxf(v, __builtin_bit_cast(float, dpp_i<0xB1>(__builtin_bit_cast(int, v)))); v = fmaxf(v, __builtin_bit_cast(float, dpp_i<0x4E>(__builtin_bit_cast(int, v))));
    v = fmaxf(v, __builtin_bit_cast(float, dpp_i<0x141>(__builtin_bit_cast(int, v)))); return v; }
struct SliceOwn { unsigned n_mine, vx, npop; };
__device__ __forceinline__ SliceOwn slice_census(unsigned* bar, unsigned x) {
    SliceOwn s; s.n_mine = 1u; s.vx = 0u; s.npop = 0u;
#pragma unroll
    for (unsigned j = 0; j < 16; ++j) { const unsigned c = (unsigned)__builtin_amdgcn_readfirstlane((int)xb_ld(&bar[XB_XCNT(j)])); if (c > 0u) { if (j < x) ++s.vx; ++s.npop; } if (j == x) s.n_mine = c > 0u ? c : 1u; }
    if (s.npop == 0u) s.npop = 1u;
    return s;
}
#define P7_EID(R0, R1, i) ((((i) & 1) ? (((i) < 8 ? R0 : R1)[((i) >> 1) & 3] >> 16) : (((i) < 8 ? R0 : R1)[((i) >> 1) & 3] & 0xffffu)))

__device__ __forceinline__ void p7a_udots(Frame& F, unsigned* bar, unsigned x, unsigned rank) {
    const int lane = fresh_lane(), r = lane >> 3, seg = lane & 7;
    const SliceOwn so = slice_census(bar, x);
    const int gwl = (int)rank * NWAVES + F.wave, stride = (int)so.n_mine * NWAVES;
    const bf16* X2B = (const bf16*)(F.ws + WS_X2B); const unsigned char* RE16b = F.ws + WS_RE16;
#pragma unroll 1
    for (int pass = 0; pass < 16; ++pass) {
        const int hs = (2 * (int)so.vx + pass) & 15; if ((unsigned)(hs >> 1) % so.npop != so.vx) continue;
        float* PD = (float*)(F.ws + (hs < 8 ? WS_PD0 : WS_PD1)) + (size_t)(hs & 7) * NT_TOK * 128;
        const unsigned char* Ub = F.ws + WS_U + (size_t)hs * (16384 * 128) + 16 * seg;
        const unsigned char* rp0 = RE16b + r * 32; const bf16* xp0 = X2B + 128 * hs + 16 * seg;
#define P7A_LOADA(R0, R1, X0, X1, t) do { const int tt_ = (t) < NT_TOK ? (t) : NT_TOK - 1; const unsigned char* rp_ = rp0 + (size_t)tt_ * 256; R0 = *(const v4u*)rp_; R1 = *(const v4u*)(rp_ + 16); \
            const bf16* xp_ = xp0 + (size_t)tt_ * DM; X0 = *(const v4u*)xp_; X1 = *(const v4u*)(xp_ + 8); } while (0)
#define P7A_ISSUE(G, R0, R1) do { __builtin_amdgcn_s_setprio(3); _Pragma("unroll") for (int i_ = 0; i_ < 16; ++i_) { const unsigned e_ = P7_EID(R0, R1, i_); G[i_] = *(const v4u*)(Ub + (size_t)e_ * 128); } __builtin_amdgcn_s_setprio(0); } while (0)
#define P7A_COMP(G, X0, X1, t) do { float xf_[16]; float am_ = 0.f; \
            _Pragma("unroll") for (int c_ = 0; c_ < 4; ++c_) { xf_[2 * c_] = bflo(X0[c_]); xf_[2 * c_ + 1] = bfhi(X0[c_]); xf_[8 + 2 * c_] = bflo(X1[c_]); xf_[8 + 2 * c_ + 1] = bfhi(X1[c_]); } \
            _Pragma("unroll") for (int c_ = 0; c_ < 16; ++c_) am_ = fmaxf(am_, fabsf(xf_[c_])); \
            am_ = red8_max(am_); const float inv_ = am_ > 0.f ? 127.0f / am_ : 0.f, hsc_ = am_ * (1.0f / 127.0f); \
            int hq_[4]; _Pragma("unroll") for (int w_ = 0; w_ < 4; ++w_) { unsigned p_ = 0; _Pragma("unroll") for (int c_ = 0; c_ < 4; ++c_) p_ |= ((unsigned)(int)__builtin_rintf(xf_[4 * w_ + c_] * inv_) & 0xffu) << (8 * c_); hq_[w_] = (int)p_; } \
            int res0_ = 0, res1_ = 0; \
            _Pragma("unroll") for (int i_ = 0; i_ < 16; ++i_) { int d_ = 0; _Pragma("unroll") for (int w_ = 0; w_ < 4; ++w_) d_ = __builtin_amdgcn_sdot4((int)G[i_][w_], hq_[w_], d_, false); \
                d_ = red8_add(d_); if ((i_ & 7) == seg) { if (i_ < 8) res0_ = d_; else res1_ = d_; } } \
            if ((t) < NT_TOK) { float* pd_ = PD + (size_t)(t) * 128 + 8 * seg + r; pd_[0] = (float)res0_ * hsc_; pd_[64] = (float)res1_ * hsc_; } } while (0)
        v4u GA[16], GB[16], ra0, ra1, xa0, xa1, rb0, rb1, xb0, xb1, xA0, xA1, xB0, xB1;
        P7A_LOADA(ra0, ra1, xa0, xa1, gwl);
        P7A_LOADA(rb0, rb1, xb0, xb1, gwl + stride);
        P7A_ISSUE(GA, ra0, ra1); xA0 = xa0; xA1 = xa1;
#pragma unroll 1
        for (int t = gwl; t < NT_TOK; t += 2 * stride) {
            P7A_LOADA(ra0, ra1, xa0, xa1, t + 2 * stride); P7A_ISSUE(GB, rb0, rb1); xB0 = xb0; xB1 = xb1; P7A_COMP(GA, xA0, xA1, t);
            P7A_LOADA(rb0, rb1, xb0, xb1, t + 3 * stride); P7A_ISSUE(GA, ra0, ra1); xA0 = xa0; xA1 = xa1; P7A_COMP(GB, xB0, xB1, t + stride);
        }
#undef P7A_LOADA
#undef P7A_ISSUE
#undef P7A_COMP
    }
}
__device__ __forceinline__ void p7b_coef(Frame& F) {
    const int gw = F.vcu * NWAVES + F.wave, NGW = F.G * NWAVES, lane = fresh_lane();
    const float* PD0 = (const float*)(F.ws + WS_PD0); const float* PD1 = (const float*)(F.ws + WS_PD1);
    const unsigned char* RE16b = F.ws + WS_RE16; const float* RG = (const float*)(F.ws + WS_RG); const float* SS = (const float*)(F.ws + WS_SS);
    const float* US = (const float*)(F.ws + WS_US); const float* VS = (const float*)(F.ws + WS_VS);
    unsigned* CQ = (unsigned*)(F.ws + WS_CQ); float* SCQ = (float*)(F.ws + WS_SCQ);
#pragma unroll 1
    for (int t = gw; t < NT_TOK; t += NGW) {
        float da = 0.f, db = 0.f;
#pragma unroll
        for (int hs = 0; hs < 8; ++hs) { const size_t o = ((size_t)hs * NT_TOK + t) * 128 + lane; da += PD0[o] + PD1[o]; db += PD0[o + 64] + PD1[o + 64]; }
        float rstd; { const float sp = (lane < 32) ? SS[(size_t)t * 32 + lane] : 0.f; rstd = 1.0f / sqrtf(wave_sum(sp) * (1.0f / DM) + RMS_EPS); }
        const unsigned short* rp = (const unsigned short*)(RE16b + (size_t)t * 256 + (lane & 7) * 32) + (lane >> 3);
        const int ea = rp[0], eb = rp[8];
        const float ga = RG[(size_t)t * 128 + lane], gb = RG[(size_t)t * 128 + 64 + lane];
        const float za = da * US[ea] * rstd, zb = db * US[eb] * rstd;
        const float ca = ga * 0.5f * za * (1.0f + erff(za * 0.70710678118654752f)) * VS[ea], cb = gb * 0.5f * zb * (1.0f + erff(zb * 0.70710678118654752f)) * VS[eb];
        float am = fmaxf(fabsf(ca), fabsf(cb));
#pragma unroll
        for (int o = 1; o < 64; o <<= 1) am = fmaxf(am, __shfl_xor(am, o));
        const float inv = am > 0.f ? 127.0f / am : 0.f;
        const int qa = (int)__builtin_rintf(ca * inv) & 0xff, qb = (int)__builtin_rintf(cb * inv) & 0xff;
        const int wa = qa | (__shfl_down(qa, 8) << 8) | (__shfl_down(qa, 16) << 16) | (__shfl_down(qa, 24) << 24);
        const int wb = qb | (__shfl_down(qb, 8) << 8) | (__shfl_down(qb, 16) << 16) | (__shfl_down(qb, 24) << 24);
        if (((lane >> 3) & 3) == 0) { unsigned* cq = CQ + (size_t)t * 32 + (lane & 7) * 4 + (lane >> 5); cq[0] = (unsigned)wa; cq[2] = (unsigned)wb; }
        if (lane == 0) SCQ[t] = am * (1.0f / 127.0f);
    }
}

#if P7A_INV
__device__ __forceinline__ void lds_inc(LAS unsigned* p) { (void)__hip_atomic_fetch_add(p, 1u, __ATOMIC_RELAXED, __HIP_MEMORY_SCOPE_WORKGROUP); }
__device__ __forceinline__ unsigned lds_inc_rtn(LAS unsigned* p) { return __hip_atomic_fetch_add(p, 1u, __ATOMIC_RELAXED, __HIP_MEMORY_SCOPE_WORKGROUP); }
__device__ __forceinline__ void p6a_hist(Frame& F) {
    const int lane = fresh_lane(), tid = F.wave * 64 + lane;
    LAS unsigned* cnt = (LAS unsigned*)F.lds;
    unsigned* H = (unsigned*)(F.ws + WS_H); const float* SS = (const float*)(F.ws + WS_SS); float* RSTD2 = (float*)(F.ws + WS_RSTD2);
#pragma unroll 1
    for (int j = F.vcu; j < IG_NSUB; j += F.G) {
        cnt[tid] = 0u; cnt[tid + 512] = 0u;
        __syncthreads();
        const v4u* re = (const v4u*)(F.ws + WS_RE16 + (size_t)j * IG_SUBT * 256);
        v4u rv[3];
#pragma unroll
        for (int k = 0; k < 3; ++k) rv[k] = re[tid + 512 * k];
#pragma unroll
        for (int k = 0; k < 3; ++k) { const v4u v = rv[k];
#pragma unroll
            for (int c = 0; c < 4; ++c) { lds_inc(&cnt[(v[c] & 0xffffu) >> 4]); lds_inc(&cnt[v[c] >> 20]); } }
        if (tid < IG_SUBT) { const int t = j * IG_SUBT + tid; const f32x4* p = (const f32x4*)(SS + (size_t)t * 32); float s = 0.f;
#pragma unroll
            for (int i = 0; i < 8; ++i) { const f32x4 v = p[i]; s += (v[0] + v[1]) + (v[2] + v[3]); }
            float rs_ = 1.0f / sqrtf(s * (1.0f / DM) + RMS_EPS);
#if P7A_X2Q
            rs_ *= ((const float*)(F.ws + WS_SX2))[t];
#endif
            RSTD2[t] = rs_; }
        __syncthreads();
        H[j * 1024 + tid] = cnt[tid]; H[j * 1024 + tid + 512] = cnt[tid + 512];
        __syncthreads();
    }
}
__device__ __forceinline__ void p6b_scatter(Frame& F) {
    const int lane = fresh_lane(), tid = F.wave * 64 + lane;
    LAS unsigned* cnt = (LAS unsigned*)F.lds; LAS unsigned* wsum = cnt + 1024;
    const unsigned* H = (const unsigned*)(F.ws + WS_H); unsigned* L = (unsigned*)(F.ws + WS_L); unsigned* TL = (unsigned*)(F.ws + WS_TL);
#pragma unroll 1
    for (int j = F.vcu; j < IG_NSUB; j += F.G) {
        const int g = j / IG_SPG, c = j % IG_SPG;
        unsigned t0 = 0, t1 = 0, p0 = 0, p1 = 0;
#pragma unroll
        for (int cc = 0; cc < IG_SPG; ++cc) { const v2u h = *(const v2u*)(H + (size_t)(IG_SPG * g + cc) * 1024 + 2 * tid); t0 += h.x; t1 += h.y; if (cc < c) { p0 += h.x; p1 += h.y; } }
        const unsigned k0 = t0 | (((t0 + 15u) >> 4) << 18), k1 = t1 | (((t1 + 15u) >> 4) << 18), s = k0 + k1;
        unsigned inc = s;
#pragma unroll
        for (int o = 1; o < 64; o <<= 1) { const unsigned v = (unsigned)__shfl_up((int)inc, o); if (lane >= o) inc += v; }
        if (lane == 63) wsum[F.wave] = inc;
        __syncthreads();
        unsigned wo = 0;
#pragma unroll
        for (int w = 0; w < 8; ++w) { const unsigned v = wsum[w]; if (w < F.wave) wo += v; }
        const unsigned e0 = wo + inc - s, e1 = e0 + k0;
        cnt[2 * tid] = (e0 & 0x3ffffu) + p0; cnt[2 * tid + 1] = (e1 & 0x3ffffu) + p1;
        if (c == 0) { unsigned* of = TL + (size_t)g * 1040; of[2 * tid] = e0 & 0x3ffffu; of[2 * tid + 1] = e1 & 0x3ffffu; if (tid == 511) of[1024] = (e1 & 0x3ffffu) + t1; }
        __syncthreads();
        const v4u* re = (const v4u*)(F.ws + WS_RE16 + (size_t)j * IG_SUBT * 256);
        unsigned* Lg = L + (size_t)g * IG_PICKS;
        v4u rv[3];
#pragma unroll
        for (int k = 0; k < 3; ++k) rv[k] = re[tid + 512 * k];
#pragma unroll
        for (int k = 0; k < 3; ++k) { const v4u v = rv[k]; const unsigned ix0 = (unsigned)(tid + 512 * k) * 8u;
            const unsigned tl7 = ((unsigned)c * IG_SUBT + (ix0 >> 7)) << 7, ri0 = ix0 & 127u;
#pragma unroll
            for (int cc = 0; cc < 8; ++cc) { const unsigned e = (cc & 1) ? (v[cc >> 1] >> 16) : (v[cc >> 1] & 0xffffu); const unsigned ri = ri0 + cc, pair = 8u * (ri & 15u) + (ri >> 4);
                const unsigned pos = lds_inc_rtn(&cnt[e >> 4]); Lg[pos] = (e << 17) | tl7 | pair; } }
        __syncthreads();
    }
}
typedef int v4i __attribute__((ext_vector_type(4)));
__device__ __forceinline__ float red16_max(float v) { v = red8_max(v); return fmaxf(v, __builtin_bit_cast(float, dpp_i<0x140>(__builtin_bit_cast(int, v)))); }
template <int MODE  >
__device__ __forceinline__ void p7a_inv(Frame& F, unsigned* bar, unsigned x, unsigned rank) {
    const int lane = fresh_lane();
    const SliceOwn so = slice_census(bar, x);
    const bf16* X2B = (const bf16*)(F.ws + WS_X2B);
    const unsigned* L = (const unsigned*)(F.ws + WS_L); const unsigned* OFF = (const unsigned*)(F.ws + WS_TL);
    LAS unsigned* OFl = (LAS unsigned*)(F.lds + 2048);
    LAS unsigned char* XS = F.lds + 8192;
#pragma unroll 1
    for (int sp = 0; sp < 8; ++sp) {
        if ((unsigned)sp % so.npop != so.vx) continue;
#pragma unroll 1
        for (int g = (int)rank; g < IG_NGRP; g += (int)so.n_mine) {
            {
                const int r4 = lane >> 4, seg = lane & 15;
                const bf16* xp0 = X2B + (size_t)(g * IG_TOK + r4) * DM + 256 * sp + 16 * seg;
#if P7A_X2Q
                {
                    const unsigned char* qp0 = (const unsigned char*)F.out + OUT_X2Q + (size_t)(g * IG_TOK + r4) * DM + 256 * sp + 16 * seg;
                    v4u XQv[12];
#pragma unroll
                    for (int k = 0; k < 12; ++k) XQv[k] = *(const v4u*)(qp0 + (size_t)(F.wave + k * NWAVES) * 4 * DM);
#pragma unroll
                    for (int k = 0; k < 12; ++k) { const int tl = (F.wave + k * NWAVES) * 4 + r4; *(LAS v4u*)(XS + tl * IG_PITCH + seg * 16) = XQv[k]; }
                }
#else
#pragma unroll 1
                for (int it0 = F.wave; it0 < IG_TOK / 4; it0 += 4 * NWAVES) {
                    v4u XA[4], XB[4];
#pragma unroll
                    for (int k = 0; k < 4; ++k) { const int it = it0 + k * NWAVES < IG_TOK / 4 ? it0 + k * NWAVES : it0; const bf16* xp = xp0 + (size_t)it * 4 * DM; XA[k] = *(const v4u*)xp; XB[k] = *(const v4u*)(xp + 8); }
#pragma unroll
                    for (int k = 0; k < 4; ++k) { const int it = it0 + k * NWAVES; if (it < IG_TOK / 4) { const v4u X0 = XA[k], X1 = XB[k];
                    float xf[16]; float am = 0.f;
#pragma unroll
                    for (int c = 0; c < 4; ++c) { xf[2 * c] = bflo(X0[c]); xf[2 * c + 1] = bfhi(X0[c]); xf[8 + 2 * c] = bflo(X1[c]); xf[8 + 2 * c + 1] = bfhi(X1[c]); }
#pragma unroll
                    for (int c = 0; c < 16; ++c) am = fmaxf(am, fabsf(xf[c]));
                    am = red16_max(am); const float inv = am > 0.f ? 127.0f / am : 0.f;
                    v4u hq;
#pragma unroll
                    for (int w = 0; w < 4; ++w) { unsigned p = 0;
#pragma unroll
                        for (int c = 0; c < 4; ++c) p |= ((unsigned)(int)__builtin_rintf(xf[4 * w + c] * inv) & 0xffu) << (8 * c);
                        hq[w] = p; }
                    const int tl = it * 4 + r4;
                    *(LAS v4u*)(XS + tl * IG_PITCH + seg * 16) = hq;
                    if (seg == 0) *(LAS float*)(XS + tl * IG_PITCH + 256) = am * (1.0f / 127.0f); } }
                }
#endif
                const int tid = F.wave * 64 + lane;
                OFl[tid] = OFF[(size_t)g * 1040 + tid]; OFl[tid + 512] = OFF[(size_t)g * 1040 + tid + 512]; if (tid < 8) OFl[1024 + tid] = OFF[(size_t)g * 1040 + 1024];
            }
            __syncthreads();
            {
                const int lane2 = fresh_lane(), i16 = lane2 & 15; const unsigned q = (unsigned)lane2 >> 4, qsh = q << 4;
                const unsigned* Lgu = L + (size_t)g * IG_PICKS;
                float* PDu = (float*)(F.ws + ((MODE & 4) ? WS_PD1 : WS_PD0)) + (size_t)sp * NT_TOK * 128 + (size_t)g * IG_PICKS;
                const unsigned char* Ub = F.ws + WS_U + (size_t)sp * (1024 * 4096) + lane2 * 16;
                const unsigned stg_ = 112640u + (unsigned)F.wave * 768u + (unsigned)lane2 * 4u, own_ = 112640u + (unsigned)F.wave * 768u + (unsigned)i16 * 4u, dmy_ = stg_ + 256u;
                float* DMG = (float*)(F.ws + WS_NTL);
#define IG_OFF(b) ((unsigned)__builtin_amdgcn_readfirstlane((int)OFl[b]))
#define IG_LD(j, R) do { const unsigned rec_ = R[j]; const unsigned t_ = ((MODE & 16) ? (unsigned)i16 : __builtin_amdgcn_ubfe(rec_, 7, 10)) * (unsigned)IG_PITCH + qsh; \
                    B0[j] = *(const LAS v4i*)(XS + t_); B1[j] = *(const LAS v4i*)(XS + t_ + 64); B2[j] = *(const LAS v4i*)(XS + t_ + 128); B3[j] = *(const LAS v4i*)(XS + t_ + 192); \
                    if (!P7A_X2Q) hv[j] = *(const LAS float*)(XS + (t_ - qsh) + 256); } while (0)
#define IG_MM(j, A) do { if (MODE & 8) { B0[j] = B0[j] | B1[j] | B2[j] | B3[j]; break; } const v4i z_ = {0, 0, 0, 0}; B0[j] = __builtin_amdgcn_mfma_i32_16x16x64_i8(A[0], B0[j], z_, 0, 0, 0); B0[j] = __builtin_amdgcn_mfma_i32_16x16x64_i8(A[1], B1[j], B0[j], 0, 0, 0); \
                    B0[j] = __builtin_amdgcn_mfma_i32_16x16x64_i8(A[2], B2[j], B0[j], 0, 0, 0); B0[j] = __builtin_amdgcn_mfma_i32_16x16x64_i8(A[3], B3[j], B0[j], 0, 0, 0); } while (0)
#define IG_ST(j, R) do { const unsigned rec_ = R[j]; const int lo_ = (rec_ & 0x20000u) ? B0[j][1] : B0[j][0], hi_ = (rec_ & 0x20000u) ? B0[j][3] : B0[j][2], val_ = (rec_ & 0x40000u) ? hi_ : lo_; \
                    const float o_ = P7A_X2Q ? (float)val_ : (float)val_ * hv[j]; \
                    *(LAS float*)(F.lds + (__builtin_amdgcn_ubfe(rec_, 19, 2) == q ? own_ : dmy_) + 64 * (j)) = o_; } while (0)
#define IG_STG(R, P0, NREM) do { const unsigned rec_ = R[0]; const int lo_ = (rec_ & 0x20000u) ? B0[0][1] : B0[0][0], hi_ = (rec_ & 0x20000u) ? B0[0][3] : B0[0][2], val_ = (rec_ & 0x40000u) ? hi_ : lo_; \
                    const float o_ = P7A_X2Q ? (float)val_ : (float)val_ * hv[0]; \
                    if (__builtin_amdgcn_ubfe(rec_, 19, 2) == q && (unsigned)i16 < (NREM)) (PDu + (P0))[i16] = o_; } while (0)
#define IG_BIDX(BI) (F.wave + NWAVES * (BI))
#define IG_BLOCK(AC, RC, AN, RN, BI) do { \
                    const unsigned s4_ = (unsigned)__builtin_amdgcn_readfirstlane((int)vS), e4_ = (unsigned)__builtin_amdgcn_readfirstlane((int)vE);     \
                    { const int b5_ = IG_BIDX((BI) + 4) < 1023 ? IG_BIDX((BI) + 4) : 1023; vS = OFl[b5_]; vE = OFl[b5_ + 1]; } \
                    const int bp_ = IG_BIDX((BI) + 3), bpc_ = (MODE & 1) ? 0 : (bp_ < 1023 ? bp_ : 1023); \
                    v4i B0[4], B1[4], B2[4], B3[4]; float hv[4]; \
                    const unsigned nrem_ = e0 - s0; const bool h3_ = nrem_ > 48u; \
                    IG_LD(0, RC); IG_LD(1, RC); IG_LD(2, RC); \
                    if (h3_) IG_LD(3, RC); \
                    __builtin_amdgcn_sched_barrier(0); \
                    AN[0] = *(const v4i*)(Ub + (size_t)bpc_ * 4096); AN[1] = *(const v4i*)(Ub + (size_t)bpc_ * 4096 + 1024); \
                    __builtin_amdgcn_sched_barrier(0); \
                    IG_MM(0, AC); IG_MM(1, AC); \
                    __builtin_amdgcn_sched_barrier(0); \
                    AN[2] = *(const v4i*)(Ub + (size_t)bpc_ * 4096 + 2048); AN[3] = *(const v4i*)(Ub + (size_t)bpc_ * 4096 + 3072); \
                    __builtin_amdgcn_sched_barrier(0); \
                    IG_MM(2, AC); \
                    IG_ST(0, RC); IG_ST(1, RC); \
                    __builtin_amdgcn_sched_barrier(0); \
                    RN[0] = (Lgu + (((MODE & 2) ? 0u : s4_)))[i16]; RN[1] = (Lgu + (((MODE & 2) ? 0u : s4_) + 16))[i16]; \
                    __builtin_amdgcn_sched_barrier(0); \
                    IG_ST(2, RC); \
                    if (h3_) { IG_MM(3, AC); IG_ST(3, RC); } \
                    __builtin_amdgcn_sched_barrier(0); \
                    RN[2] = (Lgu + (((MODE & 2) ? 0u : s4_) + 32))[i16]; RN[3] = (Lgu + (((MODE & 2) ? 0u : s4_) + 48))[i16]; \
                    __builtin_amdgcn_sched_barrier(0); \
                    { const float v_ = *(const LAS float*)(F.lds + stg_); float* dst_ = (unsigned)lane2 < nrem_ ? PDu + s0 + lane2 : DMG + lane2; *dst_ = v_; }     \
                    _Pragma("unroll 1") for (unsigned tb_ = s0 + 64u; tb_ < e0; tb_ += 16u) {     \
                        unsigned rr_[1]; rr_[0] = (Lgu + tb_)[i16]; IG_LD(0, rr_); IG_MM(0, AC); IG_STG(rr_, tb_, e0 - tb_); } \
                    s0 = s1; e0 = e1; s1 = s2; e1 = e2; s2 = s4_; e2 = e4_; } while (0)
#define IG_LOADSET(A, R, B, S) do { A[0] = *(const v4i*)(Ub + (size_t)(B) * 4096); A[1] = *(const v4i*)(Ub + (size_t)(B) * 4096 + 1024); A[2] = *(const v4i*)(Ub + (size_t)(B) * 4096 + 2048); A[3] = *(const v4i*)(Ub + (size_t)(B) * 4096 + 3072); \
                    _Pragma("unroll") for (int j_ = 0; j_ < 4; ++j_) R[j_] = (Lgu + ((S) + 16 * j_))[i16]; } while (0)
                unsigned s0 = IG_OFF(IG_BIDX(0)), e0 = IG_OFF(IG_BIDX(0) + 1), s1 = IG_OFF(IG_BIDX(1)), e1 = IG_OFF(IG_BIDX(1) + 1), s2 = IG_OFF(IG_BIDX(2)), e2 = IG_OFF(IG_BIDX(2) + 1);
                unsigned vS = OFl[IG_BIDX(3)], vE = OFl[IG_BIDX(3) + 1];
                v4i A0s[4], A1s[4], A2s[4], A3s[4]; unsigned R0s[4], R1s[4], R2s[4], R3s[4];
                IG_LOADSET(A0s, R0s, IG_BIDX(0), s0); IG_LOADSET(A1s, R1s, IG_BIDX(1), s1); IG_LOADSET(A2s, R2s, IG_BIDX(2), s2);
#pragma unroll 1
                for (int bi = 0; bi < 128; bi += 4) { IG_BLOCK(A0s, R0s, A3s, R3s, bi); IG_BLOCK(A1s, R1s, A0s, R0s, bi + 1); IG_BLOCK(A2s, R2s, A1s, R1s, bi + 2); IG_BLOCK(A3s, R3s, A2s, R2s, bi + 3); }
#undef IG_BIDX
#undef IG_LOADSET
#undef IG_BLOCK
#undef IG_ST
#undef IG_STG
#undef IG_MM
#undef IG_LD
#undef IG_OFF
            }
            __syncthreads();
        }
    }
}
__device__ __forceinline__ void p7b_sorted(Frame& F) {
    const int lane = fresh_lane(), tid = F.wave * 64 + lane;
    const float* PD = (const float*)(F.ws + WS_PD0);
    const unsigned* L = (const unsigned*)(F.ws + WS_L); float* RG = (float*)(F.ws + WS_RG); const float* RSTD2 = (const float*)(F.ws + WS_RSTD2);
    const float* US = (const float*)(F.ws + WS_US); const float* VS = (const float*)(F.ws + WS_VS);
    constexpr int NQ = IG_NGRP * IG_PICKS / 4, QPG = IG_PICKS / 4, QB = 3;
    const int q_lo = (int)((long long)F.vcu * NQ / F.G), q_hi = (int)((long long)(F.vcu + 1) * NQ / F.G);
#pragma unroll 1
    for (int q0 = q_lo + tid; q0 < q_hi; q0 += QB * NTHREADS) {
        v4u rec[QB]; f32x4 d[QB];
#pragma unroll
        for (int k = 0; k < QB; ++k) { const int qq = q0 + k * NTHREADS; const size_t pos = (size_t)(qq < q_hi ? qq : q_lo) * 4; rec[k] = *(const v4u*)(L + pos); f32x4 s = {0.f, 0.f, 0.f, 0.f};
#pragma unroll
            for (int sp = 0; sp < 8; ++sp) s += *(const f32x4*)(PD + (size_t)sp * NT_TOK * 128 + pos);
            d[k] = s; }
        float us[QB][4], vs[QB][4], rs[QB][4], gg[QB][4];
#pragma unroll
        for (int k = 0; k < QB; ++k) { const int qq = q0 + k * NTHREADS < q_hi ? q0 + k * NTHREADS : q_lo; const int g = qq / QPG;
#pragma unroll
            for (int c = 0; c < 4; ++c) { const unsigned r = rec[k][c]; const unsigned e = r >> 17; const int t = g * IG_TOK + (int)((r >> 7) & 1023u), pair = (int)(r & 127u);
                us[k][c] = US[e]; vs[k][c] = VS[e]; rs[k][c] = RSTD2[t]; gg[k][c] = RG[(size_t)t * 128 + pair]; } }
        asm volatile("s_waitcnt vmcnt(0)" ::: "memory");
#pragma unroll
        for (int k = 0; k < QB; ++k) { const int qq = q0 + k * NTHREADS; if (qq < q_hi) { const int g = qq / QPG;
#pragma unroll
            for (int c = 0; c < 4; ++c) { const unsigned r = rec[k][c]; const int t = g * IG_TOK + (int)((r >> 7) & 1023u), pair = (int)(r & 127u);
                const float z = d[k][c] * us[k][c] * rs[k][c];
                RG[(size_t)t * 128 + pair] = gg[k][c] * 0.5f * z * (1.0f + erff(z * 0.70710678118654752f)) * vs[k][c]; } } }
    }
}
__device__ __forceinline__ void p7b_quant(Frame& F) {
    const int gw = F.vcu * NWAVES + F.wave, NGW = F.G * NWAVES, lane = fresh_lane();
    const float* RG = (const float*)(F.ws + WS_RG); unsigned* CQ = (unsigned*)(F.ws + WS_CQ); float* SCQ = (float*)(F.ws + WS_SCQ);
#pragma unroll 1
    for (int t0 = gw; t0 < NT_TOK; t0 += 4 * NGW) {
        float ca[4], cb[4];
#pragma unroll
        for (int k = 0; k < 4; ++k) { const int t = t0 + k * NGW < NT_TOK ? t0 + k * NGW : t0; ca[k] = RG[(size_t)t * 128 + lane]; cb[k] = RG[(size_t)t * 128 + 64 + lane]; }
#pragma unroll
        for (int k = 0; k < 4; ++k) { const int t = t0 + k * NGW; if (t < NT_TOK) {
            float am = fmaxf(fabsf(ca[k]), fabsf(cb[k]));
#pragma unroll
            for (int o = 1; o < 64; o <<= 1) am = fmaxf(am, __shfl_xor(am, o));
            const float inv = am > 0.f ? 127.0f / am : 0.f;
            const int qa = (int)__builtin_rintf(ca[k] * inv) & 0xff, qb = (int)__builtin_rintf(cb[k] * inv) & 0xff;
            const int wa = qa | (__shfl_down(qa, 8) << 8) | (__shfl_down(qa, 16) << 16) | (__shfl_down(qa, 24) << 24);
            const int wb = qb | (__shfl_down(qb, 8) << 8) | (__shfl_down(qb, 16) << 16) | (__shfl_down(qb, 24) << 24);
            if (((lane >> 3) & 3) == 0) { unsigned* cq = CQ + (size_t)t * 32 + (lane & 7) * 4 + (lane >> 5); cq[0] = (unsigned)wa; cq[2] = (unsigned)wb; }
            if (lane == 0) SCQ[t] = am * (1.0f / 127.0f); } }
    }
}
#endif
__device__ __forceinline__ void p7c_vaxpy(Frame& F, unsigned* bar, unsigned x, unsigned rank) {
    const int lane = fresh_lane(), r = lane >> 3, seg = lane & 7;
    const SliceOwn so = slice_census(bar, x);
    const int gwl = (int)rank * NWAVES + F.wave, stride = (int)so.n_mine * NWAVES;
    const unsigned char* RE16b = F.ws + WS_RE16; const unsigned char* CQb = F.ws + WS_CQ; const float* SCQ = (const float*)(F.ws + WS_SCQ);
    float* SS3 = (float*)(F.ws + WS_SS3); bf16* X2Bw = (bf16*)(F.ws + WS_X2B);
#pragma unroll 1
    for (int pass = 0; pass < 16; ++pass) {
        const int hs = (2 * (int)so.vx + pass) & 15; if ((unsigned)(hs >> 1) % so.npop != so.vx) continue;
        const unsigned char* Vb = F.ws + WS_V + (size_t)hs * (16384 * 128) + 16 * seg;
        const unsigned char* rp0 = RE16b + r * 32; const unsigned char* cp0 = CQb + r * 16;
#define P7C_LOADA(R0, R1, C, S, X, t) do { const int tt_ = (t) < NT_TOK ? (t) : NT_TOK - 1; const unsigned char* rp_ = rp0 + (size_t)tt_ * 256; R0 = *(const v4u*)rp_; R1 = *(const v4u*)(rp_ + 16); \
            C = *(const v4u*)(cp0 + (size_t)tt_ * 128); S = SCQ[tt_]; X = *(const unsigned*)(X2Bw + (size_t)tt_ * DM + 128 * hs + 16 * seg + 2 * r); } while (0)
#define P7C_ISSUE(G, R0, R1) do { __builtin_amdgcn_s_setprio(3); _Pragma("unroll") for (int i_ = 0; i_ < 16; ++i_) { const unsigned e_ = P7_EID(R0, R1, i_); G[i_] = *(const v4u*)(Vb + (size_t)e_ * 128); } __builtin_amdgcn_s_setprio(0); } while (0)
#define P7C_COMP(G, C, S, X, t) do { int acc_[16]; _Pragma("unroll") for (int c_ = 0; c_ < 16; ++c_) acc_[c_] = 0; \
            _Pragma("unroll") for (int gi_ = 0; gi_ < 4; ++gi_) { const int cq_ = (int)C[gi_]; \
                _Pragma("unroll") for (int w_ = 0; w_ < 4; ++w_) { const unsigned A0 = G[4 * gi_][w_], A1 = G[4 * gi_ + 1][w_], A2 = G[4 * gi_ + 2][w_], A3 = G[4 * gi_ + 3][w_]; \
                    const unsigned lo01 = __builtin_amdgcn_perm(A1, A0, 0x05010400u), hi01 = __builtin_amdgcn_perm(A1, A0, 0x07030602u), lo23 = __builtin_amdgcn_perm(A3, A2, 0x05010400u), hi23 = __builtin_amdgcn_perm(A3, A2, 0x07030602u); \
                    acc_[4 * w_ + 0] = __builtin_amdgcn_sdot4((int)__builtin_amdgcn_perm(lo23, lo01, 0x05040100u), cq_, acc_[4 * w_ + 0], false); \
                    acc_[4 * w_ + 1] = __builtin_amdgcn_sdot4((int)__builtin_amdgcn_perm(lo23, lo01, 0x07060302u), cq_, acc_[4 * w_ + 1], false); \
                    acc_[4 * w_ + 2] = __builtin_amdgcn_sdot4((int)__builtin_amdgcn_perm(hi23, hi01, 0x05040100u), cq_, acc_[4 * w_ + 2], false); \
                    acc_[4 * w_ + 3] = __builtin_amdgcn_sdot4((int)__builtin_amdgcn_perm(hi23, hi01, 0x07060302u), cq_, acc_[4 * w_ + 3], false); } } \
            int a8_[8], a4_[4], a2_[2]; \
            { const bool up_ = (lane & 32) != 0; _Pragma("unroll") for (int c_ = 0; c_ < 8; ++c_) { const int keep_ = up_ ? acc_[c_ + 8] : acc_[c_], send_ = up_ ? acc_[c_] : acc_[c_ + 8]; a8_[c_] = keep_ + __shfl_xor(send_, 32); } } \
            { const bool up_ = (lane & 16) != 0; _Pragma("unroll") for (int c_ = 0; c_ < 4; ++c_) { const int keep_ = up_ ? a8_[c_ + 4] : a8_[c_], send_ = up_ ? a8_[c_] : a8_[c_ + 4]; a4_[c_] = keep_ + __shfl_xor(send_, 16); } } \
            { const bool up_ = (lane & 8) != 0; _Pragma("unroll") for (int c_ = 0; c_ < 2; ++c_) { const int keep_ = up_ ? a4_[c_ + 2] : a4_[c_], send_ = up_ ? a4_[c_] : a4_[c_ + 2]; a2_[c_] = keep_ + __shfl_xor(send_, 8); } } \
            const int tt_ = (t) < NT_TOK ? (t) : NT_TOK - 1; bf16* op_ = X2Bw + (size_t)tt_ * DM + 128 * hs + 16 * seg + 2 * r; \
            const float o0_ = bflo(X) + (float)a2_[0] * S, o1_ = bfhi(X) + (float)a2_[1] * S; \
            const float s3_ = wave_sum(o0_ * o0_ + o1_ * o1_); \
            if ((t) < NT_TOK) { *(unsigned*)op_ = pk2(o0_, o1_); if (lane == 0) SS3[(size_t)(t) * 16 + hs] = s3_; } } while (0)
        v4u GA[16], GB[16], ra0, ra1, ca, rb0, rb1, cb, cA, cB; float sa, sb, sA, sB; unsigned xa, xb2, xA, xB;
        P7C_LOADA(ra0, ra1, ca, sa, xa, gwl);
        P7C_LOADA(rb0, rb1, cb, sb, xb2, gwl + stride);
        P7C_ISSUE(GA, ra0, ra1); cA = ca; sA = sa; xA = xa;
#pragma unroll 1
        for (int t = gwl; t < NT_TOK; t += 2 * stride) {
            P7C_LOADA(ra0, ra1, ca, sa, xa, t + 2 * stride); P7C_ISSUE(GB, rb0, rb1); cB = cb; sB = sb; xB = xb2; P7C_COMP(GA, cA, sA, xA, t);
            P7C_LOADA(rb0, rb1, cb, sb, xb2, t + 3 * stride); P7C_ISSUE(GA, ra0, ra1); cA = ca; sA = sa; xA = xa; P7C_COMP(GB, cB, sB, xB, t + stride);
        }
#undef P7C_LOADA
#undef P7C_ISSUE
#undef P7C_COMP
    }
}
__device__ __forceinline__ void p7d_final(Frame& F) {
    const int gw = F.vcu * NWAVES + F.wave, NGW = F.G * NWAVES, lane = fresh_lane();
    const float* SS3 = (const float*)(F.ws + WS_SS3);
    f32x4 gf[8];
#pragma unroll
    for (int j = 0; j < 8; ++j) gf[j] = *(const f32x4*)(F.normf_g + 512 * (j >> 1) + 8 * lane + 4 * (j & 1));
#pragma unroll 1
    for (int t = gw; t < NT_TOK; t += NGW) {
        const float sp = (lane < 16) ? SS3[(size_t)t * 16 + lane] : 0.f; const float r3 = 1.0f / sqrtf(wave_sum(sp) * (1.0f / DM) + RMS_EPS);
        const v4u* xin = (const v4u*)((const bf16*)(F.ws + WS_X2B) + (size_t)t * DM) + lane;
        f32x4* row = (f32x4*)(F.out + (size_t)t * DM);
        v4u v[4];
#pragma unroll
        for (int j = 0; j < 4; ++j) v[j] = xin[64 * j];
#pragma unroll
        for (int j = 0; j < 4; ++j) {
            const f32x4 a = (f32x4){bflo(v[j].x), bfhi(v[j].x), bflo(v[j].y), bfhi(v[j].y)} * r3 * gf[2 * j], b = (f32x4){bflo(v[j].z), bfhi(v[j].z), bflo(v[j].w), bfhi(v[j].w)} * r3 * gf[2 * j + 1];
            row[128 * j + 2 * lane] = a; row[128 * j + 2 * lane + 1] = b; }
    }
}

__device__ __forceinline__ void p4b_quant_x2(Frame& F) {
    const int gw = F.vcu * NWAVES + F.wave, NGW = F.G * NWAVES, lane = fresh_lane();
    const bf16* X2B = (const bf16*)(F.ws + WS_X2B); unsigned char* X2Q = (unsigned char*)F.out + OUT_X2Q; float* SX = (float*)(F.ws + WS_SX);
    v4u cur[4], nxt[4];
    if (gw < NT_TOK) {
#pragma unroll
        for (int j = 0; j < 4; ++j) cur[j] = *(const v4u*)(X2B + (size_t)gw * DM + 512 * j + 8 * lane); }
#pragma unroll 1
    for (int t = gw; t < NT_TOK; t += NGW) {
        { const int tn = (t + NGW < NT_TOK) ? t + NGW : t;
#pragma unroll
          for (int j = 0; j < 4; ++j) nxt[j] = *(const v4u*)(X2B + (size_t)tn * DM + 512 * j + 8 * lane); }
        float v[32]; float am = 0.f;
#pragma unroll
        for (int j = 0; j < 4; ++j)
#pragma unroll
            for (int c = 0; c < 4; ++c) { v[8 * j + 2 * c] = bflo(cur[j][c]); v[8 * j + 2 * c + 1] = bfhi(cur[j][c]); am = fmaxf(am, fmaxf(fabsf(v[8 * j + 2 * c]), fabsf(v[8 * j + 2 * c + 1]))); }
#pragma unroll
        for (int o = 1; o < 64; o <<= 1) am = fmaxf(am, __shfl_xor(am, o));
        const float inv = am > 0.f ? 127.0f / am : 0.f;
#pragma unroll
        for (int j = 0; j < 4; ++j) { v2u o;
#pragma unroll
            for (int q = 0; q < 2; ++q) { unsigned w = 0;
#pragma unroll
                for (int e = 0; e < 4; ++e) w |= ((unsigned)(int)__builtin_rintf(v[8 * j + 4 * q + e] * inv) & 0xffu) << (8 * e);
                o[q] = w; }
            *(v2u*)(X2Q + (size_t)t * DM + 512 * j + 8 * lane) = o; }
        if (lane == 0) SX[t] = am > 0.f ? am * (1.0f / 127.0f) : 1.0f;
#pragma unroll
        for (int j = 0; j < 4; ++j) cur[j] = nxt[j];
    }
}
__global__ void __launch_bounds__(NTHREADS, 2) hymba_fwd(Args args) {
    extern __shared__ __attribute__((aligned(16))) unsigned char lds[];
    Frame F;
    F.lds = (LAS unsigned char*)lds; F.lds_g = lds;
    F.tid = threadIdx.x; F.lane = F.tid & 63; F.wave = __builtin_amdgcn_readfirstlane(F.tid >> 6);
    F.G = gridDim.x; { const int bx = blockIdx.x; F.vcu = (F.G % 8 == 0) ? (bx % 8) * (F.G / 8) + bx / 8 : bx; }
    F.xp = args.in[0]; F.xs = args.in[1]; F.norm1_g = args.in[2]; F.w_in = args.in[3]; F.a_out_g = args.in[4]; F.b_out_g = args.in[5]; F.sink = args.in[6];
    F.w_out = args.in[7]; F.norm2_g = args.in[8]; F.w_pq = args.in[9]; F.sub_keys = args.in[10]; F.expert_u = args.in[11]; F.expert_v = args.in[12]; F.normf_g = args.in[13];
    F.out = args.out; F.ws = args.ws;
    volatile LAS unsigned* MISC = (volatile LAS unsigned*)(F.lds + MISC_OFF);
    if (F.tid < 32) MISC[F.tid] = 0u;
    __syncthreads();
    unsigned* bar = (unsigned*)(F.ws + WS_CTL);
    XcdBarrier xb = xcd_barrier_post(bar, MISC + 8);
#define GRID_BAR() xcd_barrier(xb)
#ifndef PROBE_REP
#define PROBE_REP -1
#endif
#define REPS(k) ((PROBE_REP == (k)) ? 3 : 1)
    for (int rep = 0; rep < REPS(0); ++rep) p0_prep(F);
    GRID_BAR();
    {
#if P1_I8
        pg8::Gemm g{(const bf16*)(F.ws + WS_XN), (const bf16*)(F.ws + WS_WIN), NT_TOK, INW, DM / 2}; pg8::StaticOrder S; S.init(NT_TOK, INW, F.G, (int)blockIdx.x);
        pg8::EpiBf16I8 E{(bf16*)(F.ws + WS_PROJ), INW, (const float*)(F.ws + WS_SXN), (const float*)(F.ws + WS_SWI), 0.125f * LOG2E, NT_TOK};
        p1_quant_w<INW, false>(F, F.w_in, nullptr, (const float*)(F.ws + WS_CMAX_IN), F.ws + WS_WIN, (float*)(F.ws + WS_SWI));
        typedef pg8::EpiBf16I8 EpiP1;
#else
        pg8::Gemm g{(const bf16*)(F.ws + WS_XN), (const bf16*)(F.ws + WS_WIN), NT_TOK, INW, DM}; pg8::StaticOrder S; S.init(NT_TOK, INW, F.G, (int)blockIdx.x);
        pg8::EpiBf16 E{(bf16*)(F.ws + WS_PROJ), INW, nullptr, 0.125f * LOG2E};
        typedef pg8::EpiBf16 EpiP1;
#endif
#if P4_I8
        p1_quant_w<DM, false>(F, F.w_out, nullptr, (const float*)(F.ws + WS_CMAX), F.ws + WS_WOUT, (float*)(F.ws + WS_SWO));
#endif
#if P1_I8
        GRID_BAR();
#else
        __syncthreads();
#endif
        for (int rep = 0; rep < REPS(1); ++rep) pg8::gemm_phase<EpiP1, pg8::StaticOrder, true, true>(F.lds, g, S, E, F.wave);
    }
    GRID_BAR();
    p2_attention<0>(F);
#if PROBE_REP == 21
    p2_attention<1>(F); p2_attention<1>(F);
#elif PROBE_REP == 22
    p2_attention<2>(F); p2_attention<2>(F);
#elif PROBE_REP == 23
    p2_attention<3>(F); p2_attention<3>(F);
#elif PROBE_REP == 24
    p2_attention<4>(F); p2_attention<4>(F);
#elif PROBE_REP == 25
    p2_attention<5>(F); p2_attention<5>(F);
#elif PROBE_REP == 26
    p2_attention<6>(F); p2_attention<6>(F);
#elif PROBE_REP == 2
    p2_attention<0>(F); p2_attention<0>(F);
#endif
    GRID_BAR();
    for (int rep = 0; rep < REPS(3); ++rep) p3_finalize(F);
#if P5_I8
    __syncthreads();
    p1_quant_w<DM, true>(F, F.w_pq, F.norm2_g, (const float*)(F.ws + WS_CMAX2), F.ws + WS_WPQ, (float*)(F.ws + WS_SWQ));
#endif
    GRID_BAR();
    {
#if P4_I8
        pg8::Gemm g{(const bf16*)(F.ws + WS_MIXED), (const bf16*)(F.ws + WS_WOUT), NT_TOK, DM, DM / 2}; pg8::StaticOrder S; S.init(NT_TOK, DM, F.G, (int)blockIdx.x);
        pg8::EpiResidI8 E{F.xp, F.xs, (bf16*)(F.ws + WS_X2B), (float*)(F.ws + WS_SS), (const float*)(F.ws + WS_SA), (const float*)(F.ws + WS_SWO)};
        for (int rep = 0; rep < REPS(4); ++rep) pg8::gemm_phase<pg8::EpiResidI8, pg8::StaticOrder, true, true>(F.lds, g, S, E, F.wave);
#else
        pg8::Gemm g{(const bf16*)(F.ws + WS_MIXED), (const bf16*)(F.ws + WS_WOUT), NT_TOK, DM, DM}; pg8::StaticOrder S; S.init(NT_TOK, DM, F.G, (int)blockIdx.x);
        pg8::EpiResid E{F.xp, F.xs, F.out, (bf16*)(F.ws + WS_X2B), (float*)(F.ws + WS_SS), (unsigned char*)F.out + OUT_X2Q, (const float*)(F.ws + WS_SX2)};
        for (int rep = 0; rep < REPS(4); ++rep) pg8::gemm_phase<pg8::EpiResid, pg8::StaticOrder, true, true>(F.lds, g, S, E, F.wave);
#endif
    }
    GRID_BAR();
#if P5_I8 == 1
    p4b_quant_x2(F);
    GRID_BAR();
#endif
    {
#if P5_I8
        pg8::Gemm g{(const bf16*)((const unsigned char*)F.out + OUT_X2Q), (const bf16*)(F.ws + WS_WPQ), NT_TOK, DM, DM / 2}; pg8::StaticOrder S; S.init(NT_TOK, DM, F.G, (int)blockIdx.x);
        typedef EpiRouteT<true> EpiRoute;
        EpiRoute E{(const float*)(F.ws + WS_SS), F.ws, (const float*)(F.ws + WS_SX2), (const float*)(F.ws + WS_SWQ)};
#else
        pg8::Gemm g{(const bf16*)(F.ws + WS_X2B), (const bf16*)(F.ws + WS_WPQ), NT_TOK, DM, DM}; pg8::StaticOrder S; S.init(NT_TOK, DM, F.G, (int)blockIdx.x);
        typedef EpiRouteT<false> EpiRoute;
        EpiRoute E{(const float*)(F.ws + WS_SS), F.ws, nullptr, nullptr};
#endif
#pragma unroll 1
        for (int rep = 0; rep < REPS(5); ++rep)
#pragma unroll 1
        for (int i = 0;; ++i) { pg8::OneUnit O; if (!S.next(i, O.u)) break; pg8::gemm_phase<EpiRoute, pg8::OneUnit, false, true>(F.lds, g, O, E, F.wave); }
    }
    GRID_BAR();
    const unsigned rank = MISC[10];
#if P7A_INV
    for (int rep = 0; rep < REPS(9); ++rep) p6a_hist(F);
    GRID_BAR();
    for (int rep = 0; rep < REPS(10); ++rep) p6b_scatter(F);
    GRID_BAR();
    p7a_inv<0>(F, bar, xb.x, rank);
#if PROBE_REP == 7
    p7a_inv<4>(F, bar, xb.x, rank); p7a_inv<4>(F, bar, xb.x, rank);
#elif PROBE_REP == 71
    p7a_inv<5>(F, bar, xb.x, rank); p7a_inv<5>(F, bar, xb.x, rank);
#elif PROBE_REP == 72
    p7a_inv<6>(F, bar, xb.x, rank); p7a_inv<6>(F, bar, xb.x, rank);
#elif PROBE_REP == 73
    p7a_inv<7>(F, bar, xb.x, rank); p7a_inv<7>(F, bar, xb.x, rank);
#elif PROBE_REP == 74
    p7a_inv<12>(F, bar, xb.x, rank); p7a_inv<12>(F, bar, xb.x, rank);
#elif PROBE_REP == 75
    p7a_inv<20>(F, bar, xb.x, rank); p7a_inv<20>(F, bar, xb.x, rank);
#endif
    GRID_BAR();
    p7b_sorted(F);
    GRID_BAR();
    for (int rep = 0; rep < REPS(11); ++rep) p7b_quant(F);
    GRID_BAR();
#else
    for (int rep = 0; rep < REPS(7); ++rep) p7a_udots(F, bar, xb.x, rank);
    GRID_BAR();
    for (int rep = 0; rep < REPS(8); ++rep) p7b_coef(F);
    GRID_BAR();
#endif
    p7c_vaxpy(F, bar, xb.x, rank);
    GRID_BAR();
    p7d_final(F);
#undef GRID_BAR
}

extern "C" void kernel_launch(void* const* d_in, const int* in_sizes, int n_in, void* d_out, int out_size, void* d_ws, size_t ws_size, hipStream_t stream) {
    static int grid = 0;
    if (grid == 0) {
        if (n_in != 14 || out_size != NT_TOK * DM || ws_size < WS_END) { fprintf(stderr, "kernel_launch: unexpected shapes (n_in %d out %d ws %zu)\n", n_in, out_size, ws_size); grid = -1; return; }
        int dev = 0, cus = 0, per_cu = 0;
        (void)hipGetDevice(&dev); (void)hipDeviceGetAttribute(&cus, hipDeviceAttributeMultiprocessorCount, dev);
        (void)hipFuncSetAttribute((const void*)hymba_fwd, hipFuncAttributeMaxDynamicSharedMemorySize, LDS_BYTES);
        (void)hipOccupancyMaxActiveBlocksPerMultiprocessor(&per_cu, (const void*)hymba_fwd, NTHREADS, LDS_BYTES);
        if (per_cu < 1) { fprintf(stderr, "kernel_launch: occupancy query says %d blocks per CU\n", per_cu); per_cu = 1; }
        (void)hipGetLastError();
        grid = cus;
    }
    if (grid < 0) return;
    Args a{};
    for (int i = 0; i < 14; ++i) a.in[i] = (const float*)d_in[i];
    a.out = (float*)d_out; a.ws = (unsigned char*)d_ws; a.ph_lo = 0; a.ph_hi = 0;
    if (hipMemsetAsync((char*)d_ws + WS_CTL, 0, CTL_ZERO_BYTES, stream) != hipSuccess) { fprintf(stderr, "kernel_launch: memset failed\n"); return; }
    void* kargs[] = {&a};
    hipError_t e = hipLaunchCooperativeKernel((const void*)hymba_fwd, dim3(grid), dim3(NTHREADS), kargs, LDS_BYTES, stream);
    if (e != hipSuccess) fprintf(stderr, "cooperative launch failed: %s (grid %d)\n", hipGetErrorString(e), grid);
}
```
